# Optimizing an MI355X kernel written in HIP

```python
import jax, jax.numpy as jnp
from jax import lax
import numpy as np

D_MODEL = 1024
BATCH = 16
SEQ = 4096
DEPTH = 2

EPS = 1e-6
MLA_HEADS = 8
QK_NOPE = 64
QK_ROPE = 32
QK_HEAD = QK_NOPE + QK_ROPE
V_HEAD = 64
Q_RANK = 384
KV_RANK = 256
ROPE_BASE = 10000.0
Q_BLOCK = 128
MLA_WIDTH = MLA_HEADS * V_HEAD
SG_GROUPS = 4
SG_GROUP_DIM = 128
SG_WIDTH = SG_GROUPS * SG_GROUP_DIM
CHUNK = 128
CONV_WIDTH = 512
CONV_K = 3
N_GROUPS = 4
EXPERTS_PER_GROUP = 8
N_EXPERTS = N_GROUPS * EXPERTS_PER_GROUP
TOP_K = 2
D_EXPERT = 256
IN_SIZES = (Q_RANK, KV_RANK, QK_ROPE, SG_WIDTH, SG_WIDTH,
            CONV_WIDTH, CONV_WIDTH, CONV_WIDTH, D_MODEL, D_MODEL, D_MODEL)
D_IN = Q_RANK + KV_RANK + QK_ROPE + 2 * SG_WIDTH + 3 * CONV_WIDTH + 3 * D_MODEL

kernel_name = "hybrid_mla_sgmlp_shortconv_hmoe"


def rmsnorm(x, g):
    xf = x.astype(jnp.float32)
    y = xf * lax.rsqrt(jnp.mean(xf * xf, axis=-1, keepdims=True) + EPS)
    return (y * g.astype(jnp.float32)).astype(x.dtype)


def split_cols(a, sizes):
    out, start = [], 0
    for s in sizes:
        out.append(a[..., start:start + s])
        start += s
    return out


def rope_tables(positions):
    inv = ROPE_BASE ** (-jnp.arange(0, QK_ROPE, 2, dtype=jnp.float32) / QK_ROPE)
    ang = positions.astype(jnp.float32)[..., None] * inv
    return jnp.cos(ang), jnp.sin(ang)


def apply_rope(x, cos, sin):
    xf = x.astype(jnp.float32)
    x1, x2 = xf[..., :QK_ROPE // 2], xf[..., QK_ROPE // 2:]
    return jnp.concatenate([x1 * cos - x2 * sin, x2 * cos + x1 * sin], axis=-1).astype(x.dtype)


def mla_branch(c_q, c_kv, k_rope_raw, cos, sin, q_norm, w_q_up, kv_norm, w_kv_up):
    B, S, _ = c_q.shape
    q = (rmsnorm(c_q, q_norm) @ w_q_up).reshape(B, S, MLA_HEADS, QK_HEAD)
    q_nope, q_rope = q[..., :QK_NOPE], q[..., QK_NOPE:]
    q_rope = apply_rope(q_rope, cos[:, :, None, :], sin[:, :, None, :])
    q = jnp.concatenate([q_nope, q_rope], axis=-1)
    kv = (rmsnorm(c_kv, kv_norm) @ w_kv_up).reshape(B, S, MLA_HEADS, QK_NOPE + V_HEAD)
    k_nope, v = kv[..., :QK_NOPE], kv[..., QK_NOPE:]
    k_rope = apply_rope(k_rope_raw[:, :, None, :], cos[:, :, None, :], sin[:, :, None, :])
    k = jnp.concatenate([k_nope, jnp.broadcast_to(k_rope, (B, S, MLA_HEADS, QK_ROPE))], axis=-1)
    scale = QK_HEAD ** -0.5
    nb = S // Q_BLOCK
    q_blocks = q.reshape(B, nb, Q_BLOCK, MLA_HEADS, QK_HEAD).transpose(1, 0, 2, 3, 4)
    k_pos = jnp.arange(S)
    neg = jnp.finfo(jnp.float32).min

    def attend(args):
        q_blk, blk = args
        q_pos = blk * Q_BLOCK + jnp.arange(Q_BLOCK)
        s = jnp.einsum('bqhd,bkhd->bhqk', q_blk, k).astype(jnp.float32) * scale
        s = jnp.where(k_pos[None, :] <= q_pos[:, None], s, neg)
        p = jax.nn.softmax(s, axis=-1).astype(v.dtype)
        return jnp.einsum('bhqk,bkhd->bqhd', p, v)

    o = lax.map(attend, (q_blocks, jnp.arange(nb)))
    return o.transpose(1, 0, 2, 3, 4).reshape(B, S, MLA_WIDTH)


def spatial_gating_branch(u, v, sg_norm, w_s, b_s):
    B, S, _ = u.shape
    u = jax.nn.gelu(u)
    v = rmsnorm(jax.nn.gelu(v), sg_norm)
    v = v.reshape(B, S // CHUNK, CHUNK, SG_GROUPS, SG_GROUP_DIM)
    w = w_s * jnp.tril(jnp.ones((CHUNK, CHUNK), dtype=w_s.dtype))[None]
    mixed = jnp.einsum('gts,bcsgd->bctgd', w, v) + b_s.T[:, :, None]
    return u * mixed.reshape(B, S, SG_WIDTH)


def short_conv_branch(b_gate, c_gate, h, conv_w):
    S = h.shape[1]
    z = c_gate * h
    zp = jnp.pad(z, ((0, 0), (CONV_K - 1, 0), (0, 0)))
    y = conv_w[0] * zp[:, 0:S]
    for j in range(1, CONV_K):
        y = y + conv_w[j] * zp[:, j:j + S]
    return b_gate * y


def hier_moe(h, w_group_router, b_group_router, w_expert_router, b_expert_router, w_gate_up, w_down):
    B, S, D = h.shape
    t = h.reshape(B * S, D)
    T = t.shape[0]
    g_prob = jax.nn.softmax((t @ w_group_router).astype(jnp.float32) + b_group_router.astype(jnp.float32), axis=-1)
    g_p, g_idx = lax.top_k(g_prob, 1)
    e_logits = ((t @ w_expert_router).astype(jnp.float32) + b_expert_router.astype(jnp.float32))
    e_logits = e_logits.reshape(T, N_GROUPS, EXPERTS_PER_GROUP)
    e_sel = jnp.take_along_axis(e_logits, g_idx[:, :, None], axis=1)[:, 0]
    e_prob = jax.nn.softmax(e_sel, axis=-1)
    top_p, top_i = lax.top_k(e_prob, TOP_K)
    weights = g_p * (top_p / jnp.sum(top_p, axis=-1, keepdims=True))
    expert_id = g_idx * EXPERTS_PER_GROUP + top_i
    combine = jnp.einsum('tk,tke->te', weights, jax.nn.one_hot(expert_id, N_EXPERTS, dtype=jnp.float32))
    combine = combine.astype(t.dtype)
    out = jnp.zeros_like(t)
    for e in range(N_EXPERTS):
        gu = t @ w_gate_up[e]
        y = (jax.nn.silu(gu[:, :D_EXPERT]) * gu[:, D_EXPERT:]) @ w_down[e]
        out = out + combine[:, e:e + 1] * y
    return out.reshape(B, S, D)


def setup_inputs(seed: int = 0) -> dict:
    key = jax.random.key(seed)
    ks = jax.random.split(key, 32)
    L, D, f32 = DEPTH, D_MODEL, jnp.float32

    def nrm(k, shape, fan_in):
        return jax.random.normal(k, shape, f32) * (fan_in ** -0.5)

    def gain(k, shape):
        return 1.0 + 0.05 * jax.random.normal(k, shape, f32)

    offsets = jax.random.randint(ks[1], (BATCH,), 0, 1024, dtype=jnp.int32)
    positions = offsets[:, None] + jnp.arange(SEQ, dtype=jnp.int32)[None, :]
    return {
        "x": jax.random.normal(ks[0], (BATCH, SEQ, D), f32),
        "positions": positions,
        "norm_mix": gain(ks[2], (L, D)),
        "w_in": nrm(ks[3], (L, D, D_IN), D),
        "q_norm": gain(ks[4], (L, Q_RANK)),
        "w_q_up": nrm(ks[5], (L, Q_RANK, MLA_HEADS * QK_HEAD), Q_RANK),
        "kv_norm": gain(ks[6], (L, KV_RANK)),
        "w_kv_up": nrm(ks[7], (L, KV_RANK, MLA_HEADS * (QK_NOPE + V_HEAD)), KV_RANK),
        "sg_norm": gain(ks[8], (L, SG_WIDTH)),
        "w_s": nrm(ks[9], (L, SG_GROUPS, CHUNK, CHUNK), CHUNK),
        "b_s": 1.0 + 0.1 * jax.random.normal(ks[10], (L, SG_GROUPS, CHUNK), f32),
        "conv_w": nrm(ks[11], (L, CONV_K, CONV_WIDTH), CONV_K),
        "w_a_out": nrm(ks[12], (L, MLA_WIDTH, D), MLA_WIDTH),
        "w_b_out": nrm(ks[13], (L, SG_WIDTH, D), SG_WIDTH),
        "w_c_out": nrm(ks[14], (L, CONV_WIDTH, D), CONV_WIDTH),
        "w_o": nrm(ks[15], (L, D, D), D),
        "norm_ffn": gain(ks[16], (L, D)),
        "w_group_router": nrm(ks[17], (L, D, N_GROUPS), D),
        "b_group_router": 0.01 * jax.random.normal(ks[18], (L, N_GROUPS), f32),
        "w_expert_router": nrm(ks[19], (L, D, N_EXPERTS), D),
        "b_expert_router": 0.01 * jax.random.normal(ks[20], (L, N_EXPERTS), f32),
        "w_gate_up": nrm(ks[21], (L, N_EXPERTS, D, 2 * D_EXPERT), D),
        "w_down": nrm(ks[22], (L, N_EXPERTS, D_EXPERT, D), D_EXPERT),
        "final_norm": gain(ks[23], (D,)),
    }


def reference(x, positions, norm_mix, w_in, q_norm, w_q_up, kv_norm, w_kv_up, sg_norm, w_s, b_s,
              conv_w, w_a_out, w_b_out, w_c_out, w_o, norm_ffn, w_group_router, b_group_router,
              w_expert_router, b_expert_router, w_gate_up, w_down, final_norm):
    cos, sin = rope_tables(positions)
    for l in range(DEPTH):
        h = rmsnorm(x, norm_mix[l])
        (c_q, c_kv, k_r, sg_u, sg_v, cb, cc, ch, ga, gb, gc) = split_cols(h @ w_in[l], IN_SIZES)
        y_a = mla_branch(c_q, c_kv, k_r, cos, sin, q_norm[l], w_q_up[l], kv_norm[l], w_kv_up[l]) @ w_a_out[l]
        y_b = spatial_gating_branch(sg_u, sg_v, sg_norm[l], w_s[l], b_s[l]) @ w_b_out[l]
        y_c = short_conv_branch(cb, cc, ch, conv_w[l]) @ w_c_out[l]
        merged = jax.nn.sigmoid(ga) * y_a + jax.nn.sigmoid(gb) * y_b + jax.nn.sigmoid(gc) * y_c
        x = x + merged @ w_o[l]
        h = rmsnorm(x, norm_ffn[l])
        x = x + hier_moe(h, w_group_router[l], b_group_router[l], w_expert_router[l],
                         b_expert_router[l], w_gate_up[l], w_down[l])
    return rmsnorm(x, final_norm)
```

```cpp
#include <hip/hip_runtime.h>
#include <cstdio>
#include <cstdint>

#ifndef MK_ONE_LAUNCH
#define MK_ONE_LAUNCH 1
#endif
#ifndef FAST_ATTN
#define FAST_ATTN 1
#endif

#define GAS __attribute__((address_space(1)))
#define LAS __attribute__((address_space(3)))
typedef unsigned short bf16_t;
typedef short bf16x8 __attribute__((ext_vector_type(8)));
typedef float f32x4 __attribute__((ext_vector_type(4)));
typedef float f32x2 __attribute__((ext_vector_type(2)));
typedef unsigned u32x4 __attribute__((ext_vector_type(4)));
typedef unsigned u32x2 __attribute__((ext_vector_type(2)));

constexpr int D = 1024, NB = 16, S = 4096, T = NB * S, DEPTH = 2;
constexpr int NH = 8, NOPE = 64, ROPE = 32, QKH = 96, VH = 64, QR = 384, KVR = 256;
constexpr int SGW = 512, CW = 512, DIN = 6304, NE = 32, DE = 256;
constexpr float EPS = 1e-6f;
constexpr int C_CQ = 0, C_CKV = 384, C_KR = 640, C_SGU = 672, C_SGV = 1184, C_CB = 1696, C_CC = 2208, C_CH = 2720, C_GA = 3232, C_GB = 4256, C_GC = 5280;
constexpr int N_P1 = 3328, N_GATES = 3072, N_WIN = N_P1 + N_GATES;
constexpr int T0W = 768;
constexpr int N_F8A = 1280;
constexpr int WQ8_LD = 512;

constexpr size_t MiB = 1u << 20;
constexpr size_t WS_CTL = 0, CTL_ZERO_BYTES = 1 * MiB;
constexpr size_t WS_WSG = 1 * MiB;
constexpr size_t WS_WRT = 1 * MiB + 128 * 1024;
constexpr size_t WS_ROPE = 2 * MiB;
constexpr size_t WS_WT = 10 * MiB;
constexpr size_t WT_WIN = 0, WT_WQ = 13 * MiB, WT_WKV = 14 * MiB, WT_WA = 15 * MiB, WT_WB = 16 * MiB, WT_WC = 17 * MiB, WT_WO = 18 * MiB;
constexpr size_t WS_REC = 30 * MiB;
constexpr size_t WS_H = 32 * MiB;
constexpr size_t WS_T0 = 160 * MiB;
constexpr size_t WS_GV = 256 * MiB;
constexpr size_t WS_Z = 320 * MiB;
constexpr size_t WS_SGU = 384 * MiB;
constexpr size_t WS_CB = 448 * MiB;
constexpr size_t WS_KN = 512 * MiB;
constexpr size_t WS_V = 576 * MiB;
constexpr size_t WS_GB = 640 * MiB;
constexpr size_t WS_GC = 768 * MiB;
constexpr size_t WS_Q = 896 * MiB;
constexpr size_t WS_KR = 992 * MiB;
constexpr size_t WS_ST0 = 996 * MiB;
constexpr size_t WS_STV = 1000 * MiB;
constexpr size_t WS_RS = 1002 * MiB;
constexpr size_t WS_END = 1003 * MiB;
constexpr size_t WS_GA = WS_T0, WS_O = WS_Z, WS_MRG = WS_KN;
constexpr size_t WS_H8 = 704 * MiB;
constexpr size_t WT_WT8 = 10 * MiB + 512 * 1024;
constexpr size_t WT_WG8 = 7 * MiB;
constexpr float W8_SCALE = 32.f;
constexpr size_t WS_WGU = 32 * MiB, WS_WD = 64 * MiB, WS_ACT = 80 * MiB;
constexpr size_t WS_XB = 160 * MiB, WS_YB = 432 * MiB;
constexpr size_t WS_X1 = 832 * MiB;
constexpr size_t WS_LIST = 288 * MiB, WS_RL = 296 * MiB;
constexpr int MAX_TILES = 544;
constexpr int CW_TMO = 0, CW_BAR = 4096, CW_CNT = 8192;

#define LDS_WAIT() asm volatile("s_waitcnt lgkmcnt(0)" ::: "memory")
#define VM_WAIT() asm volatile("s_waitcnt vmcnt(0)" ::: "memory")
__device__ __forceinline__ float bf2f(unsigned v) { return __uint_as_float(v << 16); }
__device__ __forceinline__ unsigned f2bf(float f) { unsigned u = __float_as_uint(f); return (u + 0x7fffu + ((u >> 16) & 1u)) >> 16; }
__device__ __forceinline__ unsigned pk2(float lo, float hi) { return f2bf(lo) | (f2bf(hi) << 16); }
__device__ __forceinline__ float lo16(unsigned w) { return __uint_as_float(w << 16); }
__device__ __forceinline__ float hi16(unsigned w) { return __uint_as_float(w & 0xffff0000u); }
__device__ __forceinline__ float wave_sum(float v) {
#pragma unroll
    for (int o = 1; o < 64; o <<= 1) v += __shfl_xor(v, o);
    return v;
}
__device__ __forceinline__ float sigmoidf_(float x) { return 1.f / (1.f + __expf(-x)); }
__device__ __forceinline__ float gelu_tanh(float x) { const float u = 0.7978845608028654f * (x + 0.044715f * x * x * x); return x / (1.f + __expf(-2.f * u)); }
__device__ __forceinline__ float siluf_(float x) { return x / (1.f + __expf(-x)); }
typedef __bf16 bf16x2_t __attribute__((ext_vector_type(2)));
__device__ __forceinline__ unsigned cvt_pk(float lo, float hi) { const f32x2 v = {lo, hi}; const bf16x2_t b = __builtin_convertvector(v, bf16x2_t); return __builtin_bit_cast(unsigned, b); }
__device__ __forceinline__ unsigned pk4f8(float a, float b, float c, float d) { int w = 0; w = __builtin_amdgcn_cvt_pk_fp8_f32(a, b, w, false); w = __builtin_amdgcn_cvt_pk_fp8_f32(c, d, w, true); return (unsigned)w; }
__device__ __forceinline__ u32x4 pack8(const f32x4 a, const f32x4 b) { u32x4 w; w.x = cvt_pk(a[0], a[1]); w.y = cvt_pk(a[2], a[3]); w.z = cvt_pk(b[0], b[1]); w.w = cvt_pk(b[2], b[3]); return w; }
__device__ __forceinline__ float fsigmoid(float x) { return __builtin_amdgcn_rcpf(1.f + __builtin_amdgcn_exp2f(-1.4426950408889634f * x)); }
__device__ __forceinline__ float fgelu(float x) { const float t = x * x; return x * __builtin_amdgcn_rcpf(1.f + __builtin_amdgcn_exp2f(x * (-2.302208198f + -0.102943240f * t))); }
__device__ __forceinline__ f32x4 fgelu4(const f32x4 v) { return (f32x4){fgelu(v[0]), fgelu(v[1]), fgelu(v[2]), fgelu(v[3])}; }
__device__ __forceinline__ float dot8(const f32x4 a, const f32x4 b) { return ((a[0] * a[0] + a[1] * a[1]) + (a[2] * a[2] + a[3] * a[3])) + ((b[0] * b[0] + b[1] * b[1]) + (b[2] * b[2] + b[3] * b[3])); }

#define XB_TMO      128
#define XB_XCNT(j)  (256  + 64 * (j))
#define XB_XSUB(j)  (1280 + 64 * (j))
#define XB_XGEN(j)  (2304 + 64 * (j))
#define XB_TOP      3328
#define XB_TOPGEN   3392
#define XCD_BAR_WORDS 3456
#define XB_SPIN_CAP (1u << 18)
__device__ __forceinline__ unsigned xb_ld(unsigned* p)              { return __hip_atomic_load(p, __ATOMIC_RELAXED, __HIP_MEMORY_SCOPE_AGENT); }
__device__ __forceinline__ unsigned xb_add(unsigned* p, unsigned v) { return __hip_atomic_fetch_add(p, v, __ATOMIC_RELAXED, __HIP_MEMORY_SCOPE_AGENT); }
__device__ __forceinline__ unsigned xb_xcc_id() { return (unsigned)__builtin_amdgcn_s_getreg((3 << 11) | 20) & 0xFu; }
#define XB_SPIN(cond, bar) do { unsigned _sp = 0; while (cond) { __builtin_amdgcn_s_sleep(1); \
    if ((++_sp & 255u) == 0u) { if (xb_ld(&(bar)[XB_TMO])) break; if (_sp > XB_SPIN_CAP) { atomicAdd(&(bar)[XB_TMO], 1u); break; } } } } while (0)
struct XcdBarrier { unsigned* bar; unsigned x; volatile LAS unsigned* st; };
__device__ __forceinline__ XcdBarrier xcd_barrier_post(unsigned* bar, volatile LAS unsigned* st) {
    XcdBarrier b; b.bar = bar; b.x = xb_xcc_id(); b.st = st;
    if (threadIdx.x == 0) (void)xb_add(&bar[XB_XCNT(b.x)], 1u);
    return b;
}
__device__ __forceinline__ void xcd_barrier_complete(unsigned* bar, unsigned x, unsigned& nloc, unsigned& nx) {
    const unsigned G = gridDim.x * gridDim.y * gridDim.z;
    unsigned sum, cnt, mine, sp = 0u;
    for (;;) {
        sum = 0u; cnt = 0u; mine = 0u;
#pragma unroll
        for (unsigned j = 0; j < 16; ++j) { const unsigned c = xb_ld(&bar[XB_XCNT(j)]); sum += c; cnt += (c > 0u) ? 1u : 0u; mine = (j == x) ? c : mine; }
        if (sum == G) break;
        __builtin_amdgcn_s_sleep(1);
        if ((++sp & 255u) == 0u) { if (xb_ld(&bar[XB_TMO])) break; if (sp > XB_SPIN_CAP) { atomicAdd(&bar[XB_TMO], 1u); break; } }
    }
    nloc = mine > 0u ? mine : 1u; nx = cnt > 0u ? cnt : 1u;
}
__device__ __forceinline__ void xcd_barrier(const XcdBarrier& b, const bool is_t0) {
    asm volatile("s_waitcnt vmcnt(0)" ::: "memory");
    __syncthreads();
    if (is_t0) {
        unsigned* bar = b.bar;
        __builtin_amdgcn_s_waitcnt(0);
        unsigned nloc = b.st[0], nx = b.st[1];
        if (nloc == 0u) { xcd_barrier_complete(bar, b.x, nloc, nx); b.st[0] = nloc; b.st[1] = nx; }
        const unsigned old = xb_add(&bar[XB_XSUB(b.x)], 1u);
        const unsigned gen = old / nloc;
        if (old + 1u == (gen + 1u) * nloc) {
            __builtin_amdgcn_fence(__ATOMIC_RELEASE, "agent");
            asm volatile("s_waitcnt vmcnt(0)" ::: "memory");
            const unsigned og = xb_add(&bar[XB_TOP], 1u);
            const unsigned tg = og / nx;
            if (og + 1u == (tg + 1u) * nx) xb_add(&bar[XB_TOPGEN], 1u);
            else XB_SPIN(xb_ld(&bar[XB_TOPGEN]) == tg, bar);
            __builtin_amdgcn_fence(__ATOMIC_ACQUIRE, "agent");
            xb_add(&bar[XB_XGEN(b.x)], 1u);
            asm volatile("s_waitcnt vmcnt(0)" ::: "memory");
        } else {
            XB_SPIN(xb_ld(&bar[XB_XGEN(b.x)]) == gen, bar);
            __builtin_amdgcn_fence(__ATOMIC_ACQUIRE, "agent");
            asm volatile("s_waitcnt vmcnt(0)" ::: "memory");
        }
    }
    __syncthreads();
}

constexpr int RING_BYTES = 131072;
constexpr int TAB_OFF = RING_BYTES;
constexpr int TAB_BYTES = 2048;
constexpr int MISC_OFF = TAB_OFF + TAB_BYTES;
constexpr int LDS_BYTES = 147456;
constexpr int NWAVES = 8, NTHREADS = 512;

__device__ __forceinline__ int fresh_tid(int wave) { int lane; asm volatile("v_mbcnt_lo_u32_b32 %0, -1, 0\n\tv_mbcnt_hi_u32_b32 %0, -1, %0" : "=v"(lane)); return wave * 64 + lane; }
struct Frame {
    LAS unsigned char* lds;
    unsigned char* lds_generic;
    unsigned char* ws;
    int wave, G;
    const float* const* in;
    float* out;
};

struct MapIdent { __device__ __forceinline__ int operator()(int n) const { return n; } };
struct MapWin {
    __device__ __forceinline__ int operator()(int n) const {
        if (n < 256) return C_CKV + n;
        if (n < 640) return C_CQ + (n - 256);
        if (n < 672) return C_KR + (n - 640);
        if (n < 768) return -1;
        if (n < 1280) return C_SGV + (n - 768);
        if (n < 1792) return C_SGU + (n - 1280);
        if (n < 2304) return C_CB + (n - 1792);
        if (n < 3328) { const int j = (n - 2304) >> 1; return (n & 1) ? C_CH + j : C_CC + j; }
        if (n < 4352) return C_GA + (n - 3328);
        if (n < 5376) return C_GB + (n - 4352);
        return C_GC + (n - 5376);
    }
};
struct MapGates { __device__ __forceinline__ int operator()(int n) const { return C_GA + n; } };
struct MapWq {
    __device__ __forceinline__ int operator()(int n) const { const int h = n / 96, d = n - h * 96; if (d < 64) return n; const int j = d - 64, i = j >> 1; return h * 96 + 64 + ((j & 1) ? 16 + i : i); }
};
struct MapWkv {
    __device__ __forceinline__ int operator()(int n) const { const int part = n >> 9, r = n & 511, h = r >> 6, j = r & 63; return h * 128 + part * 64 + j; }
};
struct MapWgu {
    __device__ __forceinline__ int operator()(int n) const { const int j = n >> 1; return (n & 1) ? 256 + j : j; }
};
template <class Map, bool FP8 = false>
__device__ __forceinline__ void transpose_mat(const float* W, int K, int Nsrc, bf16_t* WT, int ndest, const Map map, const float* kscale,
                                              LAS float* scr, int gw, int ngw, int lane, int nmat, size_t src_stride, size_t dst_stride, int ldk = 0  ) {
    const int nblk = ndest / 32, kblk = K / 64, per = nblk * kblk;
    for (int it = gw; it < per * nmat; it += ngw) {
        const int mat = it / per, r = it - mat * per, kb = r / nblk, nb = r - kb * nblk, k0 = kb * 64, n0 = nb * 32;
        const float* Wm = W + (size_t)mat * src_stride; bf16_t* WTm = WT + (size_t)mat * dst_stride;
        const int sc = map(n0 + (lane & 31)); const float msk = sc >= 0 ? 1.f : 0.f;
        const float* src = Wm + (size_t)(k0 + (lane >> 5)) * Nsrc + (sc >= 0 ? sc : 0);
        float v[32];
#pragma unroll
        for (int i = 0; i < 32; ++i) v[i] = src[(size_t)(2 * i) * Nsrc];
        const int c = lane & 7;
        f32x4 ka = {1.f, 1.f, 1.f, 1.f}, kb4 = ka;
        if (kscale) { ka = *(const f32x4*)(kscale + k0 + 8 * c); kb4 = *(const f32x4*)(kscale + k0 + 8 * c + 4); }
        if constexpr (FP8) { ka *= W8_SCALE; kb4 *= W8_SCALE; }
#pragma unroll
        for (int i = 0; i < 32; ++i) scr[(2 * i + (lane >> 5)) * 33 + (lane & 31)] = v[i] * msk;
        LDS_WAIT(); asm volatile("" ::: "memory");
#pragma unroll
        for (int j = 0; j < 4; ++j) { const int n = (lane >> 3) + 8 * j; const LAS float* s = scr + (8 * c) * 33 + n;
            if constexpr (FP8) { u32x2 o; o.x = pk4f8(s[0 * 33] * ka[0], s[1 * 33] * ka[1], s[2 * 33] * ka[2], s[3 * 33] * ka[3]); o.y = pk4f8(s[4 * 33] * kb4[0], s[5 * 33] * kb4[1], s[6 * 33] * kb4[2], s[7 * 33] * kb4[3]);
                *(u32x2*)((unsigned char*)WT + (size_t)mat * dst_stride + (size_t)(n0 + n) * (ldk ? ldk : K) + k0 + 8 * c) = o; }
            else { u32x4 o; o.x = pk2(s[0 * 33] * ka[0], s[1 * 33] * ka[1]); o.y = pk2(s[2 * 33] * ka[2], s[3 * 33] * ka[3]); o.z = pk2(s[4 * 33] * kb4[0], s[5 * 33] * kb4[1]); o.w = pk2(s[6 * 33] * kb4[2], s[7 * 33] * kb4[3]);
            *(u32x4*)(WTm + (size_t)(n0 + n) * K + k0 + 8 * c) = o; } }
        LDS_WAIT(); asm volatile("" ::: "memory");
    }
}
__device__ __forceinline__ void convert_mixer_weights(Frame& F, int l) {
    const int tid_ = fresh_tid(F.wave), lane_ = tid_ & 63; (void)lane_;
    LAS float* scr = (LAS float*)(F.lds + F.wave * 16384);
    unsigned char* wt = F.ws + WS_WT;
    transpose_mat(F.in[3] + (size_t)l * D * DIN, D, DIN, (bf16_t*)(wt + WT_WIN), N_P1, MapWin(), nullptr, scr, ((int)blockIdx.x * NWAVES + F.wave), (F.G * NWAVES), lane_, 1, 0, 0);
    transpose_mat<MapGates, true>(F.in[3] + (size_t)l * D * DIN, D, DIN, (bf16_t*)(wt + WT_WG8), N_GATES, MapGates(), nullptr, scr, ((int)blockIdx.x * NWAVES + F.wave), (F.G * NWAVES), lane_, 1, 0, 0);
    transpose_mat<MapWin, true>(F.in[3] + (size_t)l * D * DIN, D, DIN, (bf16_t*)(wt + WT_WT8), N_F8A, MapWin(), nullptr, scr, ((int)blockIdx.x * NWAVES + F.wave), (F.G * NWAVES), lane_, 1, 0, 0);
    transpose_mat<MapWq, true>(F.in[5] + (size_t)l * QR * 768, QR, 768, (bf16_t*)(wt + WT_WQ), 768, MapWq(), F.in[4] + l * QR, scr, ((int)blockIdx.x * NWAVES + F.wave), (F.G * NWAVES), lane_, 1, 0, 0, WQ8_LD);
    for (int idx = (int)blockIdx.x * NTHREADS + tid_; idx < 768 * 32; idx += F.G * NTHREADS) *(unsigned*)(wt + WT_WQ + (size_t)(idx >> 5) * WQ8_LD + QR + (idx & 31) * 4) = 0u;
    transpose_mat<MapWkv, true>(F.in[7] + (size_t)l * KVR * 1024, KVR, 1024, (bf16_t*)(wt + WT_WKV), 1024, MapWkv(), F.in[6] + l * KVR, scr, ((int)blockIdx.x * NWAVES + F.wave), (F.G * NWAVES), lane_, 1, 0, 0);
    transpose_mat(F.in[12] + (size_t)l * 512 * D, 512, D, (bf16_t*)(wt + WT_WA), D, MapIdent(), nullptr, scr, ((int)blockIdx.x * NWAVES + F.wave), (F.G * NWAVES), lane_, 1, 0, 0);
    transpose_mat(F.in[13] + (size_t)l * 512 * D, 512, D, (bf16_t*)(wt + WT_WB), D, MapIdent(), nullptr, scr, ((int)blockIdx.x * NWAVES + F.wave), (F.G * NWAVES), lane_, 1, 0, 0);
    transpose_mat(F.in[14] + (size_t)l * 512 * D, 512, D, (bf16_t*)(wt + WT_WC), D, MapIdent(), nullptr, scr, ((int)blockIdx.x * NWAVES + F.wave), (F.G * NWAVES), lane_, 1, 0, 0);
    transpose_mat(F.in[15] + (size_t)l * D * D, D, D, (bf16_t*)(wt + WT_WO), D, MapIdent(), nullptr, scr, ((int)blockIdx.x * NWAVES + F.wave), (F.G * NWAVES), lane_, 1, 0, 0);
}
__device__ __forceinline__ void convert_moe_weights(Frame& F, int l) {
    const int tid_ = fresh_tid(F.wave), lane_ = tid_ & 63; (void)lane_;
    LAS float* scr = (LAS float*)(F.lds + F.wave * 16384);
    transpose_mat<MapWgu, true>(F.in[21] + (size_t)l * NE * D * 512, D, 512, (bf16_t*)(F.ws + WS_WGU), 512, MapWgu(), F.in[16] + l * D  , scr, ((int)blockIdx.x * NWAVES + F.wave), (F.G * NWAVES), lane_, NE, (size_t)D * 512, (size_t)512 * D  );
    transpose_mat<MapIdent, true>(F.in[22] + (size_t)l * NE * DE * D, DE, D, (bf16_t*)(F.ws + WS_WD), D, MapIdent(), nullptr, scr, ((int)blockIdx.x * NWAVES + F.wave), (F.G * NWAVES), lane_, NE, (size_t)DE * D, (size_t)D * DE  );
}

__device__ __forceinline__ void norm_rows_bf16(Frame& F, const float* X, const float* gain, bf16_t* H, unsigned char* H8, float* RS) {
    const int tid_ = fresh_tid(F.wave), lane_ = tid_ & 63; (void)lane_;
    constexpr int RB = 8;
    f32x4 g[4];
#pragma unroll
    for (int j = 0; j < 4; ++j) g[j] = ((const f32x4*)gain)[lane_ + 64 * j];
    for (int m0 = ((int)blockIdx.x * NWAVES + F.wave); m0 < T; m0 += RB * (F.G * NWAVES)) {
        f32x4 v[RB][4];
#pragma unroll
        for (int r = 0; r < RB; ++r) { const int m = m0 + r * (F.G * NWAVES); if (m < T) { const f32x4* xr = (const f32x4*)(X + (size_t)m * D) + lane_;
#pragma unroll
            for (int j = 0; j < 4; ++j) v[r][j] = xr[64 * j]; } }
#pragma unroll
        for (int r = 0; r < RB; ++r) { const int m = m0 + r * (F.G * NWAVES); if (m < T) { float s = 0.f;
#pragma unroll
            for (int j = 0; j < 4; ++j) s += (v[r][j].x * v[r][j].x + v[r][j].y * v[r][j].y) + (v[r][j].z * v[r][j].z + v[r][j].w * v[r][j].w);
            const float ms = wave_sum(s) * (1.f / D) + EPS, rstd = rsqrtf(ms);
            if (lane_ == 0) RS[m] = ms * rstd;
            u32x2* o = (u32x2*)(H + (size_t)m * D) + lane_;
#pragma unroll
            for (int j = 0; j < 4; ++j) { u32x2 w; w.x = cvt_pk(v[r][j].x * rstd * g[j].x, v[r][j].y * rstd * g[j].y); w.y = cvt_pk(v[r][j].z * rstd * g[j].z, v[r][j].w * rstd * g[j].w); o[64 * j] = w; }
            unsigned* o8 = (unsigned*)(H8 + (size_t)m * D) + lane_;
#pragma unroll
            for (int j = 0; j < 4; ++j) o8[64 * j] = pk4f8(v[r][j].x * rstd * g[j].x, v[r][j].y * rstd * g[j].y, v[r][j].z * rstd * g[j].z, v[r][j].w * rstd * g[j].w); } }
    }
}
__device__ __forceinline__ void rope_table(Frame& F) {
    const int tid_ = fresh_tid(F.wave), lane_ = tid_ & 63; (void)lane_;
    const int* pos = (const int*)F.in[1]; float* R = (float*)(F.ws + WS_ROPE);
    const int gt = blockIdx.x * NTHREADS + tid_, nt = F.G * NTHREADS;
    for (int idx = gt; idx < T * 16; idx += nt) { const int t = idx >> 4, i = idx & 15;
        const float inv = powf(10000.f, -(float)(2 * i) / 32.f); const float ang = (float)pos[t] * inv;
        R[t * 32 + i] = cosf(ang); R[t * 32 + 16 + i] = sinf(ang); }
}
namespace pg8 {
constexpr int BM = 256, BK = 64, HALF = 128, HTB = HALF * BK * 2, STAGE_BYTES = 8 * HTB, NXCD = 8, WGM = 8;
__host__ __device__ __forceinline__ int lds_byte(int r, int c) { const int st = (r >> 4) * 2 + (c >> 5), rr = r & 15, cc = c & 31, ob = rr * 64 + cc * 2; return st * 1024 + (ob ^ (((ob >> 9) & 1) << 5)); }
__host__ __device__ __forceinline__ void stage_rc(int b, int& R, int& C) { const int st = b / 1024, sb = b % 1024, swz = sb ^ (((sb >> 9) & 1) << 5); R = (st >> 1) * 16 + swz / 64; C = (st & 1) * 32 + (swz % 64) / 2; }
__host__ __device__ __forceinline__ int perm32(int rho) { const int n = rho >> 4, i = rho & 15; return 8 * (i >> 2) + 4 * n + (i & 3); }
struct Unit { int pm, pn, aux, rm, rn; };
struct Gemm { const bf16_t* A; const bf16_t* Bt; };
struct StaticOrder {
    int nM, nN, nwg, G, c;
    __host__ __device__ void init(int M, int N, int G_, int c_) { nM = M / BM; nN = N / BM; nwg = nM * nN; G = G_; c = c_; }
    __host__ __device__ bool next(int i, Unit& u) const {
        const long L = (long)i * G + c; if (L >= nwg) return false;
        int wgid = (int)L; { const int q = nwg / NXCD, r = nwg % NXCD, xcd = wgid % NXCD, off = wgid / NXCD; wgid = (xcd < r ? xcd * (q + 1) : r * (q + 1) + (xcd - r) * q) + off; }
        const int nig = WGM * nN, gid = wgid / nig, fm = gid * WGM, gsz = (nM - fm) < WGM ? (nM - fm) : WGM;
        u.pm = fm + ((wgid % nig) % gsz); u.pn = (wgid % nig) / gsz; return true;
    }
};
struct MoeOrder {
    const LAS unsigned char* tile_e; int ntiles, ntn, G, c;
    __device__ bool next(int i, Unit& u) const {
        const int L = i * G + c; if (L >= ntiles * ntn) return false;
        const int tile = L / ntn, pn = L - tile * ntn; u.pm = tile; u.pn = __builtin_amdgcn_readfirstlane((int)tile_e[tile]) * ntn + pn; return true;
    }
};
struct MoeGatherOrder {
    const LAS unsigned char* tile_e; const LAS unsigned short* tile_r; const LAS int* cnt; const unsigned* list; int ntiles, ntn, G, c;
    __device__ bool next(int i, Unit& u) const {
        const int L = i * G + c; if (L >= ntiles * ntn) return false;
        const int tile = L / ntn, pn = L - tile * ntn, e = __builtin_amdgcn_readfirstlane((int)tile_e[tile]), rt = __builtin_amdgcn_readfirstlane((int)tile_r[tile]);
        u.pm = tile; u.pn = e * ntn + pn; u.aux = e; u.rm = rt; u.rn = __builtin_amdgcn_readfirstlane(cnt[e]); return true;
    }
    __device__ __forceinline__ unsigned rowoff(const Unit& u, int r) const { const int idx = u.rm * 256 + r; const unsigned tok = idx < u.rn ? list[(size_t)u.aux * T + idx] : 0u; return tok * (unsigned)D; }
};
struct ChainOrder {
    StaticOrder so;
    __device__ bool next(int i, Unit& u) const {
        const int it = i / 3, br = i - it * 3; Unit t;
        if (!so.next(it, t)) return false;
        u.rm = t.pm; u.rn = t.pn; u.aux = br;
        constexpr size_t TS = (size_t)256 * 512 * 2;
        constexpr int A0 = (int)(WS_SGU / TS), A1 = (int)(WS_CB / TS), A2 = (int)(WS_O / TS), B0 = (int)((WS_WT + WT_WB) / TS), B1 = (int)((WS_WT + WT_WC) / TS), B2 = (int)((WS_WT + WT_WA) / TS);
        int ao = A0 + br * (A1 - A0), bo = B0 + br * (B1 - B0); if (br == 2) { ao = A2; bo = B2; }
        u.pm = t.pm + ao; u.pn = t.pn + bo; return true;
    }
};
template <class Fn> struct Epi8 {
    static constexpr bool PERM = true, CHAIN = false;
    Fn f;
    __device__ __forceinline__ void operator()(const f32x4 (&acc)[2][2][4][2], const Unit& u, int wr, int wc, int fr, int fq) const {
#pragma unroll
        for (int ai = 0; ai < 2; ++ai)
#pragma unroll
            for (int m = 0; m < 4; ++m) { const int row = u.pm * BM + ai * HALF + wr * 64 + m * 16 + fr;
#pragma unroll
                for (int bj = 0; bj < 2; ++bj) f(u, row, u.pn * BM + bj * HALF + wc * 32 + 8 * fq, acc[ai][bj][m][0], acc[ai][bj][m][1]);
                asm volatile("" ::: "memory"); }
    }
};
template <class Fn, int MB> struct Epi8L {
    static constexpr bool PERM = true, CHAIN = false;
    Fn f;
    __device__ __forceinline__ void operator()(const f32x4 (&acc)[2][2][4][2], const Unit& u, int wr, int wc, int fr, int fq) const {
#pragma unroll
        for (int ai = 0; ai < 2; ++ai)
#pragma unroll
            for (int mb = 0; mb < 4; mb += MB) {
                typename Fn::Pre pre[MB][2];
#pragma unroll
                for (int m = 0; m < MB; ++m)
#pragma unroll
                    for (int bj = 0; bj < 2; ++bj) pre[m][bj] = f.pre(u, u.pm * BM + ai * HALF + wr * 64 + (mb + m) * 16 + fr, u.pn * BM + bj * HALF + wc * 32 + 8 * fq);
                asm volatile("" ::: "memory");
#pragma unroll
                for (int m = 0; m < MB; ++m)
#pragma unroll
                    for (int bj = 0; bj < 2; ++bj) f.post(u, u.pm * BM + ai * HALF + wr * 64 + (mb + m) * 16 + fr, u.pn * BM + bj * HALF + wc * 32 + 8 * fq, acc[ai][bj][mb + m][0], acc[ai][bj][mb + m][1], pre[m][bj]);
                asm volatile("" ::: "memory"); }
    }
};
template <class Fn> struct Epi8A {
    static constexpr bool PERM = true, CHAIN = false;
    Fn f;
    __device__ __forceinline__ void operator()(const f32x4 (&acc)[2][2][4][2], const Unit& u, int wr, int wc, int fr, int fq) const {
        typename Fn::Pre pre[2][4][2];
#pragma unroll
        for (int ai = 0; ai < 2; ++ai)
#pragma unroll
            for (int m = 0; m < 4; ++m)
#pragma unroll
                for (int bj = 0; bj < 2; ++bj) pre[ai][m][bj] = f.pre(u, u.pm * BM + ai * HALF + wr * 64 + m * 16 + fr, u.pn * BM + bj * HALF + wc * 32 + 8 * fq);
        asm volatile("" ::: "memory");
#pragma unroll
        for (int ai = 0; ai < 2; ++ai)
#pragma unroll
            for (int m = 0; m < 4; ++m) {
#pragma unroll
                for (int bj = 0; bj < 2; ++bj) f.post(u, u.pm * BM + ai * HALF + wr * 64 + m * 16 + fr, u.pn * BM + bj * HALF + wc * 32 + 8 * fq, acc[ai][bj][m][0], acc[ai][bj][m][1], pre[ai][m][bj]);
                asm volatile("" ::: "memory"); }
    }
};
typedef int i32x4_t __attribute__((ext_vector_type(4)));
typedef int i32x8_t __attribute__((ext_vector_type(8)));
__device__ __forceinline__ i32x8_t cat8(const bf16x8 a, const bf16x8 b) { const i32x4_t x = __builtin_bit_cast(i32x4_t, a), y = __builtin_bit_cast(i32x4_t, b); return __builtin_shufflevector(x, y, 0, 1, 2, 3, 4, 5, 6, 7); }
template <class Epi, class Sched, int LDA, int LDB, int KK, bool ALIGN_EPI = true, bool GATHER = false, bool FP8 = false>
__device__ __forceinline__ void gemm_phase(LAS unsigned char* lds, const int wave, const Gemm g, const Sched& S, const Epi& E) {
    const int tid = fresh_tid(wave), wid = __builtin_amdgcn_readfirstlane(tid >> 6), lane = tid & 63, wr = wid >> 2, wc = wid & 3, fr = lane & 15, fq = lane >> 4;
    constexpr int nt = KK / BK; static_assert(KK % 128 == 0, "K must be a multiple of 128");
    unsigned voffA, voffB;
    { int R, C; stage_rc(tid * 16, R, C); const int Rb = Epi::PERM ? ((R & ~31) + perm32(R & 31)) : R;
      voffA = (unsigned)(R * LDA + C) * 2u; voffB = (unsigned)(Rb * LDB + C) * 2u; }
    constexpr size_t pieceA = (size_t)64 * LDA * 2, pieceB = (size_t)64 * LDB * 2;
    unsigned gc00 = 0, gc01 = 0, gc10 = 0, gc11 = 0, gn00 = 0, gn01 = 0, gn10 = 0, gn11 = 0;
    constexpr size_t kstep = (size_t)(BK * 2);
    constexpr size_t hstepA = (size_t)HALF * LDA * 2, hstepB = (size_t)HALF * LDB * 2;
    constexpr size_t tstepA = 2 * hstepA, tstepB = 2 * hstepB;
    const unsigned ldsw = (unsigned)wid * 1024u;
    const int aoff = lds_byte(wr * 64 + fr, fq * 8), boff = lds_byte(wc * 32 + fr, fq * 8);
#define PG8_SA(b, h) (((b) * 2 + (h)) * HTB)
#define PG8_SB(b, h) ((4 + (b) * 2 + (h)) * HTB)
#define PG8_STAGE(bufoff, gbase, voff) do { \
        __builtin_amdgcn_global_load_lds((const unsigned*)((const char*)(gbase) + voff), (LAS unsigned*)(lds + (bufoff) + ldsw), 16, 0, 0); \
        __builtin_amdgcn_global_load_lds((const unsigned*)((const char*)(gbase) + PG8_PIECE_##voff + voff), (LAS unsigned*)(lds + (bufoff) + ldsw + 8192), 16, 0, 0); } while (0)
#define PG8_GLD(gptr, ldsoff) __builtin_amdgcn_global_load_lds((const unsigned*)(gptr), (LAS unsigned*)(lds + (ldsoff)), 16, 0, 0)
#define PG8_STAGE_A(bufoff, ptr, h, nx) do { if constexpr (GATHER) { \
        const unsigned o0_ = (nx) ? ((h) ? gn10 : gn00) : ((h) ? gc10 : gc00), o1_ = (nx) ? ((h) ? gn11 : gn01) : ((h) ? gc11 : gc01); \
        PG8_GLD((const char*)(ptr) + o0_, (bufoff) + ldsw); PG8_GLD((const char*)(ptr) + o1_, (bufoff) + ldsw + 8192); \
    } else { PG8_STAGE(bufoff, (const char*)(ptr) + (h) * hstepA, voffA); } } while (0)
#define PG8_ROWOFFS(u, o00, o01, o10, o11) do { int gR_, gC_; stage_rc(fresh_tid(wave) * 16, gR_, gC_);     \
        o00 = S.rowoff(u, gR_) + gC_ * 2; o01 = S.rowoff(u, gR_ + 64) + gC_ * 2; o10 = S.rowoff(u, 128 + gR_) + gC_ * 2; o11 = S.rowoff(u, 192 + gR_) + gC_ * 2; } while (0)
#define PG8_PIECE_voffA pieceA
#define PG8_PIECE_voffB pieceB
#define PG8_LDA(dst, b, h) do { _Pragma("unroll") for (int m = 0; m < 4; ++m) _Pragma("unroll") for (int k = 0; k < 2; ++k) dst[m][k] = *(const LAS bf16x8*)(lds + PG8_SA(b, h) + aoff + m * 2048 + k * 1024); } while (0)
#define PG8_LDB(dst, b, h) do { _Pragma("unroll") for (int n = 0; n < 2; ++n) _Pragma("unroll") for (int k = 0; k < 2; ++k) dst[n][k] = *(const LAS bf16x8*)(lds + PG8_SB(b, h) + boff + n * 2048 + k * 1024); } while (0)
#define PG8_MMA(ai, bj, At, Bt) do { __builtin_amdgcn_s_setprio(1); _Pragma("unroll") for (int m = 0; m < 4; ++m) _Pragma("unroll") for (int n = 0; n < 2; ++n) { \
        if constexpr (FP8) asm volatile("v_mfma_f32_16x16x128_f8f6f4 %0, %1, %2, %0" : "+v"(acc[ai][bj][m][n]) : "v"(cat8(Bt[n][0], Bt[n][1])), "v"(cat8(At[m][0], At[m][1])));   \
        else { _Pragma("unroll") for (int k = 0; k < 2; ++k) acc[ai][bj][m][n] = __builtin_amdgcn_mfma_f32_16x16x32_bf16(Bt[n][k], At[m][k], acc[ai][bj][m][n], 0, 0, 0); } } __builtin_amdgcn_s_setprio(0); } while (0)
#define PG8_WAIT_V(n) asm volatile("s_waitcnt vmcnt(" #n ")" ::: "memory")
#define PG8_WAIT_L(n) asm volatile("s_waitcnt lgkmcnt(" #n ")" ::: "memory")
#define PG8_BAR __builtin_amdgcn_s_barrier()
#define PG8_SCHED __builtin_amdgcn_sched_barrier(0)
    Unit cur, nxt; int ui = 0;
    if (!S.next(0, cur)) return;
    f32x4 acc[2][2][4][2];
#pragma unroll
    for (int a = 0; a < 2; ++a)
#pragma unroll
        for (int b = 0; b < 2; ++b)
#pragma unroll
            for (int m = 0; m < 4; ++m)
#pragma unroll
                for (int n = 0; n < 2; ++n) acc[a][b][m][n] = (f32x4){0.f, 0.f, 0.f, 0.f};
    bf16x8 At[4][2], B0[2][2], B1[2][2];
    const char* cA = (const char*)g.A + (GATHER ? (size_t)0 : (size_t)cur.pm * tstepA); const char* cB = (const char*)g.Bt + (size_t)cur.pn * tstepB;
    if constexpr (GATHER) PG8_ROWOFFS(cur, gc00, gc01, gc10, gc11);
    PG8_STAGE(PG8_SB(0, 0), cB, voffB); PG8_STAGE(PG8_SB(0, 1), cB + hstepB, voffB); PG8_STAGE_A(PG8_SA(0, 0), cA, 0, false); PG8_STAGE_A(PG8_SA(0, 1), cA, 1, false);
    if (wr == 1) PG8_BAR;
    PG8_WAIT_V(2); PG8_BAR;
    PG8_STAGE(PG8_SB(1, 0), cB + kstep, voffB); PG8_STAGE_A(PG8_SA(1, 0), cA + kstep, 0, false); PG8_STAGE(PG8_SB(1, 1), cB + hstepB + kstep, voffB);
    PG8_WAIT_V(6); PG8_BAR;
    for (;;) {
        const bool has_next = S.next(ui + 1, nxt);
        const char* nA = (has_next && !GATHER) ? (const char*)g.A + (size_t)nxt.pm * tstepA : cA;
        if constexpr (GATHER) { if (has_next) PG8_ROWOFFS(nxt, gn00, gn01, gn10, gn11); else { gn00 = gc00; gn01 = gc01; gn10 = gc10; gn11 = gc11; } } const char* nB = has_next ? (const char*)g.Bt + (size_t)nxt.pn * tstepB : cB;
#pragma nounroll
        for (int t = 0; t < nt; t += 2) {
            const bool last = (t == nt - 2);
            const char* a1 = cA + (size_t)(t + 1) * kstep;
            const char* a2 = last ? nA : cA + (size_t)(t + 2) * kstep; const char* b2 = last ? nB : cB + (size_t)(t + 2) * kstep;
            const char* a3 = a2 + kstep; const char* b3 = b2 + kstep;
            PG8_LDB(B0, 0, 0); PG8_LDB(B1, 0, 1); PG8_SCHED; PG8_LDA(At, 0, 0); PG8_STAGE_A(PG8_SA(1, 1), a1, 1, false);
            PG8_WAIT_V(8); PG8_WAIT_L(0); PG8_BAR; PG8_MMA(0, 0, At, B0); PG8_MMA(0, 1, At, B1); PG8_BAR; PG8_SCHED;
            PG8_LDA(At, 0, 1); PG8_STAGE(PG8_SB(0, 0), b2, voffB); PG8_STAGE(PG8_SB(0, 1), b2 + hstepB, voffB); PG8_STAGE_A(PG8_SA(0, 0), a2, 0, last);
            PG8_WAIT_V(8); PG8_WAIT_L(0); PG8_BAR; PG8_MMA(1, 0, At, B0); PG8_MMA(1, 1, At, B1); PG8_BAR; PG8_SCHED;
            PG8_LDB(B0, 1, 0); PG8_LDB(B1, 1, 1); PG8_SCHED; PG8_LDA(At, 1, 0); PG8_STAGE_A(PG8_SA(0, 1), a2, 1, last);
            PG8_WAIT_V(8); PG8_WAIT_L(0); PG8_BAR; PG8_MMA(0, 0, At, B0); PG8_MMA(0, 1, At, B1); PG8_BAR; PG8_SCHED;
            PG8_LDA(At, 1, 1); PG8_STAGE(PG8_SB(1, 0), b3, voffB); PG8_STAGE(PG8_SB(1, 1), b3 + hstepB, voffB); PG8_STAGE_A(PG8_SA(1, 0), a3, 0, last);
            PG8_WAIT_V(8); PG8_WAIT_L(0); PG8_BAR; PG8_MMA(1, 0, At, B0); PG8_MMA(1, 1, At, B1); PG8_BAR; PG8_SCHED;
        }
        if constexpr (FP8) asm volatile("s_nop 15\n\ts_nop 15" ::: "memory");
        if constexpr (ALIGN_EPI) { if (wr == 0) PG8_BAR; }
        { const int l2 = fresh_tid(wave) & 63; E(acc, cur, wr, wc, l2 & 15, l2 >> 4); }
        if (!has_next) break;
        if (!Epi::CHAIN || cur.aux == 2) {
#pragma unroll
        for (int a = 0; a < 2; ++a)
#pragma unroll
            for (int b = 0; b < 2; ++b)
#pragma unroll
                for (int m = 0; m < 4; ++m)
#pragma unroll
                    for (int n = 0; n < 2; ++n) acc[a][b][m][n] = (f32x4){0.f, 0.f, 0.f, 0.f}; }
        cur = nxt; cA = nA; cB = nB; ++ui;
        if constexpr (GATHER) { gc00 = gn00; gc01 = gn01; gc10 = gn10; gc11 = gn11; }
        if constexpr (ALIGN_EPI) { if (wr == 1) PG8_BAR; }
    }
    PG8_WAIT_V(0);
    if constexpr (!ALIGN_EPI) { if (wr == 0) PG8_BAR; }
    PG8_BAR;
#undef PG8_SA
#undef PG8_SB
#undef PG8_STAGE
#undef PG8_GLD
#undef PG8_STAGE_A
#undef PG8_ROWOFFS
#undef PG8_PIECE_voffA
#undef PG8_PIECE_voffB
#undef PG8_LDA
#undef PG8_LDB
#undef PG8_MMA
#undef PG8_WAIT_V
#undef PG8_WAIT_L
#undef PG8_BAR
#undef PG8_SCHED
}
}

template <int LDA, int LDB, int N, int KK, bool FP8 = false, class Epi>
__device__ __forceinline__ void gemm_dense(Frame& F, const bf16_t* A, const bf16_t* Bt, const Epi& E) {
    pg8::Gemm g{A, Bt}; pg8::StaticOrder So; So.init(T, N, F.G, (int)blockIdx.x);
    pg8::gemm_phase<Epi, pg8::StaticOrder, LDA, LDB, KK, true, false, FP8>(F.lds, F.wave, g, So, E);
}

template <bool F8> struct EpiP1 {
    static constexpr bool PERM = true, CHAIN = false;
    bf16_t *T0, *SGU, *GV, *CB, *Z; float *ST0, *STV;
    __device__ __forceinline__ void operator()(const f32x4 (&acc)[2][2][4][2], const pg8::Unit& u, int wr, int wc, int fr, int fq) const {
        const int pn = F8 ? (u.pn < 3 ? u.pn : u.pn + 2) : (u.pn < 2 ? u.pn + 3 : u.pn + 5);
#pragma unroll
        for (int ai = 0; ai < 2; ++ai)
#pragma unroll
            for (int m = 0; m < 4; ++m) { const int row = u.pm * 256 + ai * 128 + wr * 64 + m * 16 + fr;
                float ss0 = 0.f, ss1 = 0.f;
#pragma unroll
                for (int bj = 0; bj < 2; ++bj) { const int c = bj * 128 + wc * 32 + 8 * fq; f32x4 v0 = acc[ai][bj][m][0], v1 = acc[ai][bj][m][1]; float ss = 0.f;
                    if (F8) { v0 *= (1.f / W8_SCALE); v1 *= (1.f / W8_SCALE); }
                    if (pn < 3) { u32x2 w8; w8.x = pk4f8(v0[0], v0[1], v0[2], v0[3]); w8.y = pk4f8(v1[0], v1[1], v1[2], v1[3]); *(u32x2*)((unsigned char*)T0 + (size_t)row * T0W + pn * 256 + c) = w8; ss = dot8(v0, v1); }
                    else if (pn < 5) { v0 = fgelu4(v0); v1 = fgelu4(v1); *(u32x4*)(SGU + (size_t)row * SGW + (pn - 3) * 256 + c) = pack8(v0, v1); }
                    else if (pn < 7) { v0 = fgelu4(v0); v1 = fgelu4(v1); *(u32x4*)(GV + (size_t)row * SGW + (pn - 5) * 256 + c) = pack8(v0, v1); ss = dot8(v0, v1); }
                    else if (pn < 9) { *(u32x4*)(CB + (size_t)row * CW + (pn - 7) * 256 + c) = pack8(v0, v1); }
                    else { u32x2 w; w.x = cvt_pk(v0[0] * v0[1], v0[2] * v0[3]); w.y = cvt_pk(v1[0] * v1[1], v1[2] * v1[3]); *(u32x2*)(Z + (size_t)row * CW + (pn - 9) * 128 + (c >> 1)) = w; }
                    if (bj == 0) ss0 = ss; else ss1 = ss; }
                if (pn < 3 || (pn >= 5 && pn < 7)) {
                    float sv = (pn == 2) ? ss0 : ss0 + ss1;
                    sv += __shfl_xor(sv, 16); sv += __shfl_xor(sv, 32);
                    if (fq == 0) { if (pn < 3) ST0[(size_t)row * 12 + pn * 4 + wc] = sv; else STV[(size_t)row * 8 + (pn - 5) * 4 + wc] = sv; } }
                asm volatile("" ::: "memory"); }
    }
};
struct FnGates8 {
    unsigned char* ws;
    __device__ __forceinline__ void operator()(const pg8::Unit& u, int row, int col, f32x4 v0, f32x4 v1) const {
        const int w = u.pn >> 2; size_t off = WS_GB + (size_t)(w - 1) * (WS_GC - WS_GB); if (w == 0) off = WS_GA;
        constexpr float KS = -1.4426950408889634f / W8_SCALE;
        u32x2 pk = {0u, 0u};
#pragma unroll
        for (int j = 0; j < 4; ++j) {
            pk.x = __builtin_amdgcn_cvt_pk_u8_f32(__builtin_amdgcn_rcpf(1.f + __builtin_amdgcn_exp2f(KS * v0[j])) * 255.f + 0.5f, j, pk.x);
            pk.y = __builtin_amdgcn_cvt_pk_u8_f32(__builtin_amdgcn_rcpf(1.f + __builtin_amdgcn_exp2f(KS * v1[j])) * 255.f + 0.5f, j, pk.y); }
        const unsigned char* gb = ws + off; const unsigned vo = (unsigned)row * (unsigned)D + (unsigned)(col & 1023);
        *(u32x2*)(gb + vo) = pk;
    }
};
constexpr float QSCALE = 0.10206207261596577f * 1.4426950408889634f;
struct FnQ8 {
    bf16_t* Q; const float* ST0; const float* rope;
    struct Pre { f32x4 a, b, c, s; };
    __device__ __forceinline__ Pre pre(const pg8::Unit& u, int row, int col) const {
        Pre p; p.a = *(const f32x4*)(ST0 + (size_t)row * 12 + 4); p.b = *(const f32x4*)(ST0 + (size_t)row * 12 + 8);
        const int d = col % 96, i = d >= 64 ? (d - 64) >> 1 : 0;
        p.c = *(const f32x4*)(rope + (size_t)row * 32 + i); p.s = *(const f32x4*)(rope + (size_t)row * 32 + 16 + i);
        if (d < 64) { p.c = (f32x4){1.f, 1.f, 1.f, 1.f}; p.s = (f32x4){0.f, 0.f, 0.f, 0.f}; }
        return p; }
    __device__ __forceinline__ void post(const pg8::Unit& u, int row, int col, f32x4 v0, f32x4 v1, const Pre& p) const {
        const float r = rsqrtf((((p.a[0] + p.a[1]) + (p.a[2] + p.a[3])) + ((p.b[0] + p.b[1]) + (p.b[2] + p.b[3]))) * (1.f / QR) + EPS);
        const f32x4 t0 = v0 * (r * (QSCALE / W8_SCALE)), t1 = v1 * (r * (QSCALE / W8_SCALE)), c = p.c, s = p.s;
        v0[0] = t0[0] * c[0] - t0[1] * s[0]; v0[1] = t0[1] * c[0] + t0[0] * s[0]; v0[2] = t0[2] * c[1] - t0[3] * s[1]; v0[3] = t0[3] * c[1] + t0[2] * s[1];
        v1[0] = t1[0] * c[2] - t1[1] * s[2]; v1[1] = t1[1] * c[2] + t1[0] * s[2]; v1[2] = t1[2] * c[3] - t1[3] * s[3]; v1[3] = t1[3] * c[3] + t1[2] * s[3];
        *(u32x4*)(Q + (size_t)row * 768 + col) = pack8(v0, v1);
    }
};
struct FnKV8 {
    bf16_t *KN, *V; const float* ST0;
    struct Pre { f32x4 a; };
    __device__ __forceinline__ Pre pre(const pg8::Unit& u, int row, int col) const { Pre p; p.a = *(const f32x4*)(ST0 + (size_t)row * 12); return p; }
    __device__ __forceinline__ void post(const pg8::Unit& u, int row, int col, f32x4 v0, f32x4 v1, const Pre& p) const {
        const float r = rsqrtf(((p.a[0] + p.a[1]) + (p.a[2] + p.a[3])) * (1.f / KVR) + EPS) * (1.f / W8_SCALE);
        bf16_t* O = u.pn < 2 ? KN : V;
        *(u32x4*)(O + (size_t)row * 512 + (col & 511)) = pack8(v0 * r, v1 * r);
    }
};
template <bool FIRST> struct FnMerge8 {
    bf16_t* MRG; const bf16_t* G;
    struct Pre { u32x4 g, m; };
    __device__ __forceinline__ Pre pre(const pg8::Unit& u, int row, int col) const {
        const size_t o = (size_t)row * D + col; Pre p; p.g = *(const u32x4*)(G + o);
        if (!FIRST) p.m = *(const u32x4*)(MRG + o); else p.m = (u32x4){0u, 0u, 0u, 0u};
        return p; }
    __device__ __forceinline__ void post(const pg8::Unit& u, int row, int col, f32x4 v0, f32x4 v1, const Pre& p) const {
        const size_t o = (size_t)row * D + col; const u32x4 g = p.g, m = p.m;
        v0 = (f32x4){lo16(g.x) * v0[0], hi16(g.x) * v0[1], lo16(g.y) * v0[2], hi16(g.y) * v0[3]};
        v1 = (f32x4){lo16(g.z) * v1[0], hi16(g.z) * v1[1], lo16(g.w) * v1[2], hi16(g.w) * v1[3]};
        if (!FIRST) { v0 += (f32x4){lo16(m.x), hi16(m.x), lo16(m.y), hi16(m.y)}; v1 += (f32x4){lo16(m.z), hi16(m.z), lo16(m.w), hi16(m.w)}; }
        *(u32x4*)(MRG + o) = pack8(v0, v1);
    }
};
template <bool BASE_F32> struct FnResB {
    const void* base; bf16_t* out; unsigned char* out8;
    struct Pre { f32x4 b0, b1; };
    __device__ __forceinline__ Pre pre(const pg8::Unit& u, int row, int col) const { const size_t o = (size_t)row * D + col; Pre p;
        if (BASE_F32) { p.b0 = *(const f32x4*)((const float*)base + o); p.b1 = *(const f32x4*)((const float*)base + o + 4); }
        else { const u32x4 w = *(const u32x4*)((const bf16_t*)base + o); p.b0 = (f32x4){lo16(w.x), hi16(w.x), lo16(w.y), hi16(w.y)}; p.b1 = (f32x4){lo16(w.z), hi16(w.z), lo16(w.w), hi16(w.w)}; }
        return p; }
    __device__ __forceinline__ void post(const pg8::Unit& u, int row, int col, f32x4 v0, f32x4 v1, const Pre& p) const { v0 += p.b0; v1 += p.b1; *(u32x4*)(out + (size_t)row * D + col) = pack8(v0, v1);
        u32x2 w; w.x = pk4f8(v0[0], v0[1], v0[2], v0[3]); w.y = pk4f8(v1[0], v1[1], v1[2], v1[3]); *(u32x2*)(out8 + (size_t)row * D + col) = w; }
};
struct EpiResH {
    static constexpr bool PERM = true, CHAIN = false;
    const bf16_t* Hn; const float* rs; const float* gain; bf16_t* out; unsigned char* out8;
    __device__ __forceinline__ void operator()(const f32x4 (&acc)[2][2][4][2], const pg8::Unit& u, int wr, int wc, int fr, int fq) const {
        f32x4 ig[2][2]; u32x4 h[2][4][2]; float r[2][4];
#pragma unroll
        for (int bj = 0; bj < 2; ++bj) { const int col = u.pn * 256 + bj * 128 + wc * 32 + 8 * fq; ig[bj][0] = *(const f32x4*)(gain + col); ig[bj][1] = *(const f32x4*)(gain + col + 4); }
#pragma unroll
        for (int ai = 0; ai < 2; ++ai)
#pragma unroll
            for (int m = 0; m < 4; ++m) { const int row = u.pm * 256 + ai * 128 + wr * 64 + m * 16 + fr; r[ai][m] = rs[row];
#pragma unroll
                for (int bj = 0; bj < 2; ++bj) h[ai][m][bj] = *(const u32x4*)(Hn + (size_t)row * D + u.pn * 256 + bj * 128 + wc * 32 + 8 * fq); }
        asm volatile("" ::: "memory");
#pragma unroll
        for (int bj = 0; bj < 2; ++bj)
#pragma unroll
            for (int k = 0; k < 2; ++k) ig[bj][k] = (f32x4){__builtin_amdgcn_rcpf(ig[bj][k][0]), __builtin_amdgcn_rcpf(ig[bj][k][1]), __builtin_amdgcn_rcpf(ig[bj][k][2]), __builtin_amdgcn_rcpf(ig[bj][k][3])};
#pragma unroll
        for (int ai = 0; ai < 2; ++ai)
#pragma unroll
            for (int m = 0; m < 4; ++m) { const int row = u.pm * 256 + ai * 128 + wr * 64 + m * 16 + fr;
#pragma unroll
                for (int bj = 0; bj < 2; ++bj) { const size_t o = (size_t)row * D + u.pn * 256 + bj * 128 + wc * 32 + 8 * fq; const u32x4 w = h[ai][m][bj];
                    const f32x4 v0 = (f32x4){lo16(w.x), hi16(w.x), lo16(w.y), hi16(w.y)} * (ig[bj][0] * r[ai][m]) + acc[ai][bj][m][0];
                    const f32x4 v1 = (f32x4){lo16(w.z), hi16(w.z), lo16(w.w), hi16(w.w)} * (ig[bj][1] * r[ai][m]) + acc[ai][bj][m][1];
                    *(u32x4*)(out + o) = pack8(v0, v1);
                    u32x2 w8; w8.x = pk4f8(v0[0], v0[1], v0[2], v0[3]); w8.y = pk4f8(v1[0], v1[1], v1[2], v1[3]); *(u32x2*)(out8 + o) = w8; }
                asm volatile("" ::: "memory"); }
    }
};
struct FnRes8 {
    const float* base; float* out;
    struct Pre { f32x4 b0, b1; };
    __device__ __forceinline__ Pre pre(const pg8::Unit& u, int row, int col) const { const size_t o = (size_t)row * D + col; Pre p; p.b0 = *(const f32x4*)(base + o); p.b1 = *(const f32x4*)(base + o + 4); return p; }
    __device__ __forceinline__ void post(const pg8::Unit& u, int row, int col, f32x4 v0, f32x4 v1, const Pre& p) const {
        const size_t o = (size_t)row * D + col; *(f32x4*)(out + o) = p.b0 + v0; *(f32x4*)(out + o + 4) = p.b1 + v1;
    }
};
struct EpiChain {
    static constexpr bool PERM = true, CHAIN = true;
    bf16_t* MRG; const unsigned char* ws;
    static __device__ __forceinline__ f32x4 ub4(unsigned w) {
        return (f32x4){fmaxf((float)(w & 255u), 1.f), fmaxf((float)((w >> 8) & 255u), 1.f), fmaxf((float)((w >> 16) & 255u), 1.f), fmaxf((float)(w >> 24), 1.f)}; }
    __device__ __forceinline__ void operator()(f32x4 (&acc)[2][2][4][2], const pg8::Unit& u, int wr, int wc, int fr, int fq) const {
        const int br = u.aux;
        const size_t on = (br == 2) ? WS_GA : WS_GB + (size_t)br * (WS_GC - WS_GB), od = (br == 0) ? WS_GC : WS_GA;
        const unsigned char* Gn = ws + on; const unsigned char* Gd = ws + od;
        u32x2 gna[2][4][2], gda[2][4][2];
#pragma unroll
        for (int ai = 0; ai < 2; ++ai)
#pragma unroll
            for (int m = 0; m < 4; ++m)
#pragma unroll
                for (int bj = 0; bj < 2; ++bj) { const size_t o = (size_t)(u.rm * 256 + ai * 128 + wr * 64 + m * 16 + fr) * D + u.rn * 256 + bj * 128 + wc * 32 + 8 * fq;
                    gna[ai][m][bj] = *(const u32x2*)(Gn + o); if (br != 2) gda[ai][m][bj] = *(const u32x2*)(Gd + o); else gda[ai][m][bj] = (u32x2){0u, 0u}; }
        asm volatile("" ::: "memory");
#pragma unroll
        for (int ai = 0; ai < 2; ++ai) {
            const u32x2 (&gn)[4][2] = gna[ai]; const u32x2 (&gd)[4][2] = gda[ai];
#pragma unroll
            for (int m = 0; m < 4; ++m)
#pragma unroll
                for (int bj = 0; bj < 2; ++bj) { const size_t o = (size_t)(u.rm * 256 + ai * 128 + wr * 64 + m * 16 + fr) * D + u.rn * 256 + bj * 128 + wc * 32 + 8 * fq;
                    f32x4 f0 = ub4(gn[m][bj].x), f1 = ub4(gn[m][bj].y);
                    if (br != 2) { const f32x4 d0 = ub4(gd[m][bj].x), d1 = ub4(gd[m][bj].y);
                        f0 *= (f32x4){__builtin_amdgcn_rcpf(d0[0]), __builtin_amdgcn_rcpf(d0[1]), __builtin_amdgcn_rcpf(d0[2]), __builtin_amdgcn_rcpf(d0[3])};
                        f1 *= (f32x4){__builtin_amdgcn_rcpf(d1[0]), __builtin_amdgcn_rcpf(d1[1]), __builtin_amdgcn_rcpf(d1[2]), __builtin_amdgcn_rcpf(d1[3])};
                        acc[ai][bj][m][0] *= f0; acc[ai][bj][m][1] *= f1;
                    } else { *(u32x4*)(MRG + o) = pack8(acc[ai][bj][m][0] * (f0 * (1.f / 255.f)), acc[ai][bj][m][1] * (f1 * (1.f / 255.f))); } }
            asm volatile("" ::: "memory"); }
    }
};
struct FnMoe1G {
    bf16_t* ACT; const float* rl;
    struct Pre { float rs; };
    __device__ __forceinline__ Pre pre(const pg8::Unit& u, int row, int col) const { Pre p; p.rs = rl[(size_t)u.aux * T + u.rm * 256 + (row - u.pm * 256)] * (1.f / W8_SCALE); return p; }
    __device__ __forceinline__ void post(const pg8::Unit& u, int row, int col, f32x4 v0, f32x4 v1, const Pre& p) const {
        v0 *= p.rs; v1 *= p.rs;
        *(unsigned*)((unsigned char*)ACT + (size_t)row * DE + ((col & 511) >> 1)) = pk4f8(v0[0] * fsigmoid(v0[0]) * v0[1], v0[2] * fsigmoid(v0[2]) * v0[3], v1[0] * fsigmoid(v1[0]) * v1[1], v1[2] * fsigmoid(v1[2]) * v1[3]);
    }
};
struct FnMoe1_8 {
    bf16_t* ACT;
    __device__ __forceinline__ void operator()(const pg8::Unit& u, int row, int col, f32x4 v0, f32x4 v1) const {
        u32x2 w; w.x = cvt_pk(v0[0] * fsigmoid(v0[0]) * v0[1], v0[2] * fsigmoid(v0[2]) * v0[3]); w.y = cvt_pk(v1[0] * fsigmoid(v1[0]) * v1[1], v1[2] * fsigmoid(v1[2]) * v1[3]);
        *(u32x2*)(ACT + (size_t)row * DE + ((col & 511) >> 1)) = w;
    }
};
struct FnMoe2_8 {
    unsigned char* YB;
    __device__ __forceinline__ void operator()(const pg8::Unit& u, int row, int col, f32x4 v0, f32x4 v1) const {
        v0 *= (1.f / W8_SCALE); v1 *= (1.f / W8_SCALE);
        u32x2 w; w.x = pk4f8(v0[0], v0[1], v0[2], v0[3]); w.y = pk4f8(v1[0], v1[1], v1[2], v1[3]);
        *(u32x2*)(YB + (size_t)row * D + (col & 1023)) = w; }
};

__device__ __forceinline__ void sgmix_pass(Frame& F, int l, bf16_t* OUT) {
    typedef float f32x16 __attribute__((ext_vector_type(16)));
    const int tid_ = fresh_tid(F.wave), lane_ = tid_ & 63, r32 = lane_ & 31, hi = lane_ >> 5, wid = F.wave;
    LAS unsigned char* VT = F.lds; LAS float* RV = (LAS float*)(F.lds + TAB_OFF);
    bf16_t* SGU = (bf16_t*)(F.ws + WS_SGU); const bf16_t* GV = (const bf16_t*)(F.ws + WS_GV); const float* stv = (const float*)(F.ws + WS_STV);
    const float* sgn = F.in[8] + l * SGW; const bf16_t* WSG = (const bf16_t*)(F.ws + WS_WSG); const float* bs = F.in[10] + l * 4 * 128;
    for (int chunk = blockIdx.x; chunk < T / 128; chunk += gridDim.x) {
        const int t0 = chunk * 128;
        __syncthreads();
        if (tid_ < 128) { const f32x4 a = *(const f32x4*)(stv + (size_t)(t0 + tid_) * 8), b = *(const f32x4*)(stv + (size_t)(t0 + tid_) * 8 + 4);
            RV[tid_] = rsqrtf((((a[0] + a[1]) + (a[2] + a[3])) + ((b[0] + b[1]) + (b[2] + b[3]))) * (1.f / SGW) + EPS); }
        __syncthreads();
        u32x4 av[8], bv[8];
#pragma unroll
        for (int k = 0; k < 8; ++k) { const int c0 = (wid + 8 * k) * 8, s2 = 2 * lane_;
            av[k] = *(const u32x4*)(GV + (size_t)(t0 + s2) * SGW + c0); bv[k] = *(const u32x4*)(GV + (size_t)(t0 + s2 + 1) * SGW + c0); }
#pragma unroll
        for (int k = 0; k < 8; ++k) { const int cc = wid + 8 * k, c0 = cc * 8, s2 = 2 * lane_, g = c0 >> 7, d0 = c0 & 127;
            const u32x4 a = av[k], b = bv[k];
            const float ra = RV[s2], rb = RV[s2 + 1]; const f32x4 g0 = *(const f32x4*)(sgn + c0), g1 = *(const f32x4*)(sgn + c0 + 4);
            const float ga[8] = {g0[0], g0[1], g0[2], g0[3], g1[0], g1[1], g1[2], g1[3]};
#pragma unroll
            for (int j = 0; j < 8; ++j) { const unsigned wa = a[j >> 1], wb = b[j >> 1];
                const float va = ((j & 1) ? hi16(wa) : lo16(wa)) * ra * ga[j], vb = ((j & 1) ? hi16(wb) : lo16(wb)) * rb * ga[j];
                const int d = d0 + j;
                *(LAS unsigned*)(VT + g * 32768 + d * 256 + ((((s2 >> 3) ^ (d & 15)) << 4) + (s2 & 7) * 2)) = cvt_pk(va, vb); } }
        __syncthreads();
        const int g = wid >> 1;
#pragma unroll 1
        for (int pass = 0; pass < 2; ++pass) { const int tt = (wid & 1) ? 1 + pass : (pass ? 3 : 0);
            f32x16 acc[4] = {};
            const bf16_t* wrow = WSG + ((size_t)(g * 128 + 32 * tt + r32)) * 128 + 8 * hi;
            const LAS unsigned char* vb = VT + g * 32768;
            bf16x8 Af[8];
#pragma unroll
            for (int ks = 0; ks < 8; ++ks) Af[ks] = *(const bf16x8*)(wrow + 16 * ks);
            const int nks = 2 * (tt + 1);
#pragma unroll
            for (int ks = 0; ks < 8; ++ks) if (ks < nks) {
#pragma unroll
                for (int dt = 0; dt < 4; ++dt) { const int d = 32 * dt + r32;
                    const bf16x8 B = *(const LAS bf16x8*)(vb + d * 256 + (((2 * ks + hi) ^ (d & 15)) << 4));
                    acc[dt] = __builtin_amdgcn_mfma_f32_32x32x16_bf16(Af[ks], B, acc[dt], 0, 0, 0); } }
#pragma unroll
            for (int r = 0; r < 16; ++r) { const int t = 32 * tt + (r & 3) + 8 * (r >> 2) + 4 * hi; const float bias = bs[g * 128 + t];
#pragma unroll
                for (int dt = 0; dt < 4; ++dt) { const size_t o_ = (size_t)(t0 + t) * SGW + g * 128 + 32 * dt + r32;
                    OUT[o_] = (bf16_t)f2bf(bf2f(SGU[o_]) * (acc[dt][r] + bias)); } }
        }
    }
    __syncthreads();
}
__device__ __forceinline__ void conv_pass(Frame& F, int l, bf16_t* OUT) {
    const int tid_ = fresh_tid(F.wave);
    bf16_t* CB = (bf16_t*)(F.ws + WS_CB); const bf16_t* Z = (const bf16_t*)(F.ws + WS_Z); const float* cw = F.in[11] + (size_t)l * 3 * CW;
    const int gt = blockIdx.x * NTHREADS + tid_, nt = F.G * NTHREADS;
    for (int idx = gt; idx < (T / 4) * 64; idx += nt) { const int t0 = (idx >> 6) * 4, c8 = (idx & 63) * 8, s0 = t0 & (S - 1);
        u32x4 z[6], b[4];
        z[0] = (u32x4){0, 0, 0, 0}; z[1] = z[0];
        if (s0 >= 2) { z[0] = *(const u32x4*)(Z + (size_t)(t0 - 2) * CW + c8); z[1] = *(const u32x4*)(Z + (size_t)(t0 - 1) * CW + c8); }
#pragma unroll
        for (int i = 0; i < 4; ++i) { z[2 + i] = *(const u32x4*)(Z + (size_t)(t0 + i) * CW + c8); b[i] = *(const u32x4*)(CB + (size_t)(t0 + i) * CW + c8); }
        const f32x4 w00 = *(const f32x4*)(cw + c8), w01 = *(const f32x4*)(cw + c8 + 4), w10 = *(const f32x4*)(cw + CW + c8), w11 = *(const f32x4*)(cw + CW + c8 + 4), w20 = *(const f32x4*)(cw + 2 * CW + c8), w21 = *(const f32x4*)(cw + 2 * CW + c8 + 4);
        const float w0[8] = {w00[0], w00[1], w00[2], w00[3], w01[0], w01[1], w01[2], w01[3]}, w1[8] = {w10[0], w10[1], w10[2], w10[3], w11[0], w11[1], w11[2], w11[3]}, w2[8] = {w20[0], w20[1], w20[2], w20[3], w21[0], w21[1], w21[2], w21[3]};
#pragma unroll
        for (int i = 0; i < 4; ++i) { u32x4 o;
#pragma unroll
            for (int j = 0; j < 4; ++j) {
                const float y0 = w0[2 * j] * lo16(z[i][j]) + w1[2 * j] * lo16(z[i + 1][j]) + w2[2 * j] * lo16(z[i + 2][j]);
                const float y1 = w0[2 * j + 1] * hi16(z[i][j]) + w1[2 * j + 1] * hi16(z[i + 1][j]) + w2[2 * j + 1] * hi16(z[i + 2][j]);
                o[j] = cvt_pk(lo16(b[i][j]) * y0, hi16(b[i][j]) * y1); }
            *(u32x4*)(OUT + (size_t)(t0 + i) * CW + c8) = o; } }
}
__device__ __forceinline__ void krope_pass(Frame& F) {
    const int tid_ = fresh_tid(F.wave), lane_ = tid_ & 63; (void)lane_;
    const unsigned char* T8 = F.ws + WS_T0; bf16_t* KR = (bf16_t*)(F.ws + WS_KR); const float* rope = (const float*)(F.ws + WS_ROPE);
    const int gt = blockIdx.x * NTHREADS + tid_, nt = F.G * NTHREADS;
    for (int idx0 = gt; idx0 < T * 16; idx0 += 4 * nt) {
        float x1[4], x2[4], c[4], sn[4];
#pragma unroll
        for (int j = 0; j < 4; ++j) { const int idx = idx0 + j * nt; if (idx < T * 16) { const int t = idx >> 4, i = idx & 15;
            x1[j] = __builtin_amdgcn_cvt_f32_fp8((int)T8[(size_t)t * T0W + 640 + i], 0); x2[j] = __builtin_amdgcn_cvt_f32_fp8((int)T8[(size_t)t * T0W + 656 + i], 0); c[j] = rope[t * 32 + i]; sn[j] = rope[t * 32 + 16 + i]; } }
#pragma unroll
        for (int j = 0; j < 4; ++j) { const int idx = idx0 + j * nt; if (idx < T * 16) { const int t = idx >> 4, i = idx & 15;
            *(unsigned*)(KR + (size_t)t * 32 + 2 * i) = pk2(x1[j] * c[j] - x2[j] * sn[j], x2[j] * c[j] + x1[j] * sn[j]); } } }
}
__device__ __forceinline__ void attn_simple(Frame& F) {
    const int tid_ = fresh_tid(F.wave), lane_ = tid_ & 63; (void)lane_;
    const bf16_t* Q = (const bf16_t*)(F.ws + WS_Q); const bf16_t* KN = (const bf16_t*)(F.ws + WS_KN); const bf16_t* KR = (const bf16_t*)(F.ws + WS_KR);
    const bf16_t* V = (const bf16_t*)(F.ws + WS_V); bf16_t* O = (bf16_t*)(F.ws + WS_O);
    const float scale = 0.10206207261596577f;
    for (int item = ((int)blockIdx.x * NWAVES + F.wave); item < NB * NH * (S / 64); item += (F.G * NWAVES)) {
        const int bh = item / (S / 64), qb = item % (S / 64), b = bh >> 3, h = bh & 7, i = qb * 64 + lane_; const size_t t = (size_t)b * S + i;
        u32x4 qp[12]; float o[64]; float m = -1e30f, lsum = 0.f;
#pragma unroll
        for (int c = 0; c < 12; ++c) qp[c] = *(const u32x4*)(Q + t * 768 + h * 96 + c * 8);
#pragma unroll
        for (int d = 0; d < 64; ++d) o[d] = 0.f;
        const int jend = qb * 64 + 63;
        for (int j = 0; j <= jend; ++j) { const size_t tk = (size_t)b * S + j;
            float s = 0.f;
#pragma unroll
            for (int c = 0; c < 8; ++c) { const u32x4 w = *(const u32x4*)(KN + tk * 512 + h * 64 + c * 8);
#pragma unroll
                for (int e = 0; e < 4; ++e) s += lo16(qp[c][e]) * lo16(w[e]) + hi16(qp[c][e]) * hi16(w[e]); }
#pragma unroll
            for (int c = 0; c < 4; ++c) { const u32x4 w = *(const u32x4*)(KR + tk * 32 + c * 8);
#pragma unroll
                for (int e = 0; e < 4; ++e) s += lo16(qp[8 + c][e]) * lo16(w[e]) + hi16(qp[8 + c][e]) * hi16(w[e]); }
            s *= scale;
            const bool ok = j <= i;
            const float mn = ok ? fmaxf(m, s) : m; const float a = __expf(m - mn); const float p = ok ? __expf(s - mn) : 0.f;
            lsum = lsum * a + p; m = mn;
#pragma unroll
            for (int c = 0; c < 8; ++c) { const u32x4 w = *(const u32x4*)(V + tk * 512 + h * 64 + c * 8);
#pragma unroll
                for (int e = 0; e < 4; ++e) { o[c * 8 + 2 * e] = o[c * 8 + 2 * e] * a + p * lo16(w[e]); o[c * 8 + 2 * e + 1] = o[c * 8 + 2 * e + 1] * a + p * hi16(w[e]); } }
        }
        const float il = 1.f / lsum;
#pragma unroll
        for (int c = 0; c < 8; ++c) { u32x4 w;
#pragma unroll
            for (int e = 0; e < 4; ++e) w[e] = pk2(o[c * 8 + 2 * e] * il, o[c * 8 + 2 * e + 1] * il);
            *(u32x4*)(O + t * 512 + h * 64 + c * 8) = w; }
    }
}

namespace att {
constexpr int NW = 8, QBLK = 32, KVBLK = 64, QB = NW * QBLK;
constexpr int SHM_V = 16384, SHM_K = 16384;
constexpr int NVS = 3, NKS = 2;
constexpr int ATT_LDS = NVS * SHM_V + NKS * SHM_K + NW * 64 * 4;
constexpr int QS = 768, KNS = 512, KRS = 32, VS = 512, OS = 512;
constexpr float SCALE = 0.10206207261596577f, THR = 8.f;
constexpr unsigned WBIG = 1u << 30;
typedef short s16x4 __attribute__((ext_vector_type(4)));
typedef float f32x16 __attribute__((ext_vector_type(16)));
#define AT_KSWZ(row, colB) ((row) * 256 + ((colB) ^ (((row) & 7) << 4)))
#define AT_SBAR() __builtin_amdgcn_sched_barrier(0)
__device__ __forceinline__ int v_st(int k, int c) { const int kk = (k & ~0xC) | ((k & 4) << 1) | ((k & 8) >> 1); return ((kk >> 3) * 4 + (c >> 5)) * 512 + ((kk & 7) * 32 + (c & 31)) * 2; }
__device__ __forceinline__ int v_rd_base(int lane) { return ((lane & 3) << 3) | (((lane >> 2) & 3) << 6) | (((lane >> 4) & 1) << 5) | (((lane >> 5) & 1) << 8); }
constexpr int v_rd_off(int d0, int ks, int half) { return d0 * 512 + ks * 4096 + half * 2048; }
__device__ __forceinline__ int crow(int r, int hi) { return (r & 3) + 8 * (r >> 2) + 4 * hi; }
__device__ __forceinline__ unsigned cvtpk(float lo, float hi) { unsigned r; asm volatile("v_cvt_pk_bf16_f32 %0, %1, %2" : "=v"(r) : "v"(lo), "v"(hi)); return r; }
__device__ __forceinline__ void mask_tile(f32x16& p0, f32x16& p1, int dq, unsigned W) {
    const float NEG = -__builtin_inff();
#pragma unroll
    for (int r = 0; r < 16; ++r) { const int c = (r & 3) + 8 * (r >> 2);
        if (dq < c) p0[r] = NEG;
        if (dq < c + 32) p1[r] = NEG; }
}
constexpr float THR2 = 8.f;
template <bool FIRST>
__device__ __forceinline__ void partialSM(f32x16& p0, f32x16& p1, float& mref, f32x16& negm, float& alpha) {
    float pmax = p0[0];
#pragma unroll
    for (int r = 1; r < 16; ++r) pmax = fmaxf(pmax, p0[r]);
#pragma unroll
    for (int r = 0; r < 16; ++r) pmax = fmaxf(pmax, p1[r]);
    { auto rr = __builtin_amdgcn_permlane32_swap(__float_as_uint(pmax), __float_as_uint(pmax), false, false);
      pmax = fmaxf(__uint_as_float(rr[0]), __uint_as_float(rr[1])); }
    alpha = 1.f;
    if (FIRST || __builtin_expect(__any(pmax > THR2), 0)) {
        const float dl = FIRST ? pmax : fmaxf(pmax, 0.f);
        mref += dl;
#pragma unroll
        for (int r = 0; r < 16; ++r) { p0[r] -= dl; p1[r] -= dl; }
#pragma unroll
        for (int r = 0; r < 16; ++r) negm[r] = -mref;
        asm volatile("" : "+v"(negm));
        if (!FIRST) alpha = __builtin_amdgcn_exp2f(-dl);
    }
#pragma unroll
    for (int r = 0; r < 16; ++r) p0[r] = __builtin_amdgcn_exp2f(p0[r]);
}
__device__ __forceinline__ void finishSM(f32x16& p0, f32x16& p1, float alpha, float& l_reg, bf16x8& pa0, bf16x8& pa1, bf16x8& pa2, bf16x8& pa3) {
#pragma unroll
    for (int r = 0; r < 16; ++r) p1[r] = __builtin_amdgcn_exp2f(p1[r]);
    float ps = 0;
#pragma unroll
    for (int r = 0; r < 16; ++r) ps += p0[r];
#pragma unroll
    for (int r = 0; r < 16; ++r) ps += p1[r];
    { auto rr = __builtin_amdgcn_permlane32_swap(__float_as_uint(ps), __float_as_uint(ps), false, false);
      ps = __uint_as_float(rr[0]) + __uint_as_float(rr[1]); }
    l_reg = l_reg * alpha + ps;
#define AT_PK4(P, B_, OUT) do { unsigned a0 = cvtpk(P[B_+0], P[B_+1]), a1 = cvtpk(P[B_+2], P[B_+3]);                          \
        unsigned b0 = cvtpk(P[B_+4], P[B_+5]), b1 = cvtpk(P[B_+6], P[B_+7]);                                             \
        auto r0 = __builtin_amdgcn_permlane32_swap(a0, b0, false, false); auto r1 = __builtin_amdgcn_permlane32_swap(a1, b1, false, false); \
        u32x4 w = {r0[0], r1[0], r0[1], r1[1]}; OUT = *reinterpret_cast<bf16x8*>(&w); } while (0)
    AT_PK4(p0, 0, pa0); AT_PK4(p0, 8, pa1); AT_PK4(p1, 0, pa2); AT_PK4(p1, 8, pa3);
#undef AT_PK4
}
template <int KB>
__device__ __forceinline__ void qkt(f32x16& p0, f32x16& p1, const char* K_lds, int r32, int hi, const bf16x8* qr, const f32x16& negm) {
    p0 = negm; p1 = negm;
    const char* kb[4];
#pragma unroll
    for (int dd = 0; dd < 4; ++dd) kb[dd] = K_lds + KB * SHM_K + AT_KSWZ(r32, (dd * 16 + hi * 8) * 2);
#pragma unroll
    for (int d0 = 0; d0 < 6; ++d0) { const char* a = kb[d0 & 3] + (d0 >> 2) * 128;
        bf16x8 b0 = *reinterpret_cast<const bf16x8*>(a);
        bf16x8 b1 = *reinterpret_cast<const bf16x8*>(a + 32 * 256);
        p0 = __builtin_amdgcn_mfma_f32_32x32x16_bf16(b0, qr[d0], p0, 0, 0, 0);
        p1 = __builtin_amdgcn_mfma_f32_32x32x16_bf16(b1, qr[d0], p1, 0, 0, 0); }
}
template <int VB>
__device__ __forceinline__ void pv_tile(f32x16* o, int vb0, bf16x8 pa0, bf16x8 pa1, bf16x8 pa2, bf16x8 pa3) {
#define AT_TRRD(dst, off) asm volatile("ds_read_b64_tr_b16 %0, %1 offset:%2" : "=&v"(dst) : "v"(vb0), "i"(off) : "memory")
#define AT_PV_D0(d0) do { s16x4 l0, l1, l2, l3, h0, h1, h2, h3; constexpr int b_ = VB * SHM_V + v_rd_off(d0, 0, 0); \
        AT_TRRD(l0, b_); AT_TRRD(h0, b_ + 2048); AT_TRRD(l1, b_ + 4096); AT_TRRD(h1, b_ + 6144); AT_TRRD(l2, b_ + 8192); AT_TRRD(h2, b_ + 10240); AT_TRRD(l3, b_ + 12288); AT_TRRD(h3, b_ + 14336); \
        asm volatile("s_waitcnt lgkmcnt(0)" ::: "memory"); AT_SBAR();   \
        o[d0] = __builtin_amdgcn_mfma_f32_32x32x16_bf16(pa0, (bf16x8){l0[0], l0[1], l0[2], l0[3], h0[0], h0[1], h0[2], h0[3]}, o[d0], 0, 0, 0);   \
        o[d0] = __builtin_amdgcn_mfma_f32_32x32x16_bf16(pa1, (bf16x8){l1[0], l1[1], l1[2], l1[3], h1[0], h1[1], h1[2], h1[3]}, o[d0], 0, 0, 0);   \
        o[d0] = __builtin_amdgcn_mfma_f32_32x32x16_bf16(pa2, (bf16x8){l2[0], l2[1], l2[2], l2[3], h2[0], h2[1], h2[2], h2[3]}, o[d0], 0, 0, 0);   \
        o[d0] = __builtin_amdgcn_mfma_f32_32x32x16_bf16(pa3, (bf16x8){l3[0], l3[1], l3[2], l3[3], h3[0], h3[1], h3[2], h3[3]}, o[d0], 0, 0, 0); } while (0)
    AT_PV_D0(0); AT_PV_D0(1);
#undef AT_PV_D0
#undef AT_TRRD
}
struct BlockRef { const bf16_t* Q; const bf16_t* KN; const bf16_t* KR; const bf16_t* V; bf16_t* O; int P0; };
struct Seam { bf16x8 qr[6]; int v_prev, v_cur, v_next; };
#define AT_VMW() asm volatile("s_waitcnt vmcnt(0)" ::: "memory")
#define AT_VMWN(n) asm volatile("s_waitcnt vmcnt(%0)" :: "i"(n) : "memory")
__device__ __forceinline__ void glds16(const void* gsrc, unsigned lds_dst) { unsigned keep;
    asm volatile("s_mov_b32 %0, m0\n\ts_mov_b32 m0, %2\n\ts_nop 0\n\tglobal_load_lds_dwordx4 %1, off\n\ts_mov_b32 m0, %0" : "=&s"(keep) : "v"(gsrc), "s"(lds_dst) : "memory"); }
#define AT_LANE_CONSTS() \
    const int krow_ = 4 * wid + (lane >> 4), kc_ = (lane & 15) ^ (krow_ & 7); const bool isKR = (kc_ >= 8 && kc_ < 12); \
    const unsigned kstrB = isKR ? (unsigned)(KRS * 2) : (unsigned)(KNS * 2), koffB = (unsigned)krow_ * kstrB + (isKR ? (unsigned)(kc_ - 8) * 16u : (kc_ < 8 ? (unsigned)kc_ * 16u : 0u)); \
    const int vkk_ = wid * 8 + ((lane & 31) >> 2), vk_ = (vkk_ & ~0xC) | ((vkk_ & 4) << 1) | ((vkk_ & 8) >> 1); \
    const unsigned voffB = (unsigned)vk_ * (unsigned)(VS * 2) + (unsigned)(((lane >> 5) * 32 + (lane & 3) * 8) * 2); \
    const unsigned lds0 = (unsigned)(uintptr_t)lds
#define AT_DMA_TILE(ref, k0, kslot, vslot) do { \
        const unsigned kd_ = isKR ? (unsigned)((const char*)(ref).KR - (const char*)(ref).KN) : 0u; \
        const char* ks_ = (const char*)(ref).KN + (kd_ + koffB + (unsigned)(k0) * kstrB); \
        glds16(ks_, (unsigned)__builtin_amdgcn_readfirstlane((int)(lds0 + NVS * SHM_V + (kslot) + wid * 1024))); \
        glds16(ks_ + 32u * kstrB, (unsigned)__builtin_amdgcn_readfirstlane((int)(lds0 + NVS * SHM_V + (kslot) + (wid + 8) * 1024))); \
        glds16((const char*)(ref).V + (voffB + (unsigned)(k0) * (unsigned)(VS * 2)), (unsigned)__builtin_amdgcn_readfirstlane((int)(lds0 + (vslot) + wid * 2048))); } while (0)
#define AT_WAIT_SYNC() do { asm volatile("s_waitcnt vmcnt(0)" ::: "memory"); __syncthreads(); } while (0)
__device__ __forceinline__ void prime(const BlockRef& cur, char* lds, Seam& S, int tid) {
    const int wid = __builtin_amdgcn_readfirstlane(tid >> 6), lane = tid & 63, r32 = lane & 31, hi = lane >> 5;
    AT_LANE_CONSTS();
#pragma unroll
    for (int d0 = 0; d0 < 6; ++d0) S.qr[d0] = *(const bf16x8*)((const char*)cur.Q + (unsigned)(((wid * QBLK + r32) * QS + hi * 8) * 2) + d0 * 32);
    AT_DMA_TILE(cur, 0, 0, 0);
    S.v_prev = SHM_V; S.v_cur = 2 * SHM_V; S.v_next = 0;
}
typedef short v4i16_t __attribute__((ext_vector_type(4)));
__device__ __forceinline__ s16x4 vtr(const LAS char* p) { return __builtin_bit_cast(s16x4, __builtin_amdgcn_ds_read_tr16_b64_v4i16((LAS v4i16_t*)p)); }
#define AT_MFMA(a, b, c) __builtin_amdgcn_mfma_f32_32x32x16_bf16(a, b, c, 0, 0, 0)
#define AT_PIN(x) asm volatile("" : "+v"(x))
__device__ __forceinline__ void block(const BlockRef& cur, const BlockRef& nxt, char* lds, Seam& S, int tid) {
    const int wid = __builtin_amdgcn_readfirstlane(tid >> 6), lane = tid & 63, r32 = lane & 31, hi = lane >> 5;
    const int NT = (cur.P0 + QB - 1) / KVBLK + 1;
    const int qlo = cur.P0 + wid * QBLK, qm = qlo + r32 - 4 * hi;
    float* ws = (float*)(lds + NVS * SHM_V + NKS * SHM_K) + wid * 64; float* li_l = ws, * al_l = ws + 32;
    float mref = 0.f, l_reg = 0; f32x16 o[2] = {}; f32x16 negm = {}; AT_PIN(negm);
    AT_LANE_CONSTS();
    const LAS char* lds3 = (const LAS char*)lds;
    const LAS char* kp[4];
#pragma unroll
    for (int dd = 0; dd < 4; ++dd) kp[dd] = lds3 + NVS * SHM_V + AT_KSWZ(r32, (dd * 16 + hi * 8) * 2);
    const LAS char* vp = lds3 + v_rd_base(lane);
#define AT_KBASE(t) ((t) * KVBLK)
#define AT_MASKT(P0_, P1_, t) do { const int kb_ = AT_KBASE(t); if (kb_ + KVBLK - 1 > qlo) mask_tile(P0_, P1_, qm - kb_, WBIG); } while (0)
#define AT_KF(i, KB) (*(const LAS bf16x8*)(kp[((i) >> 1) & 3] + (KB) * SHM_K + ((i) >> 3) * 128 + ((i) & 1) * 8192))
#define AT_VRD(i, VO) do { vlo[i] = vtr(vp + (VO) + v_rd_off((i) >> 2, (i) & 3, 0)); vhi[i] = vtr(vp + (VO) + v_rd_off((i) >> 2, (i) & 3, 1)); } while (0)
#define AT_VFR(i) (bf16x8){vlo[i][0], vlo[i][1], vlo[i][2], vlo[i][3], vhi[i][0], vhi[i][1], vhi[i][2], vhi[i][3]}
#define AT_PAF(k) __builtin_bit_cast(bf16x8, pw##k)
#define AT_SWAPS(PW) do { auto r0_ = __builtin_amdgcn_permlane32_swap(a0, b0, false, false); auto r1_ = __builtin_amdgcn_permlane32_swap(a1, b1, false, false); PW = (u32x4){r0_[0], r1_[0], r0_[1], r1_[1]}; AT_PIN(PW); } while (0)
#define AT_EX4(X, B) do { X[B] = __builtin_amdgcn_exp2f(X[B]); X[B + 1] = __builtin_amdgcn_exp2f(X[B + 1]); X[B + 2] = __builtin_amdgcn_exp2f(X[B + 2]); X[B + 3] = __builtin_amdgcn_exp2f(X[B + 3]); AT_PIN(X); AT_SBAR(); } while (0)
#define AT_ROWMAX(C0, C1, rm) do { float a_ = fmaxf(fmaxf(C0[0], C0[1]), C1[0]), b_ = fmaxf(fmaxf(C0[2], C0[3]), C1[1]); a_ = fmaxf(fmaxf(a_, C1[2]), C1[3]); \
        _Pragma("unroll") for (int r = 4; r < 16; r += 4) { a_ = fmaxf(fmaxf(a_, C0[r]), C0[r + 1]); b_ = fmaxf(fmaxf(b_, C0[r + 2]), C0[r + 3]); a_ = fmaxf(fmaxf(a_, C1[r]), C1[r + 1]); b_ = fmaxf(fmaxf(b_, C1[r + 2]), C1[r + 3]); } \
        rm = fmaxf(a_, b_); { auto rr_ = __builtin_amdgcn_permlane32_swap(__float_as_uint(rm), __float_as_uint(rm), false, false); rm = fmaxf(__uint_as_float(rr_[0]), __uint_as_float(rr_[1])); } } while (0)
#define AT_PHASE_A(C0, C1, P0, P1, KB, VB) do { \
        kf[0] = AT_KF(0, KB); kf[1] = AT_KF(1, KB); kf[2] = AT_KF(2, KB); kf[3] = AT_KF(3, KB); AT_SBAR(); \
        sacc = P0[0] + P0[1]; \
        C0 = AT_MFMA(kf[0], S.qr[0], negm); kf[4] = AT_KF(4, KB); sacc += P0[2]; sacc += P0[3]; a0 = cvt_pk(P0[0], P0[1]); a1 = cvt_pk(P0[2], P0[3]); AT_PIN(a0); AT_PIN(a1); AT_PIN(sacc); AT_SBAR(); \
        C1 = AT_MFMA(kf[1], S.qr[0], negm); kf[5] = AT_KF(5, KB); sacc += P0[4]; sacc += P0[5]; sacc += P0[6]; b0 = cvt_pk(P0[4], P0[5]); b1 = cvt_pk(P0[6], P0[7]); AT_PIN(b0); AT_PIN(b1); AT_PIN(sacc); AT_SBAR(); \
        C0 = AT_MFMA(kf[2], S.qr[1], C0); kf[6] = AT_KF(6, KB); sacc += P0[7]; sacc += P0[8]; sacc += P0[9]; AT_SWAPS(pw0); AT_PIN(sacc); AT_SBAR(); \
        C1 = AT_MFMA(kf[3], S.qr[1], C1); kf[7] = AT_KF(7, KB); sacc += P0[10]; sacc += P0[11]; sacc += P0[12]; a0 = cvt_pk(P0[8], P0[9]); a1 = cvt_pk(P0[10], P0[11]); AT_PIN(a0); AT_PIN(a1); AT_PIN(sacc); AT_SBAR(); \
        C0 = AT_MFMA(kf[4], S.qr[2], C0); kf[8] = AT_KF(8, KB); sacc += P0[13]; sacc += P0[14]; sacc += P0[15]; b0 = cvt_pk(P0[12], P0[13]); b1 = cvt_pk(P0[14], P0[15]); AT_PIN(b0); AT_PIN(b1); AT_PIN(sacc); AT_SBAR(); \
        C1 = AT_MFMA(kf[5], S.qr[2], C1); kf[9] = AT_KF(9, KB); sacc += P1[0]; sacc += P1[1]; sacc += P1[2]; AT_SWAPS(pw1); AT_PIN(sacc); AT_SBAR(); \
        C0 = AT_MFMA(kf[6], S.qr[3], C0); kf[10] = AT_KF(10, KB); sacc += P1[3]; sacc += P1[4]; sacc += P1[5]; a0 = cvt_pk(P1[0], P1[1]); a1 = cvt_pk(P1[2], P1[3]); AT_PIN(a0); AT_PIN(a1); AT_PIN(sacc); AT_SBAR(); \
        C1 = AT_MFMA(kf[7], S.qr[3], C1); kf[11] = AT_KF(11, KB); sacc += P1[6]; sacc += P1[7]; sacc += P1[8]; b0 = cvt_pk(P1[4], P1[5]); b1 = cvt_pk(P1[6], P1[7]); AT_PIN(b0); AT_PIN(b1); AT_PIN(sacc); AT_SBAR(); \
        C0 = AT_MFMA(kf[8], S.qr[4], C0);  sacc += P1[9]; sacc += P1[10]; sacc += P1[11]; AT_SWAPS(pw2); AT_PIN(sacc); AT_SBAR(); \
        C1 = AT_MFMA(kf[9], S.qr[4], C1);  sacc += P1[12]; sacc += P1[13]; sacc += P1[14]; a0 = cvt_pk(P1[8], P1[9]); a1 = cvt_pk(P1[10], P1[11]); AT_PIN(a0); AT_PIN(a1); AT_PIN(sacc); AT_SBAR(); \
        C0 = AT_MFMA(kf[10], S.qr[5], C0); sacc += P1[15]; b0 = cvt_pk(P1[12], P1[13]); b1 = cvt_pk(P1[14], P1[15]); AT_PIN(b0); AT_PIN(b1); AT_PIN(sacc); AT_SBAR(); \
        C1 = AT_MFMA(kf[11], S.qr[5], C1); AT_SWAPS(pw3); AT_SBAR(); \
        l_reg += sacc; } while (0)
#define AT_DECIDE(C0, C1) do { float rm_; AT_ROWMAX(C0, C1, rm_); resc = false; \
        if (__builtin_expect(__any(rm_ > THR2), 0)) { const float dl_ = fmaxf(rm_, 0.f); mref += dl_; \
            _Pragma("unroll") for (int r = 0; r < 16; ++r) { C0[r] -= dl_; C1[r] -= dl_; } \
            _Pragma("unroll") for (int r = 0; r < 16; ++r) negm[r] = -mref; AT_PIN(negm); \
            fsc = __builtin_amdgcn_exp2f(-dl_); l_reg *= fsc; resc = true; } AT_SBAR(); } while (0)
#define AT_PHASE_B(C0, C1, VB) do { AT_VRD(0, VB); AT_VRD(4, VB); AT_SBAR(); \
        o[0] = AT_MFMA(AT_PAF(0), AT_VFR(0), o[0]); AT_VRD(1, VB); AT_EX4(C0, 0); \
        o[1] = AT_MFMA(AT_PAF(0), AT_VFR(4), o[1]); AT_VRD(5, VB); AT_EX4(C0, 4); \
        o[0] = AT_MFMA(AT_PAF(1), AT_VFR(1), o[0]); AT_VRD(2, VB); AT_EX4(C0, 8); \
        o[1] = AT_MFMA(AT_PAF(1), AT_VFR(5), o[1]); AT_VRD(6, VB); AT_EX4(C0, 12); \
        o[0] = AT_MFMA(AT_PAF(2), AT_VFR(2), o[0]); AT_VRD(3, VB); AT_EX4(C1, 0); \
        o[1] = AT_MFMA(AT_PAF(2), AT_VFR(6), o[1]); AT_VRD(7, VB); AT_EX4(C1, 4); \
        o[0] = AT_MFMA(AT_PAF(3), AT_VFR(3), o[0]); AT_EX4(C1, 8); \
        o[1] = AT_MFMA(AT_PAF(3), AT_VFR(7), o[1]); AT_EX4(C1, 12); } while (0)
#define AT_RESC() do { if (resc) { if (hi == 0) al_l[r32] = fsc; asm volatile("s_waitcnt lgkmcnt(0)" ::: "memory");              \
                     for (int d_ = 0; d_ < 2; ++d_) for (int r = 0; r < 16; ++r) o[d_][r] *= al_l[crow(r, hi)]; } } while (0)
    f32x16 pA0, pA1, pB0, pB1; bf16x8 kf[12]; s16x4 vlo[8], vhi[8]; u32x4 pw0, pw1, pw2, pw3; unsigned a0, a1, b0, b1; float sacc, fsc = 1.f; bool resc = false;
    int v_prev = S.v_prev, v_cur = S.v_cur, v_next = S.v_next;
#define AT_ROT() do { v_prev = v_cur; v_cur = v_next; v_next = (v_next == (NVS - 1) * SHM_V) ? 0 : v_next + SHM_V; } while (0)
    AT_WAIT_SYNC(); AT_ROT();
    AT_DMA_TILE(cur, AT_KBASE(1), SHM_K, v_next);
#pragma unroll
    for (int i = 0; i < 12; ++i) kf[i] = AT_KF(i, 0);
    pA0 = AT_MFMA(kf[0], S.qr[0], negm); pA1 = AT_MFMA(kf[1], S.qr[0], negm);
#pragma unroll
    for (int i = 2; i < 12; i += 2) { pA0 = AT_MFMA(kf[i], S.qr[i >> 1], pA0); pA1 = AT_MFMA(kf[i + 1], S.qr[i >> 1], pA1); }
    AT_MASKT(pA0, pA1, 0);
    { float rm_; AT_ROWMAX(pA0, pA1, rm_); mref = rm_;
#pragma unroll
      for (int r = 0; r < 16; ++r) { pA0[r] -= rm_; pA1[r] -= rm_; }
#pragma unroll
      for (int r = 0; r < 16; ++r) negm[r] = -mref;
      AT_PIN(negm);
#pragma unroll
      for (int r = 0; r < 16; ++r) { pA0[r] = __builtin_amdgcn_exp2f(pA0[r]); pA1[r] = __builtin_amdgcn_exp2f(pA1[r]); } }
    AT_WAIT_SYNC(); AT_ROT();
#define AT_STEP(C0, C1, P0, P1, t, KB) do { AT_SBAR();                                                                         \
        AT_DMA_TILE(cur, AT_KBASE((t) + 1), (1 - (KB)) * SHM_K, v_next); AT_SBAR();                                            \
        AT_PHASE_A(C0, C1, P0, P1, KB, 0);                                                                                    \
        AT_MASKT(C0, C1, (t)); AT_DECIDE(C0, C1);                                                                             \
        AT_PHASE_B(C0, C1, v_prev);                                                                                           \
        AT_RESC(); AT_WAIT_SYNC(); AT_ROT(); } while (0)
    for (int t = 1; t + 1 < NT; t += 2) {
        AT_STEP(pB0, pB1, pA0, pA1, t, 1);
        AT_STEP(pA0, pA1, pB0, pB1, t + 1, 0);
    }
    AT_SBAR();
    BlockRef nx = nxt;
    asm volatile("" : "+s"(nx.Q), "+s"(nx.KN), "+s"(nx.KR), "+s"(nx.V));
    AT_DMA_TILE(nx, 0, 0, v_next); AT_SBAR();
    AT_PHASE_A(pB0, pB1, pA0, pA1, 1, 0);
#pragma unroll
    for (int d0 = 0; d0 < 6; ++d0) S.qr[d0] = *(const bf16x8*)((const char*)nx.Q + (unsigned)(((wid * QBLK + r32) * QS + hi * 8) * 2) + d0 * 32);
    AT_SBAR();
    AT_MASKT(pB0, pB1, NT - 1); AT_DECIDE(pB0, pB1);
    AT_PHASE_B(pB0, pB1, v_prev);
    AT_RESC();
    { sacc = pB0[0] + pB0[1];
#pragma unroll
      for (int r = 2; r < 16; ++r) sacc += pB0[r];
#pragma unroll
      for (int r = 0; r < 16; ++r) sacc += pB1[r];
      l_reg += sacc;
#pragma unroll
      for (int i = 0; i < 8; ++i) AT_VRD(i, v_cur);
      a0 = cvt_pk(pB0[0], pB0[1]); a1 = cvt_pk(pB0[2], pB0[3]); b0 = cvt_pk(pB0[4], pB0[5]); b1 = cvt_pk(pB0[6], pB0[7]); AT_SWAPS(pw0);
      a0 = cvt_pk(pB0[8], pB0[9]); a1 = cvt_pk(pB0[10], pB0[11]); b0 = cvt_pk(pB0[12], pB0[13]); b1 = cvt_pk(pB0[14], pB0[15]); AT_SWAPS(pw1);
      a0 = cvt_pk(pB1[0], pB1[1]); a1 = cvt_pk(pB1[2], pB1[3]); b0 = cvt_pk(pB1[4], pB1[5]); b1 = cvt_pk(pB1[6], pB1[7]); AT_SWAPS(pw2);
      a0 = cvt_pk(pB1[8], pB1[9]); a1 = cvt_pk(pB1[10], pB1[11]); b0 = cvt_pk(pB1[12], pB1[13]); b1 = cvt_pk(pB1[14], pB1[15]); AT_SWAPS(pw3);
      o[0] = AT_MFMA(AT_PAF(0), AT_VFR(0), o[0]); o[1] = AT_MFMA(AT_PAF(0), AT_VFR(4), o[1]); o[0] = AT_MFMA(AT_PAF(1), AT_VFR(1), o[0]); o[1] = AT_MFMA(AT_PAF(1), AT_VFR(5), o[1]);
      o[0] = AT_MFMA(AT_PAF(2), AT_VFR(2), o[0]); o[1] = AT_MFMA(AT_PAF(2), AT_VFR(6), o[1]); o[0] = AT_MFMA(AT_PAF(3), AT_VFR(3), o[0]); o[1] = AT_MFMA(AT_PAF(3), AT_VFR(7), o[1]); }
    S.v_prev = v_prev; S.v_cur = v_cur; S.v_next = v_next;
    { auto rr = __builtin_amdgcn_permlane32_swap(__float_as_uint(l_reg), __float_as_uint(l_reg), false, false); l_reg = __uint_as_float(rr[0]) + __uint_as_float(rr[1]); }
    if (hi == 0) li_l[r32] = l_reg; asm volatile("s_waitcnt lgkmcnt(0)" ::: "memory");
    float rli[16];
#pragma unroll
    for (int r = 0; r < 16; ++r) rli[r] = __builtin_amdgcn_rcpf(li_l[crow(r, hi)]);
    bf16_t* Oc = cur.O; asm volatile("" : "+s"(Oc));
    bf16_t* Ow = Oc + (size_t)(wid * QBLK) * OS;
#pragma unroll
    for (int r = 0; r < 16; ++r) { const int orow = crow(r, hi);
#pragma unroll
        for (int d0 = 0; d0 < 2; ++d0) { const float v = o[d0][r] * rli[r]; const float vn = __shfl_xor(v, 1);
            if ((r32 & 1) == 0) *(unsigned*)((char*)Ow + (unsigned)((orow * OS + d0 * 32 + r32) * 2)) = cvtpk(v, vn); } }
#undef AT_RESC
#undef AT_ROT
#undef AT_KBASE
#undef AT_MASKT
#undef AT_STEP
#undef AT_PHASE_A
#undef AT_PHASE_B
#undef AT_DECIDE
#undef AT_ROWMAX
#undef AT_EX4
#undef AT_SWAPS
#undef AT_PAF
#undef AT_VFR
#undef AT_VRD
#undef AT_KF
}
__device__ __forceinline__ BlockRef make_ref(int L, int pass, const bf16_t* Q, const bf16_t* KN, const bf16_t* KR, const bf16_t* V, bf16_t* O) {
    const int bh = L >> 3, x = L & 7, b = bh >> 3, h = bh & 7, qb = pass ? 15 - x : x;
    BlockRef r; const size_t row0 = (size_t)b * S;
    r.Q = Q + (row0 + (size_t)qb * QB) * QS + h * 96; r.O = O + (row0 + (size_t)qb * QB) * OS + h * 64;
    r.KN = KN + row0 * KNS + h * 64; r.KR = KR + row0 * KRS; r.V = V + row0 * VS + h * 64; r.P0 = qb * QB;
    return r;
}
__device__ __forceinline__ void phase(char* lds, int tid, int vcu, int G, const bf16_t* Q, const bf16_t* KN, const bf16_t* KR, const bf16_t* V, bf16_t* O) {
    const int total = NB * NH * 8;
    int L = vcu; if (L >= total) return;
    if (__builtin_amdgcn_readfirstlane(tid >> 6) >= 4) __builtin_amdgcn_s_setprio(1);
    int pass = 0;
    BlockRef cur = make_ref(L, 0, Q, KN, KR, V, O);
    Seam S;
    prime(cur, lds, S, tid);
    for (;;) {
        const bool more_pass = pass == 0, more_item = L + G < total, last = !more_pass && !more_item;
        int passn = pass + 1, Ln = L;
        if (!more_pass) { passn = 0; Ln = more_item ? L + G : L; }
        const BlockRef nxt = last ? cur : make_ref(Ln, passn, Q, KN, KR, V, O);
        block(cur, nxt, lds, S, tid);
        if (last) break;
        cur = nxt; pass = passn; L = Ln;
    }
    __builtin_amdgcn_s_setprio(0);
}
#undef AT_VMW
#undef AT_VMWN
#undef AT_LANE_CONSTS
#undef AT_DMA_TILE
#undef AT_WAIT_SYNC
#undef AT_KSWZ
#undef AT_SBAR
}

__device__ __forceinline__ void moe_tables(Frame& F, int l) {
    const int tid_ = fresh_tid(F.wave);
    LAS int* base = (LAS int*)(F.lds + TAB_OFF); LAS int* cntl = (LAS int*)(F.lds + TAB_OFF + 192);
    LAS unsigned char* tile_e = (LAS unsigned char*)(F.lds + TAB_OFF + 320); LAS unsigned short* tile_r = (LAS unsigned short*)(F.lds + TAB_OFF + 896);
    __syncthreads();
    if (F.wave == 0) {
        const int lane = tid_ & 63;
        const int c = lane < NE ? (int)__hip_atomic_load(((unsigned*)F.ws) + CW_CNT + (l * NE + lane) * 64, __ATOMIC_RELAXED, __HIP_MEMORY_SCOPE_AGENT) : 0;
        const int nt = (c + 255) >> 8; int incl = nt;
#pragma unroll
        for (int o = 1; o < 32; o <<= 1) { const int v = __shfl_up(incl, o); if (lane >= o) incl += v; }
        const int excl = incl - nt;
        if (lane < NE) { base[lane] = excl * 256; cntl[lane] = c; for (int k = 0; k < nt; ++k) { tile_e[excl + k] = (unsigned char)lane; tile_r[excl + k] = (unsigned short)k; } }
        if (lane == NE - 1) { base[NE] = incl * 256; base[NE + 1] = incl; } }
    __syncthreads();
}
__device__ __forceinline__ void route_pass(Frame& F, int l, const bf16_t* X, const bool dry) {
    const int tid_ = fresh_tid(F.wave), lane_ = tid_ & 63, c16 = lane_ & 15, q = lane_ >> 4;
    LAS float* LG = (LAS float*)(F.lds + F.wave * 4096);
    const bf16_t* WH = (const bf16_t*)(F.ws + WS_WRT); const bf16_t* WL = WH + 48 * 1024;
    const float* bg = F.in[18] + l * 4; const float* be = F.in[20] + l * NE; const float* gain = F.in[16] + l * D;
    unsigned* rec = (unsigned*)(F.ws + WS_REC); unsigned* list = (unsigned*)(F.ws + WS_LIST); float* rl = (float*)(F.ws + WS_RL);
    const int gw_ = (int)blockIdx.x * NWAVES + F.wave, ngw_ = F.G * NWAVES;
    for (int tile0 = gw_; tile0 < T / 16; tile0 += 2 * ngw_) {
        const int tile1 = tile0 + ngw_; const bool has1 = tile1 < T / 16;
        const int rowA = tile0 * 16 + c16, rowB = (has1 ? tile1 : tile0) * 16 + c16;
        const bf16_t* xa = X + (size_t)rowA * D + 8 * q; const bf16_t* xb = X + (size_t)rowB * D + 8 * q; const float* gr = gain + 8 * q;
        const bf16_t* wh = WH + (size_t)c16 * 1024 + 8 * q; const bf16_t* wl = WL + (size_t)c16 * 1024 + 8 * q;
        f32x4 accA[3], accB[3]; accA[0] = (f32x4){0.f, 0.f, 0.f, 0.f}; accA[1] = accA[0]; accA[2] = accA[0]; accB[0] = accA[0]; accB[1] = accA[0]; accB[2] = accA[0]; float ssA = 0.f, ssB = 0.f;
#pragma unroll 4
        for (int ks = 0; ks < 32; ++ks) {
            const u32x4 xwa = *(const u32x4*)(xa + 32 * ks), xwb = *(const u32x4*)(xb + 32 * ks);
            const f32x4 g0 = *(const f32x4*)(gr + 32 * ks), g1 = *(const f32x4*)(gr + 32 * ks + 4);
            bf16x8 Bh[3], Bl[3];
#pragma unroll
            for (int nt = 0; nt < 3; ++nt) { Bh[nt] = *(const bf16x8*)(wh + (size_t)nt * 16 * 1024 + 32 * ks); Bl[nt] = *(const bf16x8*)(wl + (size_t)nt * 16 * 1024 + 32 * ks); }
#pragma unroll
            for (int h = 0; h < 2; ++h) { const u32x4 xw = h ? xwb : xwa;
                const f32x4 x0 = (f32x4){lo16(xw.x), hi16(xw.x), lo16(xw.y), hi16(xw.y)}, x1 = (f32x4){lo16(xw.z), hi16(xw.z), lo16(xw.w), hi16(xw.w)};
                if (h) ssB += dot8(x0, x1); else ssA += dot8(x0, x1);
                const f32x4 h0 = x0 * g0, h1 = x1 * g1;
                const u32x4 ph = pack8(h0, h1);
                const f32x4 r0 = h0 - (f32x4){lo16(ph.x), hi16(ph.x), lo16(ph.y), hi16(ph.y)}, r1 = h1 - (f32x4){lo16(ph.z), hi16(ph.z), lo16(ph.w), hi16(ph.w)};
                const u32x4 pl = pack8(r0, r1);
                const bf16x8 Ah = __builtin_bit_cast(bf16x8, ph), Al = __builtin_bit_cast(bf16x8, pl);
#pragma unroll
                for (int nt = 0; nt < 3; ++nt) { f32x4 a_ = h ? accB[nt] : accA[nt];
                    a_ = __builtin_amdgcn_mfma_f32_16x16x32_bf16(Ah, Bh[nt], a_, 0, 0, 0);
                    a_ = __builtin_amdgcn_mfma_f32_16x16x32_bf16(Ah, Bl[nt], a_, 0, 0, 0);
                    a_ = __builtin_amdgcn_mfma_f32_16x16x32_bf16(Al, Bh[nt], a_, 0, 0, 0);
                    if (h) accB[nt] = a_; else accA[nt] = a_; } } }
        auto finish = [&](const f32x4 (&acc)[3], float ss, const int row) {
        ss += __shfl_xor(ss, 16); ss += __shfl_xor(ss, 32);
        const float rstd = rsqrtf(ss * (1.f / D) + EPS);
#pragma unroll
        for (int nt = 0; nt < 3; ++nt)
#pragma unroll
            for (int r = 0; r < 4; ++r) LG[(4 * q + r) * 48 + 16 * nt + c16] = acc[nt][r];
        LDS_WAIT(); asm volatile("" ::: "memory");
        if (lane_ < 16 && !dry) {
            const LAS float* lr = LG + lane_ * 48;
            float lg[4], le[32];
#pragma unroll
            for (int n = 0; n < 4; ++n) lg[n] = lr[n] * rstd + bg[n];
#pragma unroll
            for (int n = 0; n < 32; ++n) le[n] = lr[4 + n] * rstd + be[n];
            int gi = 0; float gm = lg[0];
#pragma unroll
            for (int n = 1; n < 4; ++n) if (lg[n] > gm) { gm = lg[n]; gi = n; }
            float gs = 0.f;
#pragma unroll
            for (int n = 0; n < 4; ++n) gs += __expf(lg[n] - gm);
            const float gp = 1.f / gs;
            float es[8];
#pragma unroll
            for (int j = 0; j < 8; ++j) es[j] = gi == 0 ? le[j] : (gi == 1 ? le[8 + j] : (gi == 2 ? le[16 + j] : le[24 + j]));
            int i0 = 0; float m0 = es[0];
#pragma unroll
            for (int j = 1; j < 8; ++j) if (es[j] > m0) { m0 = es[j]; i0 = j; }
            int i1 = -1; float m1 = -3.0e38f;
#pragma unroll
            for (int j = 0; j < 8; ++j) if (j != i0 && es[j] > m1) { m1 = es[j]; i1 = j; }
            const float p1 = __expf(m1 - m0);
            const float w0 = gp / (1.f + p1), w1 = gp * p1 / (1.f + p1);
            const int e0 = gi * 8 + i0, e1 = gi * 8 + i1;
            const unsigned pos0 = __hip_atomic_fetch_add(((unsigned*)F.ws) + CW_CNT + (l * NE + e0) * 64, 1u, __ATOMIC_RELAXED, __HIP_MEMORY_SCOPE_AGENT);
            const unsigned pos1 = __hip_atomic_fetch_add(((unsigned*)F.ws) + CW_CNT + (l * NE + e1) * 64, 1u, __ATOMIC_RELAXED, __HIP_MEMORY_SCOPE_AGENT);
            u32x4 r0 = {(unsigned)e0, pos0, (unsigned)e1, pos1}, r1 = {__float_as_uint(w0), __float_as_uint(w1), __float_as_uint(rstd), 0u};
            *(u32x4*)(rec + (size_t)row * 8) = r0; *(u32x4*)(rec + (size_t)row * 8 + 4) = r1;
            list[(size_t)e0 * T + pos0] = (unsigned)row; rl[(size_t)e0 * T + pos0] = rstd; list[(size_t)e1 * T + pos1] = (unsigned)row; rl[(size_t)e1 * T + pos1] = rstd;
        }
        LDS_WAIT(); asm volatile("" ::: "memory");
        };
        finish(accA, ssA, rowA);
        if (has1) finish(accB, ssB, rowB);
    }
}
__device__ __forceinline__ void prep_small(Frame& F, int l) {
    const int tid_ = fresh_tid(F.wave); const int gt = blockIdx.x * NTHREADS + tid_, nt = F.G * NTHREADS;
    const float* wsrc = F.in[9] + (size_t)l * 4 * 128 * 128; bf16_t* WSG = (bf16_t*)(F.ws + WS_WSG);
    for (int idx = gt; idx < 4 * 128 * 128; idx += nt) { const int t = (idx >> 7) & 127, sidx = idx & 127; WSG[idx] = (bf16_t)f2bf(sidx <= t ? wsrc[idx] : 0.f); }
    const float* wg = F.in[17] + (size_t)l * D * 4; const float* we = F.in[19] + (size_t)l * D * NE; bf16_t* WH = (bf16_t*)(F.ws + WS_WRT); bf16_t* WL = WH + 48 * 1024;
    for (int idx = gt; idx < 48 * 1024; idx += nt) { const int n = idx >> 10, k = idx & 1023;
        const float v = n < 4 ? wg[k * 4 + n] : (n < 36 ? we[k * NE + (n - 4)] : 0.f);
        const unsigned h = f2bf(v); WH[idx] = (bf16_t)h; WL[idx] = (bf16_t)f2bf(v - bf2f(h)); }
}
__device__ __forceinline__ void combine_pass(Frame& F, const bf16_t* Xin, float* RS, float* OUT, const float* gain, bf16_t* H, unsigned char* H8, bool final_out) {
    const int tid_ = fresh_tid(F.wave), lane_ = tid_ & 63; (void)lane_;
    const LAS int* base = (const LAS int*)(F.lds + TAB_OFF); const unsigned* rec = (const unsigned*)(F.ws + WS_REC); const unsigned char* YB = F.ws + WS_YB;
    constexpr int RB = 8;
    f32x4 g[4];
#pragma unroll
    for (int j = 0; j < 4; ++j) g[j] = ((const f32x4*)gain)[lane_ + 64 * j];
    for (int m0 = ((int)blockIdx.x * NWAVES + F.wave); m0 < T; m0 += RB * (F.G * NWAVES)) {
        u32x4 r0[RB], r1[RB]; u32x2 xv[RB][4]; unsigned ya[RB][4], yb[RB][4];
#pragma unroll
        for (int r = 0; r < RB; ++r) { const int m = m0 + r * (F.G * NWAVES); if (m < T) { r0[r] = *(const u32x4*)(rec + (size_t)m * 8); r1[r] = *(const u32x4*)(rec + (size_t)m * 8 + 4); } }
#pragma unroll
        for (int r = 0; r < RB; ++r) { const int m = m0 + r * (F.G * NWAVES); if (m < T) {
            const size_t s0 = (size_t)base[r0[r].x] + r0[r].y, s1 = (size_t)base[r0[r].z] + r0[r].w;
            const u32x2* xr = (const u32x2*)(Xin + (size_t)m * D) + lane_;
            const unsigned* y0 = (const unsigned*)(YB + s0 * D) + lane_; const unsigned* y1 = (const unsigned*)(YB + s1 * D) + lane_;
#pragma unroll
            for (int j = 0; j < 4; ++j) { xv[r][j] = xr[64 * j]; ya[r][j] = y0[64 * j]; yb[r][j] = y1[64 * j]; } } }
#pragma unroll
        for (int r = 0; r < RB; ++r) { const int m = m0 + r * (F.G * NWAVES); if (m < T) {
            const float w0 = __uint_as_float(r1[r].x), w1 = __uint_as_float(r1[r].y); float ss = 0.f; f32x4 v[4];
#pragma unroll
            for (int j = 0; j < 4; ++j) { const u32x2 x_ = xv[r][j];
                const f32x2 a0 = __builtin_amdgcn_cvt_pk_f32_fp8((int)ya[r][j], false), a1 = __builtin_amdgcn_cvt_pk_f32_fp8((int)ya[r][j], true), b0 = __builtin_amdgcn_cvt_pk_f32_fp8((int)yb[r][j], false), b1 = __builtin_amdgcn_cvt_pk_f32_fp8((int)yb[r][j], true);
                v[j].x = lo16(x_.x) + w0 * a0[0] + w1 * b0[0]; v[j].y = hi16(x_.x) + w0 * a0[1] + w1 * b0[1]; v[j].z = lo16(x_.y) + w0 * a1[0] + w1 * b1[0]; v[j].w = hi16(x_.y) + w0 * a1[1] + w1 * b1[1];
                ss += (v[j].x * v[j].x + v[j].y * v[j].y) + (v[j].z * v[j].z + v[j].w * v[j].w); }
            const float ms = wave_sum(ss) * (1.f / D) + EPS, rstd = rsqrtf(ms);
            if (final_out) { f32x4* o = (f32x4*)(OUT + (size_t)m * D) + lane_;
#pragma unroll
                for (int j = 0; j < 4; ++j) o[64 * j] = (f32x4){v[j].x * rstd * g[j].x, v[j].y * rstd * g[j].y, v[j].z * rstd * g[j].z, v[j].w * rstd * g[j].w};
            } else {
                u32x2* o = (u32x2*)(H + (size_t)m * D) + lane_; if (lane_ == 0) RS[m] = ms * rstd;
#pragma unroll
                for (int j = 0; j < 4; ++j) { u32x2 w;
                    w.x = cvt_pk(v[j].x * rstd * g[j].x, v[j].y * rstd * g[j].y); w.y = cvt_pk(v[j].z * rstd * g[j].z, v[j].w * rstd * g[j].w); o[64 * j] = w; }
                unsigned* o8 = (unsigned*)(H8 + (size_t)m * D) + lane_;
#pragma unroll
                for (int j = 0; j < 4; ++j) o8[64 * j] = pk4f8(v[j].x * rstd * g[j].x, v[j].y * rstd * g[j].y, v[j].z * rstd * g[j].z, v[j].w * rstd * g[j].w);
            } } }
    }
}
template <int KK, int NperE, bool FP8 = false, class Fn>
__device__ __forceinline__ void gemm_moe(Frame& F, const bf16_t* A, const bf16_t* Bt, const Fn& f) {
    const LAS int* base = (const LAS int*)(F.lds + TAB_OFF);
    pg8::Gemm g{A, Bt}; pg8::MoeOrder So{(const LAS unsigned char*)(F.lds + TAB_OFF + 320), base[NE + 1], NperE / 256, F.G, (int)blockIdx.x};
    pg8::Epi8<Fn> E{f};
    pg8::gemm_phase<pg8::Epi8<Fn>, pg8::MoeOrder, KK, KK, KK, true, false, FP8>(F.lds, F.wave, g, So, E);
}

constexpr int PH_PER_LAYER = 9, N_PHASES = 1 + DEPTH * PH_PER_LAYER;
struct Args { const float* in[24]; float* out; unsigned char* ws; int ph_lo, ph_hi; };
#ifndef PHSEL
#define PHSEL -1
#endif
#ifndef REPEAT_MASK
#define REPEAT_MASK 0
#endif
#define REP(k) for (int rep_ = 0; rep_ < 1 + ((REPEAT_MASK >> (k)) & 1); ++rep_)
#define PHOK(j) (PHSEL < 0 || PHSEL == (j))
#define IN(k) (lo <= (k) && (k) < hi)
#define SEAM(k) do { if (IN(k) && IN((k) + 1)) xcd_barrier(bar, fresh_tid(F.wave) == 0); } while (0)
template <int l>
__device__ __forceinline__ void layer_body(Frame& F, const XcdBarrier& bar, const int lo, const int hi) {
    unsigned char* ws = F.ws; unsigned char* wt = ws + WS_WT;
    bf16_t* H = (bf16_t*)(ws + WS_H);
    constexpr int pb = 1 + l * PH_PER_LAYER;
    bf16_t* XS = (bf16_t*)F.out;
    bf16_t* xnew = (l + 1 < DEPTH) ? XS : (bf16_t*)(ws + WS_X1);
    if (PHOK(1) && IN(pb + 0)) {
        { EpiP1<true> E{(bf16_t*)(ws + WS_T0), (bf16_t*)(ws + WS_SGU), (bf16_t*)(ws + WS_GV), (bf16_t*)(ws + WS_CB), (bf16_t*)(ws + WS_Z), (float*)(ws + WS_ST0), (float*)(ws + WS_STV)};
          REP(0) gemm_dense<D / 2, D / 2, N_F8A, D / 2, true>(F, (const bf16_t*)(ws + WS_H8), (const bf16_t*)(wt + WT_WT8), E); }
        { EpiP1<false> E{(bf16_t*)(ws + WS_T0), (bf16_t*)(ws + WS_SGU), (bf16_t*)(ws + WS_GV), (bf16_t*)(ws + WS_CB), (bf16_t*)(ws + WS_Z), (float*)(ws + WS_ST0), (float*)(ws + WS_STV)};
          REP(0) gemm_dense<D, D, N_P1 - N_F8A, D>(F, H, (const bf16_t*)(wt + WT_WIN) + (size_t)N_F8A * D, E); } }
    SEAM(pb + 0);
    if (PHOK(2) && IN(pb + 1)) {
        const bool pass_first = (((int)blockIdx.x >> 3) & 1) != 0;
        if (pass_first) { sgmix_pass(F, l, (bf16_t*)(ws + WS_SGU)); conv_pass(F, l, (bf16_t*)(ws + WS_CB)); krope_pass(F); asm volatile("s_waitcnt vmcnt(0)" ::: "memory"); __syncthreads(); }
        { pg8::Epi8L<FnQ8, 2> E{{(bf16_t*)(ws + WS_Q), (const float*)(ws + WS_ST0), (const float*)(ws + WS_ROPE)}};
          REP(1) gemm_dense<T0W / 2, WQ8_LD / 2, 768, WQ8_LD / 2, true>(F, (const bf16_t*)(ws + WS_T0 + 256), (const bf16_t*)(wt + WT_WQ), E); }
        { pg8::Epi8A<FnKV8> E{{(bf16_t*)(ws + WS_KN), (bf16_t*)(ws + WS_V), (const float*)(ws + WS_ST0)}};
          REP(1) gemm_dense<T0W / 2, KVR / 2, 1024, KVR / 2, true>(F, (const bf16_t*)(ws + WS_T0), (const bf16_t*)(wt + WT_WKV), E); }
        if ((REPEAT_MASK >> 12) & 1) sgmix_pass(F, l, (bf16_t*)(ws + WS_GB)); if ((REPEAT_MASK >> 13) & 1) conv_pass(F, l, (bf16_t*)(ws + WS_GB));
        if (!pass_first) { sgmix_pass(F, l, (bf16_t*)(ws + WS_SGU)); conv_pass(F, l, (bf16_t*)(ws + WS_CB)); REP(11) krope_pass(F); }
    }
    SEAM(pb + 1);
    if (PHOK(3) && IN(pb + 2)) {
        const bool attn_first = (((int)blockIdx.x >> 3) & 1) != 0;
        const int vcu = (F.G % 8 == 0) ? ((int)blockIdx.x % 8) * (F.G / 8) + (int)blockIdx.x / 8 : (int)blockIdx.x;
        if (attn_first) { REP(3) att::phase((char*)F.lds_generic, fresh_tid(F.wave), vcu, F.G, (const bf16_t*)(ws + WS_Q), (const bf16_t*)(ws + WS_KN), (const bf16_t*)(ws + WS_KR), (const bf16_t*)(ws + WS_V), (bf16_t*)(ws + WS_O));
            asm volatile("s_waitcnt vmcnt(0)" ::: "memory"); __syncthreads(); }
        { pg8::Epi8<FnGates8> E{{ws}};
          REP(2) gemm_dense<D / 2, D / 2, N_GATES, D / 2, true>(F, (const bf16_t*)(ws + WS_H8), (const bf16_t*)(wt + WT_WG8), E); }
        if (!attn_first) { REP(3) att::phase((char*)F.lds_generic, fresh_tid(F.wave), vcu, F.G, (const bf16_t*)(ws + WS_Q), (const bf16_t*)(ws + WS_KN), (const bf16_t*)(ws + WS_KR), (const bf16_t*)(ws + WS_V), (bf16_t*)(ws + WS_O)); }
    }
    SEAM(pb + 2);
    if (PHOK(4) && IN(pb + 3)) {
        REP(4) {
        pg8::Gemm g{(const bf16_t*)ws, (const bf16_t*)ws};
        constexpr size_t TS = (size_t)256 * 512 * 2;
        static_assert(WS_SGU % TS == 0 && WS_CB % TS == 0 && WS_O % TS == 0 && (WS_WT + WT_WA) % TS == 0 && (WS_WT + WT_WB) % TS == 0 && (WS_WT + WT_WC) % TS == 0, "branch buffers must sit on 256 KiB boundaries");
        pg8::ChainOrder So; So.so.init(T, D, F.G, (int)blockIdx.x);
        EpiChain E{(bf16_t*)(ws + WS_MRG), ws};
        pg8::gemm_phase<EpiChain, pg8::ChainOrder, 512, 512, 512>(F.lds, F.wave, g, So, E);
        }
    }
    SEAM(pb + 3);
    if (PHOK(5) && IN(pb + 4)) {
        EpiResH E{H, (const float*)(ws + WS_RS), F.in[2] + l * D, xnew, ws + WS_XB};
        REP(5) gemm_dense<D, D, D, D>(F, (const bf16_t*)(ws + WS_MRG), (const bf16_t*)(wt + WT_WO), E); }
    SEAM(pb + 4);
    if (PHOK(6) && IN(pb + 5)) { REP(8) convert_moe_weights(F, l); if ((REPEAT_MASK >> 10) & 1) route_pass(F, l, xnew, true); route_pass(F, l, xnew, false); }
    SEAM(pb + 5);
    if (PHOK(7) && IN(pb + 6)) { moe_tables(F, l);
        const LAS int* base = (const LAS int*)(F.lds + TAB_OFF);
        pg8::Gemm g{(const bf16_t*)(ws + WS_XB), (const bf16_t*)(ws + WS_WGU)};
        pg8::MoeGatherOrder So{(const LAS unsigned char*)(F.lds + TAB_OFF + 320), (const LAS unsigned short*)(F.lds + TAB_OFF + 896), (const LAS int*)(F.lds + TAB_OFF + 192), (const unsigned*)(ws + WS_LIST), base[NE + 1], 2, F.G, (int)blockIdx.x};
        pg8::Epi8A<FnMoe1G> E{{(bf16_t*)(ws + WS_ACT), (const float*)(ws + WS_RL)}};
        REP(6) pg8::gemm_phase<pg8::Epi8A<FnMoe1G>, pg8::MoeGatherOrder, D / 2, D / 2, D / 2, true, true, true>(F.lds, F.wave, g, So, E); }
    SEAM(pb + 6);
    if (PHOK(8) && IN(pb + 7)) { moe_tables(F, l); FnMoe2_8 f{ws + WS_YB}; REP(7) gemm_moe<DE / 2, D, true>(F, (const bf16_t*)(ws + WS_ACT), (const bf16_t*)(ws + WS_WD), f);
        if (l + 1 < DEPTH) { convert_mixer_weights(F, l + 1); prep_small(F, l + 1); } }
    SEAM(pb + 7);
    if (PHOK(9) && IN(pb + 8)) { moe_tables(F, l);
        if (l + 1 < DEPTH) combine_pass(F, xnew, (float*)(ws + WS_RS), nullptr, F.in[2] + (l + 1) * D, H, ws + WS_H8, false); else combine_pass(F, xnew, nullptr, F.out, F.in[23], H, ws + WS_H8, true); }
    SEAM(pb + 8);
}
__global__ void __launch_bounds__(NTHREADS, 2) fwd(Args args) {
    extern __shared__ __attribute__((aligned(16))) unsigned char lds_raw[];
    Frame F;
    F.lds = (LAS unsigned char*)lds_raw; F.lds_generic = lds_raw; F.ws = args.ws;
    F.wave = __builtin_amdgcn_readfirstlane((int)threadIdx.x >> 6); F.G = gridDim.x;
    F.in = args.in;
    F.out = args.out;
    volatile LAS unsigned* MISC = (volatile LAS unsigned*)(F.lds + MISC_OFF);
    if (threadIdx.x < 32) MISC[threadIdx.x] = 0u;
    __syncthreads();
    XcdBarrier bar; bar.bar = ((unsigned*)F.ws) + CW_BAR; bar.x = 0; bar.st = nullptr;
    const int lo = args.ph_lo, hi = args.ph_hi;
    if (hi - lo > 1) bar = xcd_barrier_post(((unsigned*)F.ws) + CW_BAR, MISC + 8);
    if (PHOK(0) && IN(0)) REP(9) { convert_mixer_weights(F, 0); prep_small(F, 0); rope_table(F); norm_rows_bf16(F, F.in[0], F.in[2], (bf16_t*)(F.ws + WS_H), F.ws + WS_H8, (float*)(F.ws + WS_RS)); }
    SEAM(0);
    layer_body<0>(F, bar, lo, hi);
    layer_body<1>(F, bar, lo, hi);
}
#undef IN
#undef SEAM

extern "C" void kernel_launch(void* const* d_in, const int* in_sizes, int n_in, void* d_out, int out_size, void* d_ws, size_t ws_size, hipStream_t stream) {
    static int grid = 0;
    if (grid == 0) {
        if (n_in != 24 || out_size != T * D || ws_size < WS_END) { fprintf(stderr, "kernel_launch: unexpected shapes (n_in %d, out %d, ws %zu)\n", n_in, out_size, ws_size); grid = -1; return; }
        int dev = 0, cus = 0;
        if (hipGetDevice(&dev) != hipSuccess || hipDeviceGetAttribute(&cus, hipDeviceAttributeMultiprocessorCount, dev) != hipSuccess) { grid = -1; return; }
        if (hipFuncSetAttribute((const void*)fwd, hipFuncAttributeMaxDynamicSharedMemorySize, LDS_BYTES) != hipSuccess) { fprintf(stderr, "kernel_launch: hipFuncSetAttribute failed\n"); grid = -1; return; }
        int per_cu = 0;
        if (hipOccupancyMaxActiveBlocksPerMultiprocessor(&per_cu, (const void*)fwd, NTHREADS, LDS_BYTES) != hipSuccess || per_cu < 1) fprintf(stderr, "kernel_launch: occupancy query says %d\n", per_cu);
        (void)hipGetLastError();
        grid = cus;
    }
    if (grid < 0) return;
    (void)hipMemsetAsync((char*)d_ws + WS_CTL, 0, CTL_ZERO_BYTES, stream);
    Args a{};
    for (int i = 0; i < 24; ++i) a.in[i] = (const float*)d_in[i];
    a.out = (float*)d_out; a.ws = (unsigned char*)d_ws;
#if MK_ONE_LAUNCH
    a.ph_lo = 0; a.ph_hi = N_PHASES;
    hipLaunchKernelGGL(fwd, dim3(grid), dim3(NTHREADS), LDS_BYTES, stream, a);
#else
    for (int p = 0; p < N_PHASES; ++p) { a.ph_lo = p; a.ph_hi = p + 1; hipLaunchKernelGGL(fwd, dim3(grid), dim3(NTHREADS), LDS_BYTES, stream, a); }
#endif
}
```

```cpp
#include <hip/hip_runtime.h>
#include <cstdio>
#include <cstdint>

#ifndef MK_ONE_LAUNCH
#define MK_ONE_LAUNCH 1
#endif
#ifndef FAST_ATTN
#define FAST_ATTN 1
#endif

#define GAS __attribute__((address_space(1)))
#define LAS __attribute__((address_space(3)))
typedef unsigned short bf16_t;
typedef short bf16x8 __attribute__((ext_vector_type(8)));
typedef float f32x4 __attribute__((ext_vector_type(4)));
typedef float f32x2 __attribute__((ext_vector_type(2)));
typedef unsigned u32x4 __attribute__((ext_vector_type(4)));
typedef unsigned u32x2 __attribute__((ext_vector_type(2)));

constexpr int D = 1024, NB = 16, S = 4096, T = NB * S, DEPTH = 2;
constexpr int NH = 8, NOPE = 64, ROPE = 32, QKH = 96, VH = 64, QR = 384, KVR = 256;
constexpr int SGW = 512, CW = 512, DIN = 6304, NE = 32, DE = 256;
constexpr float EPS = 1e-6f;
constexpr int C_CQ = 0, C_CKV = 384, C_KR = 640, C_SGU = 672, C_SGV = 1184, C_CB = 1696, C_CC = 2208, C_CH = 2720, C_GA = 3232, C_GB = 4256, C_GC = 5280;
constexpr int N_P1 = 3328, N_GATES = 3072, N_WIN = N_P1 + N_GATES;
constexpr int T0W = 768;
constexpr int N_F8A = 1280;
constexpr int WQ8_LD = 512;

constexpr size_t MiB = 1u << 20;
constexpr size_t WS_CTL = 0, CTL_ZERO_BYTES = 1 * MiB;
constexpr size_t WS_WSG = 1 * MiB;
constexpr size_t WS_WRT = 1 * MiB + 128 * 1024;
constexpr size_t WS_ROPE = 2 * MiB;
constexpr size_t WS_WT = 10 * MiB;
constexpr size_t WT_WIN = 0, WT_WQ = 13 * MiB, WT_WKV = 14 * MiB, WT_WA = 15 * MiB, WT_WB = 16 * MiB, WT_WC = 17 * MiB, WT_WO = 18 * MiB;
constexpr size_t WS_REC = 30 * MiB;
constexpr size_t WS_H = 32 * MiB;
constexpr size_t WS_T0 = 160 * MiB;
constexpr size_t WS_GV = 256 * MiB;
constexpr size_t WS_Z = 320 * MiB;
constexpr size_t WS_SGU = 384 * MiB;
constexpr size_t WS_CB = 448 * MiB;
constexpr size_t WS_KN = 512 * MiB;
constexpr size_t WS_V = 576 * MiB;
constexpr size_t WS_GB = 640 * MiB;
constexpr size_t WS_GC = 768 * MiB;
constexpr size_t WS_Q = 896 * MiB;
constexpr size_t WS_KR = 992 * MiB;
constexpr size_t WS_ST0 = 996 * MiB;
constexpr size_t WS_STV = 1000 * MiB;
constexpr size_t WS_RS = 1002 * MiB;
constexpr size_t WS_END = 1003 * MiB;
constexpr size_t WS_GA = WS_T0, WS_O = WS_Z, WS_MRG = WS_KN;
constexpr size_t WS_H8 = 704 * MiB;
constexpr size_t WT_WT8 = 10 * MiB + 512 * 1024;
constexpr size_t WT_WG8 = 7 * MiB;
constexpr float W8_SCALE = 32.f;
constexpr size_t WS_WGU = 32 * MiB, WS_WD = 64 * MiB, WS_ACT = 80 * MiB;
constexpr size_t WS_XB = 160 * MiB, WS_YB = 432 * MiB;
constexpr size_t WS_X1 = 832 * MiB;
constexpr size_t WS_LIST = 288 * MiB, WS_RL = 296 * MiB;
constexpr int MAX_TILES = 544;
constexpr int CW_TMO = 0, CW_BAR = 4096, CW_CNT = 8192;

#define LDS_WAIT() asm volatile("s_waitcnt lgkmcnt(0)" ::: "memory")
#define VM_WAIT() asm volatile("s_waitcnt vmcnt(0)" ::: "memory")
__device__ __forceinline__ float bf2f(unsigned v) { return __uint_as_float(v << 16); }
__device__ __forceinline__ unsigned f2bf(float f) { unsigned u = __float_as_uint(f); return (u + 0x7fffu + ((u >> 16) & 1u)) >> 16; }
__device__ __forceinline__ unsigned pk2(float lo, float hi) { return f2bf(lo) | (f2bf(hi) << 16); }
__device__ __forceinline__ float lo16(unsigned w) { return __uint_as_float(w << 16); }
__device__ __forceinline__ float hi16(unsigned w) { return __uint_as_float(w & 0xffff0000u); }
__device__ __forceinline__ float wave_sum(float v) {
#pragma unroll
    for (int o = 1; o < 64; o <<= 1) v += __shfl_xor(v, o);
    return v;
}
__device__ __forceinline__ float sigmoidf_(float x) { return 1.f / (1.f + __expf(-x)); }
__device__ __forceinline__ float gelu_tanh(float x) { const float u = 0.7978845608028654f * (x + 0.044715f * x * x * x); return x / (1.f + __expf(-2.f * u)); }
__device__ __forceinline__ float siluf_(float x) { return x / (1.f + __expf(-x)); }
typedef __bf16 bf16x2_t __attribute__((ext_vector_type(2)));
__device__ __forceinline__ unsigned cvt_pk(float lo, float hi) { const f32x2 v = {lo, hi}; const bf16x2_t b = __builtin_convertvector(v, bf16x2_t); return __builtin_bit_cast(unsigned, b); }
__device__ __forceinline__ unsigned pk4f8(float a, float b, float c, float d) { int w = 0; w = __builtin_amdgcn_cvt_pk_fp8_f32(a, b, w, false); w = __builtin_amdgcn_cvt_pk_fp8_f32(c, d, w, true); return (unsigned)w; }
__device__ __forceinline__ u32x4 pack8(const f32x4 a, const f32x4 b) { u32x4 w; w.x = cvt_pk(a[0], a[1]); w.y = cvt_pk(a[2], a[3]); w.z = cvt_pk(b[0], b[1]); w.w = cvt_pk(b[2], b[3]); return w; }
__device__ __forceinline__ float fsigmoid(float x) { return __builtin_amdgcn_rcpf(1.f + __builtin_amdgcn_exp2f(-1.4426950408889634f * x)); }
__device__ __forceinline__ float fgelu(float x) { const float t = x * x; return x * __builtin_amdgcn_rcpf(1.f + __builtin_amdgcn_exp2f(x * (-2.302208198f + -0.102943240f * t))); }
__device__ __forceinline__ f32x4 fgelu4(const f32x4 v) { return (f32x4){fgelu(v[0]), fgelu(v[1]), fgelu(v[2]), fgelu(v[3])}; }
__device__ __forceinline__ float dot8(const f32x4 a, const f32x4 b) { return ((a[0] * a[0] + a[1] * a[1]) + (a[2] * a[2] + a[3] * a[3])) + ((b[0] * b[0] + b[1] * b[1]) + (b[2] * b[2] + b[3] * b[3])); }

#define XB_TMO      128
#define XB_XCNT(j)  (256  + 64 * (j))
#define XB_XSUB(j)  (1280 + 64 * (j))
#define XB_XGEN(j)  (2304 + 64 * (j))
#define XB_TOP      3328
#define XB_TOPGEN   3392
#define XCD_BAR_WORDS 3456
#define XB_SPIN_CAP (1u << 18)
__device__ __forceinline__ unsigned xb_ld(unsigned* p)              { return __hip_atomic_load(p, __ATOMIC_RELAXED, __HIP_MEMORY_SCOPE_AGENT); }
__device__ __forceinline__ unsigned xb_add(unsigned* p, unsigned v) { return __hip_atomic_fetch_add(p, v, __ATOMIC_RELAXED, __HIP_MEMORY_SCOPE_AGENT); }
__device__ __forceinline__ unsigned xb_xcc_id() { return (unsigned)__builtin_amdgcn_s_getreg((3 << 11) | 20) & 0xFu; }
#define XB_SPIN(cond, bar) do { unsigned _sp = 0; while (cond) { __builtin_amdgcn_s_sleep(1); \
    if ((++_sp & 255u) == 0u) { if (xb_ld(&(bar)[XB_TMO])) break; if (_sp > XB_SPIN_CAP) { atomicAdd(&(bar)[XB_TMO], 1u); break; } } } } while (0)
struct XcdBarrier { unsigned* bar; unsigned x; volatile LAS unsigned* st; };
__device__ __forceinline__ XcdBarrier xcd_barrier_post(unsigned* bar, volatile LAS unsigned* st) {
    XcdBarrier b; b.bar = bar; b.x = xb_xcc_id(); b.st = st;
    if (threadIdx.x == 0) (void)xb_add(&bar[XB_XCNT(b.x)], 1u);
    return b;
}
__device__ __forceinline__ void xcd_barrier_complete(unsigned* bar, unsigned x, unsigned& nloc, unsigned& nx) {
    const unsigned G = gridDim.x * gridDim.y * gridDim.z;
    unsigned sum, cnt, mine, sp = 0u;
    for (;;) {
        sum = 0u; cnt = 0u; mine = 0u;
#pragma unroll
        for (unsigned j = 0; j < 16; ++j) { const unsigned c = xb_ld(&bar[XB_XCNT(j)]); sum += c; cnt += (c > 0u) ? 1u : 0u; mine = (j == x) ? c : mine; }
        if (sum == G) break;
        __builtin_amdgcn_s_sleep(1);
        if ((++sp & 255u) == 0u) { if (xb_ld(&bar[XB_TMO])) break; if (sp > XB_SPIN_CAP) { atomicAdd(&bar[XB_TMO], 1u); break; } }
    }
    nloc = mine > 0u ? mine : 1u; nx = cnt > 0u ? cnt : 1u;
}
__device__ __forceinline__ void xcd_barrier(const XcdBarrier& b, const bool is_t0) {
    asm volatile("s_waitcnt vmcnt(0)" ::: "memory");
    __syncthreads();
    if (is_t0) {
        unsigned* bar = b.bar;
        __builtin_amdgcn_s_waitcnt(0);
        unsigned nloc = b.st[0], nx = b.st[1];
        if (nloc == 0u) { xcd_barrier_complete(bar, b.x, nloc, nx); b.st[0] = nloc; b.st[1] = nx; }
        const unsigned old = xb_add(&bar[XB_XSUB(b.x)], 1u);
        const unsigned gen = old / nloc;
        if (old + 1u == (gen + 1u) * nloc) {
            __builtin_amdgcn_fence(__ATOMIC_RELEASE, "agent");
            asm volatile("s_waitcnt vmcnt(0)" ::: "memory");
            const unsigned og = xb_add(&bar[XB_TOP], 1u);
            const unsigned tg = og / nx;
            if (og + 1u == (tg + 1u) * nx) xb_add(&bar[XB_TOPGEN], 1u);
            else XB_SPIN(xb_ld(&bar[XB_TOPGEN]) == tg, bar);
            __builtin_amdgcn_fence(__ATOMIC_ACQUIRE, "agent");
            xb_add(&bar[XB_XGEN(b.x)], 1u);
            asm volatile("s_waitcnt vmcnt(0)" ::: "memory");
        } else {
            XB_SPIN(xb_ld(&bar[XB_XGEN(b.x)]) == gen, bar);
            __builtin_amdgcn_fence(__ATOMIC_ACQUIRE, "agent");
            asm volatile("s_waitcnt vmcnt(0)" ::: "memory");
        }
    }
    __syncthreads();
}

constexpr int RING_BYTES = 131072;
constexpr int TAB_OFF = RING_BYTES;
constexpr int TAB_BYTES = 2048;
constexpr int MISC_OFF = TAB_OFF + TAB_BYTES;
constexpr int LDS_BYTES = 147456;
constexpr int NWAVES = 8, NTHREADS = 512;

__device__ __forceinline__ int fresh_tid(int wave) { int lane; asm volatile("v_mbcnt_lo_u32_b32 %0, -1, 0\n\tv_mbcnt_hi_u32_b32 %0, -1, %0" : "=v"(lane)); return wave * 64 + lane; }
struct Frame {
    LAS unsigned char* lds;
    unsigned char* lds_generic;
    unsigned char* ws;
    int wave, G;
    const float* const* in;
    float* out;
};

struct MapIdent { __device__ __forceinline__ int operator()(int n) const { return n; } };
struct MapWin {
    __device__ __forceinline__ int operator()(int n) const {
        if (n < 256) return C_CKV + n;
        if (n < 640) return C_CQ + (n - 256);
        if (n < 672) return C_KR + (n - 640);
        if (n < 768) return -1;
        if (n < 1280) return C_SGV + (n - 768);
        if (n < 1792) return C_SGU + (n - 1280);
        if (n < 2304) return C_CB + (n - 1792);
        if (n < 3328) { const int j = (n - 2304) >> 1; return (n & 1) ? C_CH + j : C_CC + j; }
        if (n < 4352) return C_GA + (n - 3328);
        if (n < 5376) return C_GB + (n - 4352);
        return C_GC + (n - 5376);
    }
};
struct MapGates { __device__ __forceinline__ int operator()(int n) const { return C_GA + n; } };
struct MapWq {
    __device__ __forceinline__ int operator()(int n) const { const int h = n / 96, d = n - h * 96; if (d < 64) return n; const int j = d - 64, i = j >> 1; return h * 96 + 64 + ((j & 1) ? 16 + i : i); }
};
struct MapWkv {
    __device__ __forceinline__ int operator()(int n) const { const int part = n >> 9, r = n & 511, h = r >> 6, j = r & 63; return h * 128 + part * 64 + j; }
};
struct MapWgu {
    __device__ __forceinline__ int operator()(int n) const { const int j = n >> 1; return (n & 1) ? 256 + j : j; }
};
template <class Map, bool FP8 = false>
__device__ __forceinline__ void transpose_mat(const float* W, int K, int Nsrc, bf16_t* WT, int ndest, const Map map, const float* kscale,
                                              LAS float* scr, int gw, int ngw, int lane, int nmat, size_t src_stride, size_t dst_stride, int ldk = 0  ) {
    const int nblk = ndest / 32, kblk = K / 64, per = nblk * kblk;
    for (int it = gw; it < per * nmat; it += ngw) {
        const int mat = it / per, r = it - mat * per, kb = r / nblk, nb = r - kb * nblk, k0 = kb * 64, n0 = nb * 32;
        const float* Wm = W + (size_t)mat * src_stride; bf16_t* WTm = WT + (size_t)mat * dst_stride;
        const int sc = map(n0 + (lane & 31)); const float msk = sc >= 0 ? 1.f : 0.f;
        const float* src = Wm + (size_t)(k0 + (lane >> 5)) * Nsrc + (sc >= 0 ? sc : 0);
        float v[32];
#pragma unroll
        for (int i = 0; i < 32; ++i) v[i] = src[(size_t)(2 * i) * Nsrc];
        const int c = lane & 7;
        f32x4 ka = {1.f, 1.f, 1.f, 1.f}, kb4 = ka;
        if (kscale) { ka = *(const f32x4*)(kscale + k0 + 8 * c); kb4 = *(const f32x4*)(kscale + k0 + 8 * c + 4); }
        if constexpr (FP8) { ka *= W8_SCALE; kb4 *= W8_SCALE; }
#pragma unroll
        for (int i = 0; i < 32; ++i) scr[(2 * i + (lane >> 5)) * 33 + (lane & 31)] = v[i] * msk;
        LDS_WAIT(); asm volatile("" ::: "memory");
#pragma unroll
        for (int j = 0; j < 4; ++j) { const int n = (lane >> 3) + 8 * j; const LAS float* s = scr + (8 * c) * 33 + n;
            if constexpr (FP8) { u32x2 o; o.x = pk4f8(s[0 * 33] * ka[0], s[1 * 33] * ka[1], s[2 * 33] * ka[2], s[3 * 33] * ka[3]); o.y = pk4f8(s[4 * 33] * kb4[0], s[5 * 33] * kb4[1], s[6 * 33] * kb4[2], s[7 * 33] * kb4[3]);
                *(u32x2*)((unsigned char*)WT + (size_t)mat * dst_stride + (size_t)(n0 + n) * (ldk ? ldk : K) + k0 + 8 * c) = o; }
            else { u32x4 o; o.x = pk2(s[0 * 33] * ka[0], s[1 * 33] * ka[1]); o.y = pk2(s[2 * 33] * ka[2], s[3 * 33] * ka[3]); o.z = pk2(s[4 * 33] * kb4[0], s[5 * 33] * kb4[1]); o.w = pk2(s[6 * 33] * kb4[2], s[7 * 33] * kb4[3]);
            *(u32x4*)(WTm + (size_t)(n0 + n) * K + k0 + 8 * c) = o; } }
        LDS_WAIT(); asm volatile("" ::: "memory");
    }
}
__device__ __forceinline__ void convert_mixer_weights(Frame& F, int l) {
    const int tid_ = fresh_tid(F.wave), lane_ = tid_ & 63; (void)lane_;
    LAS float* scr = (LAS float*)(F.lds + F.wave * 16384);
    unsigned char* wt = F.ws + WS_WT;
    transpose_mat(F.in[3] + (size_t)l * D * DIN, D, DIN, (bf16_t*)(wt + WT_WIN), N_P1, MapWin(), nullptr, scr, ((int)blockIdx.x * NWAVES + F.wave), (F.G * NWAVES), lane_, 1, 0, 0);
    transpose_mat<MapGates, true>(F.in[3] + (size_t)l * D * DIN, D, DIN, (bf16_t*)(wt + WT_WG8), N_GATES, MapGates(), nullptr, scr, ((int)blockIdx.x * NWAVES + F.wave), (F.G * NWAVES), lane_, 1, 0, 0);
    transpose_mat<MapWin, true>(F.in[3] + (size_t)l * D * DIN, D, DIN, (bf16_t*)(wt + WT_WT8), N_F8A, MapWin(), nullptr, scr, ((int)blockIdx.x * NWAVES + F.wave), (F.G * NWAVES), lane_, 1, 0, 0);
    transpose_mat<MapWq, true>(F.in[5] + (size_t)l * QR * 768, QR, 768, (bf16_t*)(wt + WT_WQ), 768, MapWq(), F.in[4] + l * QR, scr, ((int)blockIdx.x * NWAVES + F.wave), (F.G * NWAVES), lane_, 1, 0, 0, WQ8_LD);
    for (int idx = (int)blockIdx.x * NTHREADS + tid_; idx < 768 * 32; idx += F.G * NTHREADS) *(unsigned*)(wt + WT_WQ + (size_t)(idx >> 5) * WQ8_LD + QR + (idx & 31) * 4) = 0u;
    transpose_mat<MapWkv, true>(F.in[7] + (size_t)l * KVR * 1024, KVR, 1024, (bf16_t*)(wt + WT_WKV), 1024, MapWkv(), F.in[6] + l * KVR, scr, ((int)blockIdx.x * NWAVES + F.wave), (F.G * NWAVES), lane_, 1, 0, 0);
    transpose_mat(F.in[12] + (size_t)l * 512 * D, 512, D, (bf16_t*)(wt + WT_WA), D, MapIdent(), nullptr, scr, ((int)blockIdx.x * NWAVES + F.wave), (F.G * NWAVES), lane_, 1, 0, 0);
    transpose_mat(F.in[13] + (size_t)l * 512 * D, 512, D, (bf16_t*)(wt + WT_WB), D, MapIdent(), nullptr, scr, ((int)blockIdx.x * NWAVES + F.wave), (F.G * NWAVES), lane_, 1, 0, 0);
    transpose_mat(F.in[14] + (size_t)l * 512 * D, 512, D, (bf16_t*)(wt + WT_WC), D, MapIdent(), nullptr, scr, ((int)blockIdx.x * NWAVES + F.wave), (F.G * NWAVES), lane_, 1, 0, 0);
    transpose_mat(F.in[15] + (size_t)l * D * D, D, D, (bf16_t*)(wt + WT_WO), D, MapIdent(), nullptr, scr, ((int)blockIdx.x * NWAVES + F.wave), (F.G * NWAVES), lane_, 1, 0, 0);
}
__device__ __forceinline__ void convert_moe_weights(Frame& F, int l) {
    const int tid_ = fresh_tid(F.wave), lane_ = tid_ & 63; (void)lane_;
    LAS float* scr = (LAS float*)(F.lds + F.wave * 16384);
    transpose_mat<MapWgu, true>(F.in[21] + (size_t)l * NE * D * 512, D, 512, (bf16_t*)(F.ws + WS_WGU), 512, MapWgu(), F.in[16] + l * D  , scr, ((int)blockIdx.x * NWAVES + F.wave), (F.G * NWAVES), lane_, NE, (size_t)D * 512, (size_t)512 * D  );
    transpose_mat<MapIdent, true>(F.in[22] + (size_t)l * NE * DE * D, DE, D, (bf16_t*)(F.ws + WS_WD), D, MapIdent(), nullptr, scr, ((int)blockIdx.x * NWAVES + F.wave), (F.G * NWAVES), lane_, NE, (size_t)DE * D, (size_t)D * DE  );
}

__device__ __forceinline__ void norm_rows_bf16(Frame& F, const float* X, const float* gain, bf16_t* H, unsigned char* H8, float* RS) {
    const int tid_ = fresh_tid(F.wave), lane_ = tid_ & 63; (void)lane_;
    constexpr int RB = 4;
    f32x4 g[4];
#pragma unroll
    for (int j = 0; j < 4; ++j) g[j] = ((const f32x4*)gain)[lane_ + 64 * j];
    for (int m0 = ((int)blockIdx.x * NWAVES + F.wave); m0 < T; m0 += RB * (F.G * NWAVES)) {
        f32x4 v[RB][4];
#pragma unroll
        for (int r = 0; r < RB; ++r) { const int m = m0 + r * (F.G * NWAVES); if (m < T) { const f32x4* xr = (const f32x4*)(X + (size_t)m * D) + lane_;
#pragma unroll
            for (int j = 0; j < 4; ++j) v[r][j] = xr[64 * j]; } }
#pragma unroll
        for (int r = 0; r < RB; ++r) { const int m = m0 + r * (F.G * NWAVES); if (m < T) { float s = 0.f;
#pragma unroll
            for (int j = 0; j < 4; ++j) s += (v[r][j].x * v[r][j].x + v[r][j].y * v[r][j].y) + (v[r][j].z * v[r][j].z + v[r][j].w * v[r][j].w);
            const float ms = wave_sum(s) * (1.f / D) + EPS, rstd = rsqrtf(ms);
            if (lane_ == 0) RS[m] = ms * rstd;
            u32x2* o = (u32x2*)(H + (size_t)m * D) + lane_;
#pragma unroll
            for (int j = 0; j < 4; ++j) { u32x2 w; w.x = cvt_pk(v[r][j].x * rstd * g[j].x, v[r][j].y * rstd * g[j].y); w.y = cvt_pk(v[r][j].z * rstd * g[j].z, v[r][j].w * rstd * g[j].w); o[64 * j] = w; }
            unsigned* o8 = (unsigned*)(H8 + (size_t)m * D) + lane_;
#pragma unroll
            for (int j = 0; j < 4; ++j) o8[64 * j] = pk4f8(v[r][j].x * rstd * g[j].x, v[r][j].y * rstd * g[j].y, v[r][j].z * rstd * g[j].z, v[r][j].w * rstd * g[j].w); } }
    }
}
__device__ __forceinline__ void rope_table(Frame& F) {
    const int tid_ = fresh_tid(F.wave), lane_ = tid_ & 63; (void)lane_;
    const int* pos = (const int*)F.in[1]; float* R = (float*)(F.ws + WS_ROPE);
    const int gt = blockIdx.x * NTHREADS + tid_, nt = F.G * NTHREADS;
    const int i = gt & 15; const double c = exp2(-0.83048202372184059 * (double)i) * 0.15915494309189535;
    for (int idx = gt; idx < T * 16; idx += nt) { const int t = idx >> 4;
        double rd = (double)pos[t] * c; rd -= floor(rd); const float r = (float)rd;
        R[t * 32 + i] = __builtin_amdgcn_cosf(r); R[t * 32 + 16 + i] = __builtin_amdgcn_sinf(r); }
}
namespace pg8 {
constexpr int BM = 256, BK = 64, HALF = 128, HTB = HALF * BK * 2, STAGE_BYTES = 8 * HTB, NXCD = 8, WGM = 8;
__host__ __device__ __forceinline__ int lds_byte(int r, int c) { const int st = (r >> 4) * 2 + (c >> 5), rr = r & 15, cc = c & 31, ob = rr * 64 + cc * 2; return st * 1024 + (ob ^ (((ob >> 9) & 1) << 5)); }
__host__ __device__ __forceinline__ void stage_rc(int b, int& R, int& C) { const int st = b / 1024, sb = b % 1024, swz = sb ^ (((sb >> 9) & 1) << 5); R = (st >> 1) * 16 + swz / 64; C = (st & 1) * 32 + (swz % 64) / 2; }
__host__ __device__ __forceinline__ int perm32(int rho) { const int n = rho >> 4, i = rho & 15; return 8 * (i >> 2) + 4 * n + (i & 3); }
struct Unit { int pm, pn, aux, rm, rn; };
struct Gemm { const bf16_t* A; const bf16_t* Bt; };
struct StaticOrder {
    int nM, nN, nwg, G, c;
    __host__ __device__ void init(int M, int N, int G_, int c_) { nM = M / BM; nN = N / BM; nwg = nM * nN; G = G_; c = c_; }
    __host__ __device__ bool next(int i, Unit& u) const {
        const long L = (long)i * G + c; if (L >= nwg) return false;
        int wgid = (int)L; { const int q = nwg / NXCD, r = nwg % NXCD, xcd = wgid % NXCD, off = wgid / NXCD; wgid = (xcd < r ? xcd * (q + 1) : r * (q + 1) + (xcd - r) * q) + off; }
        const int nig = WGM * nN, gid = wgid / nig, fm = gid * WGM, gsz = (nM - fm) < WGM ? (nM - fm) : WGM;
        u.pm = fm + ((wgid % nig) % gsz); u.pn = (wgid % nig) / gsz; return true;
    }
};
struct MoeOrder {
    const LAS unsigned char* tile_e; int ntiles, ntn, G, c;
    __device__ bool next(int i, Unit& u) const {
        const int L = i * G + c; if (L >= ntiles * ntn) return false;
        const int tile = L / ntn, pn = L - tile * ntn; u.pm = tile; u.pn = __builtin_amdgcn_readfirstlane((int)tile_e[tile]) * ntn + pn; return true;
    }
};
struct MoeGatherOrder {
    const LAS unsigned char* tile_e; const LAS unsigned short* tile_r; const LAS int* cnt; const unsigned* list; int ntiles, ntn, G, c;
    __device__ bool next(int i, Unit& u) const {
        const int L = i * G + c; if (L >= ntiles * ntn) return false;
        const int tile = L / ntn, pn = L - tile * ntn, e = __builtin_amdgcn_readfirstlane((int)tile_e[tile]), rt = __builtin_amdgcn_readfirstlane((int)tile_r[tile]);
        u.pm = tile; u.pn = e * ntn + pn; u.aux = e; u.rm = rt; u.rn = __builtin_amdgcn_readfirstlane(cnt[e]); return true;
    }
    __device__ __forceinline__ unsigned rowoff(const Unit& u, int r) const { const int idx = u.rm * 256 + r; const unsigned tok = idx < u.rn ? list[(size_t)u.aux * T + idx] : 0u; return tok * (unsigned)D; }
};
struct ChainOrder {
    StaticOrder so;
    __device__ bool next(int i, Unit& u) const {
        const int it = i / 3, br = i - it * 3; Unit t;
        if (!so.next(it, t)) return false;
        u.rm = t.pm; u.rn = t.pn; u.aux = br;
        constexpr size_t TS = (size_t)256 * 512 * 2;
        constexpr int A0 = (int)(WS_SGU / TS), A1 = (int)(WS_CB / TS), A2 = (int)(WS_O / TS), B0 = (int)((WS_WT + WT_WB) / TS), B1 = (int)((WS_WT + WT_WC) / TS), B2 = (int)((WS_WT + WT_WA) / TS);
        int ao = A0 + br * (A1 - A0), bo = B0 + br * (B1 - B0); if (br == 2) { ao = A2; bo = B2; }
        u.pm = t.pm + ao; u.pn = t.pn + bo; return true;
    }
};
template <class Fn> struct Epi8 {
    static constexpr bool PERM = true, CHAIN = false;
    Fn f;
    __device__ __forceinline__ void operator()(const f32x4 (&acc)[2][2][4][2], const Unit& u, int wr, int wc, int fr, int fq) const {
#pragma unroll
        for (int ai = 0; ai < 2; ++ai)
#pragma unroll
            for (int m = 0; m < 4; ++m) { const int row = u.pm * BM + ai * HALF + wr * 64 + m * 16 + fr;
#pragma unroll
                for (int bj = 0; bj < 2; ++bj) f(u, row, u.pn * BM + bj * HALF + wc * 32 + 8 * fq, acc[ai][bj][m][0], acc[ai][bj][m][1]);
                asm volatile("" ::: "memory"); }
    }
};
template <class Fn, int MB> struct Epi8L {
    static constexpr bool PERM = true, CHAIN = false;
    Fn f;
    __device__ __forceinline__ void operator()(const f32x4 (&acc)[2][2][4][2], const Unit& u, int wr, int wc, int fr, int fq) const {
#pragma unroll
        for (int ai = 0; ai < 2; ++ai)
#pragma unroll
            for (int mb = 0; mb < 4; mb += MB) {
                typename Fn::Pre pre[MB][2];
#pragma unroll
                for (int m = 0; m < MB; ++m)
#pragma unroll
                    for (int bj = 0; bj < 2; ++bj) pre[m][bj] = f.pre(u, u.pm * BM + ai * HALF + wr * 64 + (mb + m) * 16 + fr, u.pn * BM + bj * HALF + wc * 32 + 8 * fq);
                asm volatile("" ::: "memory");
#pragma unroll
                for (int m = 0; m < MB; ++m)
#pragma unroll
                    for (int bj = 0; bj < 2; ++bj) f.post(u, u.pm * BM + ai * HALF + wr * 64 + (mb + m) * 16 + fr, u.pn * BM + bj * HALF + wc * 32 + 8 * fq, acc[ai][bj][mb + m][0], acc[ai][bj][mb + m][1], pre[m][bj]);
                asm volatile("" ::: "memory"); }
    }
};
template <class Fn> struct Epi8A {
    static constexpr bool PERM = true, CHAIN = false;
    Fn f;
    __device__ __forceinline__ void operator()(const f32x4 (&acc)[2][2][4][2], const Unit& u, int wr, int wc, int fr, int fq) const {
        typename Fn::Pre pre[2][4][2];
#pragma unroll
        for (int ai = 0; ai < 2; ++ai)
#pragma unroll
            for (int m = 0; m < 4; ++m)
#pragma unroll
                for (int bj = 0; bj < 2; ++bj) pre[ai][m][bj] = f.pre(u, u.pm * BM + ai * HALF + wr * 64 + m * 16 + fr, u.pn * BM + bj * HALF + wc * 32 + 8 * fq);
        asm volatile("" ::: "memory");
#pragma unroll
        for (int ai = 0; ai < 2; ++ai)
#pragma unroll
            for (int m = 0; m < 4; ++m) {
#pragma unroll
                for (int bj = 0; bj < 2; ++bj) f.post(u, u.pm * BM + ai * HALF + wr * 64 + m * 16 + fr, u.pn * BM + bj * HALF + wc * 32 + 8 * fq, acc[ai][bj][m][0], acc[ai][bj][m][1], pre[ai][m][bj]);
                asm volatile("" ::: "memory"); }
    }
};
typedef int i32x4_t __attribute__((ext_vector_type(4)));
typedef int i32x8_t __attribute__((ext_vector_type(8)));
__device__ __forceinline__ i32x8_t cat8(const bf16x8 a, const bf16x8 b) { const i32x4_t x = __builtin_bit_cast(i32x4_t, a), y = __builtin_bit_cast(i32x4_t, b); return __builtin_shufflevector(x, y, 0, 1, 2, 3, 4, 5, 6, 7); }
template <class Epi, class Sched, int LDA, int LDB, int KK, bool ALIGN_EPI = true, bool GATHER = false, bool FP8 = false>
__device__ __forceinline__ void gemm_phase(LAS unsigned char* lds, const int wave, const Gemm g, const Sched& S, const Epi& E) {
    const int tid = fresh_tid(wave), wid = __builtin_amdgcn_readfirstlane(tid >> 6), lane = tid & 63, wr = wid >> 2, wc = wid & 3, fr = lane & 15, fq = lane >> 4;
    constexpr int nt = KK / BK; static_assert(KK % 128 == 0, "K must be a multiple of 128");
    unsigned voffA, voffB;
    { int R, C; stage_rc(tid * 16, R, C); const int Rb = Epi::PERM ? ((R & ~31) + perm32(R & 31)) : R;
      voffA = (unsigned)(R * LDA + C) * 2u; voffB = (unsigned)(Rb * LDB + C) * 2u; }
    constexpr size_t pieceA = (size_t)64 * LDA * 2, pieceB = (size_t)64 * LDB * 2;
    unsigned gc00 = 0, gc01 = 0, gc10 = 0, gc11 = 0, gn00 = 0, gn01 = 0, gn10 = 0, gn11 = 0;
    constexpr size_t kstep = (size_t)(BK * 2);
    constexpr size_t hstepA = (size_t)HALF * LDA * 2, hstepB = (size_t)HALF * LDB * 2;
    constexpr size_t tstepA = 2 * hstepA, tstepB = 2 * hstepB;
    const unsigned ldsw = (unsigned)wid * 1024u;
    const int aoff = lds_byte(wr * 64 + fr, fq * 8), boff = lds_byte(wc * 32 + fr, fq * 8);
#define PG8_SA(b, h) (((b) * 2 + (h)) * HTB)
#define PG8_SB(b, h) ((4 + (b) * 2 + (h)) * HTB)
#define PG8_STAGE(bufoff, gbase, voff) do { \
        __builtin_amdgcn_global_load_lds((const unsigned*)((const char*)(gbase) + voff), (LAS unsigned*)(lds + (bufoff) + ldsw), 16, 0, 0); \
        __builtin_amdgcn_global_load_lds((const unsigned*)((const char*)(gbase) + PG8_PIECE_##voff + voff), (LAS unsigned*)(lds + (bufoff) + ldsw + 8192), 16, 0, 0); } while (0)
#define PG8_GLD(gptr, ldsoff) __builtin_amdgcn_global_load_lds((const unsigned*)(gptr), (LAS unsigned*)(lds + (ldsoff)), 16, 0, 0)
#define PG8_STAGE_A(bufoff, ptr, h, nx) do { if constexpr (GATHER) { \
        const unsigned o0_ = (nx) ? ((h) ? gn10 : gn00) : ((h) ? gc10 : gc00), o1_ = (nx) ? ((h) ? gn11 : gn01) : ((h) ? gc11 : gc01); \
        PG8_GLD((const char*)(ptr) + o0_, (bufoff) + ldsw); PG8_GLD((const char*)(ptr) + o1_, (bufoff) + ldsw + 8192); \
    } else { PG8_STAGE(bufoff, (const char*)(ptr) + (h) * hstepA, voffA); } } while (0)
#define PG8_ROWOFFS(u, o00, o01, o10, o11) do { int gR_, gC_; stage_rc(fresh_tid(wave) * 16, gR_, gC_);     \
        o00 = S.rowoff(u, gR_) + gC_ * 2; o01 = S.rowoff(u, gR_ + 64) + gC_ * 2; o10 = S.rowoff(u, 128 + gR_) + gC_ * 2; o11 = S.rowoff(u, 192 + gR_) + gC_ * 2; } while (0)
#define PG8_PIECE_voffA pieceA
#define PG8_PIECE_voffB pieceB
#define PG8_LDA(dst, b, h) do { _Pragma("unroll") for (int m = 0; m < 4; ++m) _Pragma("unroll") for (int k = 0; k < 2; ++k) dst[m][k] = *(const LAS bf16x8*)(lds + PG8_SA(b, h) + aoff + m * 2048 + k * 1024); } while (0)
#define PG8_LDB(dst, b, h) do { _Pragma("unroll") for (int n = 0; n < 2; ++n) _Pragma("unroll") for (int k = 0; k < 2; ++k) dst[n][k] = *(const LAS bf16x8*)(lds + PG8_SB(b, h) + boff + n * 2048 + k * 1024); } while (0)
#define PG8_MMA(ai, bj, At, Bt) do { __builtin_amdgcn_s_setprio(1); _Pragma("unroll") for (int m = 0; m < 4; ++m) _Pragma("unroll") for (int n = 0; n < 2; ++n) { \
        if constexpr (FP8) asm volatile("v_mfma_f32_16x16x128_f8f6f4 %0, %1, %2, %0" : "+v"(acc[ai][bj][m][n]) : "v"(cat8(Bt[n][0], Bt[n][1])), "v"(cat8(At[m][0], At[m][1])));   \
        else { _Pragma("unroll") for (int k = 0; k < 2; ++k) acc[ai][bj][m][n] = __builtin_amdgcn_mfma_f32_16x16x32_bf16(Bt[n][k], At[m][k], acc[ai][bj][m][n], 0, 0, 0); } } __builtin_amdgcn_s_setprio(0); } while (0)
#define PG8_WAIT_V(n) asm volatile("s_waitcnt vmcnt(" #n ")" ::: "memory")
#define PG8_WAIT_L(n) asm volatile("s_waitcnt lgkmcnt(" #n ")" ::: "memory")
#define PG8_BAR __builtin_amdgcn_s_barrier()
#define PG8_SCHED __builtin_amdgcn_sched_barrier(0)
    Unit cur, nxt; int ui = 0;
    if (!S.next(0, cur)) return;
    f32x4 acc[2][2][4][2];
#pragma unroll
    for (int a = 0; a < 2; ++a)
#pragma unroll
        for (int b = 0; b < 2; ++b)
#pragma unroll
            for (int m = 0; m < 4; ++m)
#pragma unroll
                for (int n = 0; n < 2; ++n) acc[a][b][m][n] = (f32x4){0.f, 0.f, 0.f, 0.f};
    bf16x8 At[4][2], B0[2][2], B1[2][2];
    const char* cA = (const char*)g.A + (GATHER ? (size_t)0 : (size_t)cur.pm * tstepA); const char* cB = (const char*)g.Bt + (size_t)cur.pn * tstepB;
    if constexpr (GATHER) PG8_ROWOFFS(cur, gc00, gc01, gc10, gc11);
    PG8_STAGE(PG8_SB(0, 0), cB, voffB); PG8_STAGE(PG8_SB(0, 1), cB + hstepB, voffB); PG8_STAGE_A(PG8_SA(0, 0), cA, 0, false); PG8_STAGE_A(PG8_SA(0, 1), cA, 1, false);
    if (wr == 1) PG8_BAR;
    PG8_WAIT_V(2); PG8_BAR;
    PG8_STAGE(PG8_SB(1, 0), cB + kstep, voffB); PG8_STAGE_A(PG8_SA(1, 0), cA + kstep, 0, false); PG8_STAGE(PG8_SB(1, 1), cB + hstepB + kstep, voffB);
    PG8_WAIT_V(6); PG8_BAR;
    for (;;) {
        const bool has_next = S.next(ui + 1, nxt);
        const char* nA = (has_next && !GATHER) ? (const char*)g.A + (size_t)nxt.pm * tstepA : cA;
        if constexpr (GATHER) { if (has_next) PG8_ROWOFFS(nxt, gn00, gn01, gn10, gn11); else { gn00 = gc00; gn01 = gc01; gn10 = gc10; gn11 = gc11; } } const char* nB = has_next ? (const char*)g.Bt + (size_t)nxt.pn * tstepB : cB;
#pragma nounroll
        for (int t = 0; t < nt; t += 2) {
            const bool last = (t == nt - 2);
            const char* a1 = cA + (size_t)(t + 1) * kstep;
            const char* a2 = last ? nA : cA + (size_t)(t + 2) * kstep; const char* b2 = last ? nB : cB + (size_t)(t + 2) * kstep;
            const char* a3 = a2 + kstep; const char* b3 = b2 + kstep;
            PG8_LDB(B0, 0, 0); PG8_LDB(B1, 0, 1); PG8_SCHED; PG8_LDA(At, 0, 0); PG8_STAGE_A(PG8_SA(1, 1), a1, 1, false);
            PG8_WAIT_V(8); PG8_WAIT_L(0); PG8_BAR; PG8_MMA(0, 0, At, B0); PG8_MMA(0, 1, At, B1); PG8_BAR; PG8_SCHED;
            PG8_LDA(At, 0, 1); PG8_STAGE(PG8_SB(0, 0), b2, voffB); PG8_STAGE(PG8_SB(0, 1), b2 + hstepB, voffB); PG8_STAGE_A(PG8_SA(0, 0), a2, 0, last);
            PG8_WAIT_V(8); PG8_WAIT_L(0); PG8_BAR; PG8_MMA(1, 0, At, B0); PG8_MMA(1, 1, At, B1); PG8_BAR; PG8_SCHED;
            PG8_LDB(B0, 1, 0); PG8_LDB(B1, 1, 1); PG8_SCHED; PG8_LDA(At, 1, 0); PG8_STAGE_A(PG8_SA(0, 1), a2, 1, last);
            PG8_WAIT_V(8); PG8_WAIT_L(0); PG8_BAR; PG8_MMA(0, 0, At, B0); PG8_MMA(0, 1, At, B1); PG8_BAR; PG8_SCHED;
            PG8_LDA(At, 1, 1); PG8_STAGE(PG8_SB(1, 0), b3, voffB); PG8_STAGE(PG8_SB(1, 1), b3 + hstepB, voffB); PG8_STAGE_A(PG8_SA(1, 0), a3, 0, last);
            PG8_WAIT_V(8); PG8_WAIT_L(0); PG8_BAR; PG8_MMA(1, 0, At, B0); PG8_MMA(1, 1, At, B1); PG8_BAR; PG8_SCHED;
        }
        if constexpr (FP8) asm volatile("s_nop 15\n\ts_nop 15" ::: "memory");
        if constexpr (ALIGN_EPI) { if (wr == 0) PG8_BAR; }
        { const int l2 = fresh_tid(wave) & 63; E(acc, cur, wr, wc, l2 & 15, l2 >> 4); }
        if (!has_next) break;
        if (!Epi::CHAIN || cur.aux == 2) {
#pragma unroll
        for (int a = 0; a < 2; ++a)
#pragma unroll
            for (int b = 0; b < 2; ++b)
#pragma unroll
                for (int m = 0; m < 4; ++m)
#pragma unroll
                    for (int n = 0; n < 2; ++n) acc[a][b][m][n] = (f32x4){0.f, 0.f, 0.f, 0.f}; }
        cur = nxt; cA = nA; cB = nB; ++ui;
        if constexpr (GATHER) { gc00 = gn00; gc01 = gn01; gc10 = gn10; gc11 = gn11; }
        if constexpr (ALIGN_EPI) { if (wr == 1) PG8_BAR; }
    }
    PG8_WAIT_V(0);
    if constexpr (!ALIGN_EPI) { if (wr == 0) PG8_BAR; }
    PG8_BAR;
#undef PG8_SA
#undef PG8_SB
#undef PG8_STAGE
#undef PG8_GLD
#undef PG8_STAGE_A
#undef PG8_ROWOFFS
#undef PG8_PIECE_voffA
#undef PG8_PIECE_voffB
#undef PG8_LDA
#undef PG8_LDB
#undef PG8_MMA
#undef PG8_WAIT_V
#undef PG8_WAIT_L
#undef PG8_BAR
#undef PG8_SCHED
}
}

template <int LDA, int LDB, int N, int KK, bool FP8 = false, class Epi>
__device__ __forceinline__ void gemm_dense(Frame& F, const bf16_t* A, const bf16_t* Bt, const Epi& E) {
    pg8::Gemm g{A, Bt}; pg8::StaticOrder So; So.init(T, N, F.G, (int)blockIdx.x);
    pg8::gemm_phase<Epi, pg8::StaticOrder, LDA, LDB, KK, true, false, FP8>(F.lds, F.wave, g, So, E);
}

template <bool F8> struct EpiP1 {
    static constexpr bool PERM = true, CHAIN = false;
    bf16_t *T0, *SGU, *GV, *CB, *Z; float *ST0, *STV;
    __device__ __forceinline__ void operator()(const f32x4 (&acc)[2][2][4][2], const pg8::Unit& u, int wr, int wc, int fr, int fq) const {
        const int pn = F8 ? (u.pn < 3 ? u.pn : u.pn + 2) : (u.pn < 2 ? u.pn + 3 : u.pn + 5);
#pragma unroll
        for (int ai = 0; ai < 2; ++ai)
#pragma unroll
            for (int m = 0; m < 4; ++m) { const int row = u.pm * 256 + ai * 128 + wr * 64 + m * 16 + fr;
                float ss0 = 0.f, ss1 = 0.f;
#pragma unroll
                for (int bj = 0; bj < 2; ++bj) { const int c = bj * 128 + wc * 32 + 8 * fq; f32x4 v0 = acc[ai][bj][m][0], v1 = acc[ai][bj][m][1]; float ss = 0.f;
                    if (F8) { v0 *= (1.f / W8_SCALE); v1 *= (1.f / W8_SCALE); }
                    if (pn < 3) { u32x2 w8; w8.x = pk4f8(v0[0], v0[1], v0[2], v0[3]); w8.y = pk4f8(v1[0], v1[1], v1[2], v1[3]); *(u32x2*)((unsigned char*)T0 + (size_t)row * T0W + pn * 256 + c) = w8; ss = dot8(v0, v1); }
                    else if (pn < 5) { v0 = fgelu4(v0); v1 = fgelu4(v1); *(u32x4*)(SGU + (size_t)row * SGW + (pn - 3) * 256 + c) = pack8(v0, v1); }
                    else if (pn < 7) { v0 = fgelu4(v0); v1 = fgelu4(v1); *(u32x4*)(GV + (size_t)row * SGW + (pn - 5) * 256 + c) = pack8(v0, v1); ss = dot8(v0, v1); }
                    else if (pn < 9) { *(u32x4*)(CB + (size_t)row * CW + (pn - 7) * 256 + c) = pack8(v0, v1); }
                    else { u32x2 w; w.x = cvt_pk(v0[0] * v0[1], v0[2] * v0[3]); w.y = cvt_pk(v1[0] * v1[1], v1[2] * v1[3]); *(u32x2*)(Z + (size_t)row * CW + (pn - 9) * 128 + (c >> 1)) = w; }
                    if (bj == 0) ss0 = ss; else ss1 = ss; }
                if (pn < 3 || (pn >= 5 && pn < 7)) {
                    float sv = (pn == 2) ? ss0 : ss0 + ss1;
                    sv += __shfl_xor(sv, 16); sv += __shfl_xor(sv, 32);
                    if (fq == 0) { if (pn < 3) ST0[(size_t)row * 12 + pn * 4 + wc] = sv; else STV[(size_t)row * 8 + (pn - 5) * 4 + wc] = sv; } }
                asm volatile("" ::: "memory"); }
    }
};
struct FnGates8 {
    unsigned char* ws;
    __device__ __forceinline__ void operator()(const pg8::Unit& u, int row, int col, f32x4 v0, f32x4 v1) const {
        const int w = u.pn >> 2; size_t off = WS_GB + (size_t)(w - 1) * (WS_GC - WS_GB); if (w == 0) off = WS_GA;
        constexpr float KS = -1.4426950408889634f / W8_SCALE;
        u32x2 pk = {0u, 0u};
#pragma unroll
        for (int j = 0; j < 4; ++j) {
            pk.x = __builtin_amdgcn_cvt_pk_u8_f32(__builtin_amdgcn_rcpf(1.f + __builtin_amdgcn_exp2f(KS * v0[j])) * 255.f + 0.5f, j, pk.x);
            pk.y = __builtin_amdgcn_cvt_pk_u8_f32(__builtin_amdgcn_rcpf(1.f + __builtin_amdgcn_exp2f(KS * v1[j])) * 255.f + 0.5f, j, pk.y); }
        const unsigned char* gb = ws + off; const unsigned vo = (unsigned)row * (unsigned)D + (unsigned)(col & 1023);
        *(u32x2*)(gb + vo) = pk;
    }
};
constexpr float QSCALE = 0.10206207261596577f * 1.4426950408889634f;
struct FnQ8 {
    bf16_t* Q; const float* ST0; const float* rope;
    struct Pre { f32x4 a, b, c, s; };
    __device__ __forceinline__ Pre pre(const pg8::Unit& u, int row, int col) const {
        Pre p; p.a = *(const f32x4*)(ST0 + (size_t)row * 12 + 4); p.b = *(const f32x4*)(ST0 + (size_t)row * 12 + 8);
        const int d = col % 96, i = d >= 64 ? (d - 64) >> 1 : 0;
        p.c = *(const f32x4*)(rope + (size_t)row * 32 + i); p.s = *(const f32x4*)(rope + (size_t)row * 32 + 16 + i);
        if (d < 64) { p.c = (f32x4){1.f, 1.f, 1.f, 1.f}; p.s = (f32x4){0.f, 0.f, 0.f, 0.f}; }
        return p; }
    __device__ __forceinline__ void post(const pg8::Unit& u, int row, int col, f32x4 v0, f32x4 v1, const Pre& p) const {
        const float r = rsqrtf((((p.a[0] + p.a[1]) + (p.a[2] + p.a[3])) + ((p.b[0] + p.b[1]) + (p.b[2] + p.b[3]))) * (1.f / QR) + EPS);
        const f32x4 t0 = v0 * (r * (QSCALE / W8_SCALE)), t1 = v1 * (r * (QSCALE / W8_SCALE)), c = p.c, s = p.s;
        v0[0] = t0[0] * c[0] - t0[1] * s[0]; v0[1] = t0[1] * c[0] + t0[0] * s[0]; v0[2] = t0[2] * c[1] - t0[3] * s[1]; v0[3] = t0[3] * c[1] + t0[2] * s[1];
        v1[0] = t1[0] * c[2] - t1[1] * s[2]; v1[1] = t1[1] * c[2] + t1[0] * s[2]; v1[2] = t1[2] * c[3] - t1[3] * s[3]; v1[3] = t1[3] * c[3] + t1[2] * s[3];
        *(u32x4*)(Q + (size_t)row * 768 + col) = pack8(v0, v1);
    }
};
struct FnKV8 {
    bf16_t *KN, *V; const float* ST0;
    struct Pre { f32x4 a; };
    __device__ __forceinline__ Pre pre(const pg8::Unit& u, int row, int col) const { Pre p; p.a = *(const f32x4*)(ST0 + (size_t)row * 12); return p; }
    __device__ __forceinline__ void post(const pg8::Unit& u, int row, int col, f32x4 v0, f32x4 v1, const Pre& p) const {
        const float r = rsqrtf(((p.a[0] + p.a[1]) + (p.a[2] + p.a[3])) * (1.f / KVR) + EPS) * (1.f / W8_SCALE);
        bf16_t* O = u.pn < 2 ? KN : V;
        *(u32x4*)(O + (size_t)row * 512 + (col & 511)) = pack8(v0 * r, v1 * r);
    }
};
template <bool FIRST> struct FnMerge8 {
    bf16_t* MRG; const bf16_t* G;
    struct Pre { u32x4 g, m; };
    __device__ __forceinline__ Pre pre(const pg8::Unit& u, int row, int col) const {
        const size_t o = (size_t)row * D + col; Pre p; p.g = *(const u32x4*)(G + o);
        if (!FIRST) p.m = *(const u32x4*)(MRG + o); else p.m = (u32x4){0u, 0u, 0u, 0u};
        return p; }
    __device__ __forceinline__ void post(const pg8::Unit& u, int row, int col, f32x4 v0, f32x4 v1, const Pre& p) const {
        const size_t o = (size_t)row * D + col; const u32x4 g = p.g, m = p.m;
        v0 = (f32x4){lo16(g.x) * v0[0], hi16(g.x) * v0[1], lo16(g.y) * v0[2], hi16(g.y) * v0[3]};
        v1 = (f32x4){lo16(g.z) * v1[0], hi16(g.z) * v1[1], lo16(g.w) * v1[2], hi16(g.w) * v1[3]};
        if (!FIRST) { v0 += (f32x4){lo16(m.x), hi16(m.x), lo16(m.y), hi16(m.y)}; v1 += (f32x4){lo16(m.z), hi16(m.z), lo16(m.w), hi16(m.w)}; }
        *(u32x4*)(MRG + o) = pack8(v0, v1);
    }
};
template <bool BASE_F32> struct FnResB {
    const void* base; bf16_t* out; unsigned char* out8;
    struct Pre { f32x4 b0, b1; };
    __device__ __forceinline__ Pre pre(const pg8::Unit& u, int row, int col) const { const size_t o = (size_t)row * D + col; Pre p;
        if (BASE_F32) { p.b0 = *(const f32x4*)((const float*)base + o); p.b1 = *(const f32x4*)((const float*)base + o + 4); }
        else { const u32x4 w = *(const u32x4*)((const bf16_t*)base + o); p.b0 = (f32x4){lo16(w.x), hi16(w.x), lo16(w.y), hi16(w.y)}; p.b1 = (f32x4){lo16(w.z), hi16(w.z), lo16(w.w), hi16(w.w)}; }
        return p; }
    __device__ __forceinline__ void post(const pg8::Unit& u, int row, int col, f32x4 v0, f32x4 v1, const Pre& p) const { v0 += p.b0; v1 += p.b1; *(u32x4*)(out + (size_t)row * D + col) = pack8(v0, v1);
        u32x2 w; w.x = pk4f8(v0[0], v0[1], v0[2], v0[3]); w.y = pk4f8(v1[0], v1[1], v1[2], v1[3]); *(u32x2*)(out8 + (size_t)row * D + col) = w; }
};
struct EpiResH {
    static constexpr bool PERM = true, CHAIN = false;
    const bf16_t* Hn; const float* rs; const float* gain; bf16_t* out; unsigned char* out8;
    __device__ __forceinline__ void operator()(const f32x4 (&acc)[2][2][4][2], const pg8::Unit& u, int wr, int wc, int fr, int fq) const {
        f32x4 ig[2][2]; u32x4 h[2][4][2]; float r[2][4];
#pragma unroll
        for (int bj = 0; bj < 2; ++bj) { const int col = u.pn * 256 + bj * 128 + wc * 32 + 8 * fq; ig[bj][0] = *(const f32x4*)(gain + col); ig[bj][1] = *(const f32x4*)(gain + col + 4); }
#pragma unroll
        for (int ai = 0; ai < 2; ++ai)
#pragma unroll
            for (int m = 0; m < 4; ++m) { const int row = u.pm * 256 + ai * 128 + wr * 64 + m * 16 + fr; r[ai][m] = rs[row];
#pragma unroll
                for (int bj = 0; bj < 2; ++bj) h[ai][m][bj] = *(const u32x4*)(Hn + (size_t)row * D + u.pn * 256 + bj * 128 + wc * 32 + 8 * fq); }
        asm volatile("" ::: "memory");
#pragma unroll
        for (int bj = 0; bj < 2; ++bj)
#pragma unroll
            for (int k = 0; k < 2; ++k) ig[bj][k] = (f32x4){__builtin_amdgcn_rcpf(ig[bj][k][0]), __builtin_amdgcn_rcpf(ig[bj][k][1]), __builtin_amdgcn_rcpf(ig[bj][k][2]), __builtin_amdgcn_rcpf(ig[bj][k][3])};
#pragma unroll
        for (int ai = 0; ai < 2; ++ai)
#pragma unroll
            for (int m = 0; m < 4; ++m) { const int row = u.pm * 256 + ai * 128 + wr * 64 + m * 16 + fr;
#pragma unroll
                for (int bj = 0; bj < 2; ++bj) { const size_t o = (size_t)row * D + u.pn * 256 + bj * 128 + wc * 32 + 8 * fq; const u32x4 w = h[ai][m][bj];
                    const f32x4 v0 = (f32x4){lo16(w.x), hi16(w.x), lo16(w.y), hi16(w.y)} * (ig[bj][0] * r[ai][m]) + acc[ai][bj][m][0];
                    const f32x4 v1 = (f32x4){lo16(w.z), hi16(w.z), lo16(w.w), hi16(w.w)} * (ig[bj][1] * r[ai][m]) + acc[ai][bj][m][1];
                    *(u32x4*)(out + o) = pack8(v0, v1);
                    u32x2 w8; w8.x = pk4f8(v0[0], v0[1], v0[2], v0[3]); w8.y = pk4f8(v1[0], v1[1], v1[2], v1[3]); *(u32x2*)(out8 + o) = w8; }
                asm volatile("" ::: "memory"); }
    }
};
struct FnRes8 {
    const float* base; float* out;
    struct Pre { f32x4 b0, b1; };
    __device__ __forceinline__ Pre pre(const pg8::Unit& u, int row, int col) const { const size_t o = (size_t)row * D + col; Pre p; p.b0 = *(const f32x4*)(base + o); p.b1 = *(const f32x4*)(base + o + 4); return p; }
    __device__ __forceinline__ void post(const pg8::Unit& u, int row, int col, f32x4 v0, f32x4 v1, const Pre& p) const {
        const size_t o = (size_t)row * D + col; *(f32x4*)(out + o) = p.b0 + v0; *(f32x4*)(out + o + 4) = p.b1 + v1;
    }
};
struct EpiChain {
    static constexpr bool PERM = true, CHAIN = true;
    bf16_t* MRG; const unsigned char* ws;
    static __device__ __forceinline__ f32x4 ub4(unsigned w) {
        return (f32x4){fmaxf((float)(w & 255u), 1.f), fmaxf((float)((w >> 8) & 255u), 1.f), fmaxf((float)((w >> 16) & 255u), 1.f), fmaxf((float)(w >> 24), 1.f)}; }
    __device__ __forceinline__ void operator()(f32x4 (&acc)[2][2][4][2], const pg8::Unit& u, int wr, int wc, int fr, int fq) const {
        const int br = u.aux;
        const size_t on = (br == 2) ? WS_GA : WS_GB + (size_t)br * (WS_GC - WS_GB), od = (br == 0) ? WS_GC : WS_GA;
        const unsigned char* Gn = ws + on; const unsigned char* Gd = ws + od;
        u32x2 gna[2][4][2], gda[2][4][2];
#pragma unroll
        for (int ai = 0; ai < 2; ++ai)
#pragma unroll
            for (int m = 0; m < 4; ++m)
#pragma unroll
                for (int bj = 0; bj < 2; ++bj) { const size_t o = (size_t)(u.rm * 256 + ai * 128 + wr * 64 + m * 16 + fr) * D + u.rn * 256 + bj * 128 + wc * 32 + 8 * fq;
                    gna[ai][m][bj] = *(const u32x2*)(Gn + o); if (br != 2) gda[ai][m][bj] = *(const u32x2*)(Gd + o); else gda[ai][m][bj] = (u32x2){0u, 0u}; }
        asm volatile("" ::: "memory");
#pragma unroll
        for (int ai = 0; ai < 2; ++ai) {
            const u32x2 (&gn)[4][2] = gna[ai]; const u32x2 (&gd)[4][2] = gda[ai];
#pragma unroll
            for (int m = 0; m < 4; ++m)
#pragma unroll
                for (int bj = 0; bj < 2; ++bj) { const size_t o = (size_t)(u.rm * 256 + ai * 128 + wr * 64 + m * 16 + fr) * D + u.rn * 256 + bj * 128 + wc * 32 + 8 * fq;
                    f32x4 f0 = ub4(gn[m][bj].x), f1 = ub4(gn[m][bj].y);
                    if (br != 2) { const f32x4 d0 = ub4(gd[m][bj].x), d1 = ub4(gd[m][bj].y);
                        f0 *= (f32x4){__builtin_amdgcn_rcpf(d0[0]), __builtin_amdgcn_rcpf(d0[1]), __builtin_amdgcn_rcpf(d0[2]), __builtin_amdgcn_rcpf(d0[3])};
                        f1 *= (f32x4){__builtin_amdgcn_rcpf(d1[0]), __builtin_amdgcn_rcpf(d1[1]), __builtin_amdgcn_rcpf(d1[2]), __builtin_amdgcn_rcpf(d1[3])};
                        acc[ai][bj][m][0] *= f0; acc[ai][bj][m][1] *= f1;
                    } else { *(u32x4*)(MRG + o) = pack8(acc[ai][bj][m][0] * (f0 * (1.f / 255.f)), acc[ai][bj][m][1] * (f1 * (1.f / 255.f))); } }
            asm volatile("" ::: "memory"); }
    }
};
struct FnMoe1G {
    bf16_t* ACT; const float* rl;
    struct Pre { float rs; };
    __device__ __forceinline__ Pre pre(const pg8::Unit& u, int row, int col) const { Pre p; p.rs = rl[(size_t)u.aux * T + u.rm * 256 + (row - u.pm * 256)] * (1.f / W8_SCALE); return p; }
    __device__ __forceinline__ void post(const pg8::Unit& u, int row, int col, f32x4 v0, f32x4 v1, const Pre& p) const {
        v0 *= p.rs; v1 *= p.rs;
        *(unsigned*)((unsigned char*)ACT + (size_t)row * DE + ((col & 511) >> 1)) = pk4f8(v0[0] * fsigmoid(v0[0]) * v0[1], v0[2] * fsigmoid(v0[2]) * v0[3], v1[0] * fsigmoid(v1[0]) * v1[1], v1[2] * fsigmoid(v1[2]) * v1[3]);
    }
};
struct FnMoe1_8 {
    bf16_t* ACT;
    __device__ __forceinline__ void operator()(const pg8::Unit& u, int row, int col, f32x4 v0, f32x4 v1) const {
        u32x2 w; w.x = cvt_pk(v0[0] * fsigmoid(v0[0]) * v0[1], v0[2] * fsigmoid(v0[2]) * v0[3]); w.y = cvt_pk(v1[0] * fsigmoid(v1[0]) * v1[1], v1[2] * fsigmoid(v1[2]) * v1[3]);
        *(u32x2*)(ACT + (size_t)row * DE + ((col & 511) >> 1)) = w;
    }
};
struct FnMoe2_8 {
    unsigned char* YB;
    __device__ __forceinline__ void operator()(const pg8::Unit& u, int row, int col, f32x4 v0, f32x4 v1) const {
        v0 *= (1.f / W8_SCALE); v1 *= (1.f / W8_SCALE);
        u32x2 w; w.x = pk4f8(v0[0], v0[1], v0[2], v0[3]); w.y = pk4f8(v1[0], v1[1], v1[2], v1[3]);
        *(u32x2*)(YB + (size_t)row * D + (col & 1023)) = w; }
};

__device__ __forceinline__ void sgmix_pass(Frame& F, int l, bf16_t* OUT) {
    typedef float f32x16 __attribute__((ext_vector_type(16)));
    const int tid_ = fresh_tid(F.wave), lane_ = tid_ & 63, r32 = lane_ & 31, hi = lane_ >> 5, wid = F.wave;
    LAS unsigned char* VT = F.lds; LAS float* RV = (LAS float*)(F.lds + TAB_OFF);
    bf16_t* SGU = (bf16_t*)(F.ws + WS_SGU); const bf16_t* GV = (const bf16_t*)(F.ws + WS_GV); const float* stv = (const float*)(F.ws + WS_STV);
    const float* sgn = F.in[8] + l * SGW; const bf16_t* WSG = (const bf16_t*)(F.ws + WS_WSG); const float* bs = F.in[10] + l * 4 * 128;
    for (int chunk = blockIdx.x; chunk < T / 128; chunk += gridDim.x) {
        const int t0 = chunk * 128;
        __syncthreads();
        if (tid_ < 128) { const f32x4 a = *(const f32x4*)(stv + (size_t)(t0 + tid_) * 8), b = *(const f32x4*)(stv + (size_t)(t0 + tid_) * 8 + 4);
            RV[tid_] = rsqrtf((((a[0] + a[1]) + (a[2] + a[3])) + ((b[0] + b[1]) + (b[2] + b[3]))) * (1.f / SGW) + EPS); }
        __syncthreads();
        u32x4 av[8], bv[8];
#pragma unroll
        for (int k = 0; k < 8; ++k) { const int c0 = (wid + 8 * k) * 8, s2 = 2 * lane_;
            av[k] = *(const u32x4*)(GV + (size_t)(t0 + s2) * SGW + c0); bv[k] = *(const u32x4*)(GV + (size_t)(t0 + s2 + 1) * SGW + c0); }
#pragma unroll
        for (int k = 0; k < 8; ++k) { const int cc = wid + 8 * k, c0 = cc * 8, s2 = 2 * lane_, g = c0 >> 7, d0 = c0 & 127;
            const u32x4 a = av[k], b = bv[k];
            const float ra = RV[s2], rb = RV[s2 + 1]; const f32x4 g0 = *(const f32x4*)(sgn + c0), g1 = *(const f32x4*)(sgn + c0 + 4);
            const float ga[8] = {g0[0], g0[1], g0[2], g0[3], g1[0], g1[1], g1[2], g1[3]};
#pragma unroll
            for (int j = 0; j < 8; ++j) { const unsigned wa = a[j >> 1], wb = b[j >> 1];
                const float va = ((j & 1) ? hi16(wa) : lo16(wa)) * ra * ga[j], vb = ((j & 1) ? hi16(wb) : lo16(wb)) * rb * ga[j];
                const int d = d0 + j;
                *(LAS unsigned*)(VT + g * 32768 + d * 256 + ((((s2 >> 3) ^ (d & 15)) << 4) + (s2 & 7) * 2)) = cvt_pk(va, vb); } }
        __syncthreads();
        const int g = wid >> 1;
#pragma unroll 1
        for (int pass = 0; pass < 2; ++pass) { const int tt = (wid & 1) ? 1 + pass : (pass ? 3 : 0);
            f32x16 acc[4] = {};
            const bf16_t* wrow = WSG + ((size_t)(g * 128 + 32 * tt + r32)) * 128 + 8 * hi;
            const LAS unsigned char* vb = VT + g * 32768;
            bf16x8 Af[8];
#pragma unroll
            for (int ks = 0; ks < 8; ++ks) Af[ks] = *(const bf16x8*)(wrow + 16 * ks);
            const int nks = 2 * (tt + 1);
#pragma unroll
            for (int ks = 0; ks < 8; ++ks) if (ks < nks) {
#pragma unroll
                for (int dt = 0; dt < 4; ++dt) { const int d = 32 * dt + r32;
                    const bf16x8 B = *(const LAS bf16x8*)(vb + d * 256 + (((2 * ks + hi) ^ (d & 15)) << 4));
                    acc[dt] = __builtin_amdgcn_mfma_f32_32x32x16_bf16(Af[ks], B, acc[dt], 0, 0, 0); } }
#pragma unroll
            for (int r = 0; r < 16; ++r) { const int t = 32 * tt + (r & 3) + 8 * (r >> 2) + 4 * hi; const float bias = bs[g * 128 + t];
#pragma unroll
                for (int dt = 0; dt < 4; ++dt) { const size_t o_ = (size_t)(t0 + t) * SGW + g * 128 + 32 * dt + r32;
                    OUT[o_] = (bf16_t)f2bf(bf2f(SGU[o_]) * (acc[dt][r] + bias)); } }
        }
    }
    __syncthreads();
}
__device__ __forceinline__ void conv_pass(Frame& F, int l, bf16_t* OUT) {
    const int tid_ = fresh_tid(F.wave);
    bf16_t* CB = (bf16_t*)(F.ws + WS_CB); const bf16_t* Z = (const bf16_t*)(F.ws + WS_Z); const float* cw = F.in[11] + (size_t)l * 3 * CW;
    const int gt = blockIdx.x * NTHREADS + tid_, nt = F.G * NTHREADS;
    for (int idx = gt; idx < (T / 4) * 64; idx += nt) { const int t0 = (idx >> 6) * 4, c8 = (idx & 63) * 8, s0 = t0 & (S - 1);
        u32x4 z[6], b[4];
        z[0] = (u32x4){0, 0, 0, 0}; z[1] = z[0];
        if (s0 >= 2) { z[0] = *(const u32x4*)(Z + (size_t)(t0 - 2) * CW + c8); z[1] = *(const u32x4*)(Z + (size_t)(t0 - 1) * CW + c8); }
#pragma unroll
        for (int i = 0; i < 4; ++i) { z[2 + i] = *(const u32x4*)(Z + (size_t)(t0 + i) * CW + c8); b[i] = *(const u32x4*)(CB + (size_t)(t0 + i) * CW + c8); }
        const f32x4 w00 = *(const f32x4*)(cw + c8), w01 = *(const f32x4*)(cw + c8 + 4), w10 = *(const f32x4*)(cw + CW + c8), w11 = *(const f32x4*)(cw + CW + c8 + 4), w20 = *(const f32x4*)(cw + 2 * CW + c8), w21 = *(const f32x4*)(cw + 2 * CW + c8 + 4);
        const float w0[8] = {w00[0], w00[1], w00[2], w00[3], w01[0], w01[1], w01[2], w01[3]}, w1[8] = {w10[0], w10[1], w10[2], w10[3], w11[0], w11[1], w11[2], w11[3]}, w2[8] = {w20[0], w20[1], w20[2], w20[3], w21[0], w21[1], w21[2], w21[3]};
#pragma unroll
        for (int i = 0; i < 4; ++i) { u32x4 o;
#pragma unroll
            for (int j = 0; j < 4; ++j) {
                const float y0 = w0[2 * j] * lo16(z[i][j]) + w1[2 * j] * lo16(z[i + 1][j]) + w2[2 * j] * lo16(z[i + 2][j]);
                const float y1 = w0[2 * j + 1] * hi16(z[i][j]) + w1[2 * j + 1] * hi16(z[i + 1][j]) + w2[2 * j + 1] * hi16(z[i + 2][j]);
                o[j] = cvt_pk(lo16(b[i][j]) * y0, hi16(b[i][j]) * y1); }
            *(u32x4*)(OUT + (size_t)(t0 + i) * CW + c8) = o; } }
}
__device__ __forceinline__ void krope_pass(Frame& F) {
    const int tid_ = fresh_tid(F.wave), lane_ = tid_ & 63; (void)lane_;
    const unsigned char* T8 = F.ws + WS_T0; bf16_t* KR = (bf16_t*)(F.ws + WS_KR); const float* rope = (const float*)(F.ws + WS_ROPE);
    const int gt = blockIdx.x * NTHREADS + tid_, nt = F.G * NTHREADS;
    for (int idx0 = gt; idx0 < T * 16; idx0 += 4 * nt) {
        float x1[4], x2[4], c[4], sn[4];
#pragma unroll
        for (int j = 0; j < 4; ++j) { const int idx = idx0 + j * nt; if (idx < T * 16) { const int t = idx >> 4, i = idx & 15;
            x1[j] = __builtin_amdgcn_cvt_f32_fp8((int)T8[(size_t)t * T0W + 640 + i], 0); x2[j] = __builtin_amdgcn_cvt_f32_fp8((int)T8[(size_t)t * T0W + 656 + i], 0); c[j] = rope[t * 32 + i]; sn[j] = rope[t * 32 + 16 + i]; } }
#pragma unroll
        for (int j = 0; j < 4; ++j) { const int idx = idx0 + j * nt; if (idx < T * 16) { const int t = idx >> 4, i = idx & 15;
            *(unsigned*)(KR + (size_t)t * 32 + 2 * i) = pk2(x1[j] * c[j] - x2[j] * sn[j], x2[j] * c[j] + x1[j] * sn[j]); } } }
}
__device__ __forceinline__ void attn_simple(Frame& F) {
    const int tid_ = fresh_tid(F.wave), lane_ = tid_ & 63; (void)lane_;
    const bf16_t* Q = (const bf16_t*)(F.ws + WS_Q); const bf16_t* KN = (const bf16_t*)(F.ws + WS_KN); const bf16_t* KR = (const bf16_t*)(F.ws + WS_KR);
    const bf16_t* V = (const bf16_t*)(F.ws + WS_V); bf16_t* O = (bf16_t*)(F.ws + WS_O);
    const float scale = 0.10206207261596577f;
    for (int item = ((int)blockIdx.x * NWAVES + F.wave); item < NB * NH * (S / 64); item += (F.G * NWAVES)) {
        const int bh = item / (S / 64), qb = item % (S / 64), b = bh >> 3, h = bh & 7, i = qb * 64 + lane_; const size_t t = (size_t)b * S + i;
        u32x4 qp[12]; float o[64]; float m = -1e30f, lsum = 0.f;
#pragma unroll
        for (int c = 0; c < 12; ++c) qp[c] = *(const u32x4*)(Q + t * 768 + h * 96 + c * 8);
#pragma unroll
        for (int d = 0; d < 64; ++d) o[d] = 0.f;
        const int jend = qb * 64 + 63;
        for (int j = 0; j <= jend; ++j) { const size_t tk = (size_t)b * S + j;
            float s = 0.f;
#pragma unroll
            for (int c = 0; c < 8; ++c) { const u32x4 w = *(const u32x4*)(KN + tk * 512 + h * 64 + c * 8);
#pragma unroll
                for (int e = 0; e < 4; ++e) s += lo16(qp[c][e]) * lo16(w[e]) + hi16(qp[c][e]) * hi16(w[e]); }
#pragma unroll
            for (int c = 0; c < 4; ++c) { const u32x4 w = *(const u32x4*)(KR + tk * 32 + c * 8);
#pragma unroll
                for (int e = 0; e < 4; ++e) s += lo16(qp[8 + c][e]) * lo16(w[e]) + hi16(qp[8 + c][e]) * hi16(w[e]); }
            s *= scale;
            const bool ok = j <= i;
            const float mn = ok ? fmaxf(m, s) : m; const float a = __expf(m - mn); const float p = ok ? __expf(s - mn) : 0.f;
            lsum = lsum * a + p; m = mn;
#pragma unroll
            for (int c = 0; c < 8; ++c) { const u32x4 w = *(const u32x4*)(V + tk * 512 + h * 64 + c * 8);
#pragma unroll
                for (int e = 0; e < 4; ++e) { o[c * 8 + 2 * e] = o[c * 8 + 2 * e] * a + p * lo16(w[e]); o[c * 8 + 2 * e + 1] = o[c * 8 + 2 * e + 1] * a + p * hi16(w[e]); } }
        }
        const float il = 1.f / lsum;
#pragma unroll
        for (int c = 0; c < 8; ++c) { u32x4 w;
#pragma unroll
            for (int e = 0; e < 4; ++e) w[e] = pk2(o[c * 8 + 2 * e] * il, o[c * 8 + 2 * e + 1] * il);
            *(u32x4*)(O + t * 512 + h * 64 + c * 8) = w; }
    }
}

namespace att {
constexpr int NW = 8, QBLK = 32, KVBLK = 64, QB = NW * QBLK;
constexpr int SHM_V = 16384, SHM_K = 16384;
constexpr int NVS = 3, NKS = 2;
constexpr int ATT_LDS = NVS * SHM_V + NKS * SHM_K + NW * 64 * 4;
constexpr int QS = 768, KNS = 512, KRS = 32, VS = 512, OS = 512;
constexpr float SCALE = 0.10206207261596577f, THR = 8.f;
constexpr unsigned WBIG = 1u << 30;
typedef short s16x4 __attribute__((ext_vector_type(4)));
typedef float f32x16 __attribute__((ext_vector_type(16)));
#define AT_KSWZ(row, colB) ((row) * 256 + ((colB) ^ (((row) & 7) << 4)))
#define AT_SBAR() __builtin_amdgcn_sched_barrier(0)
__device__ __forceinline__ int v_st(int k, int c) { const int kk = (k & ~0xC) | ((k & 4) << 1) | ((k & 8) >> 1); return ((kk >> 3) * 4 + (c >> 5)) * 512 + ((kk & 7) * 32 + (c & 31)) * 2; }
__device__ __forceinline__ int v_rd_base(int lane) { return ((lane & 3) << 3) | (((lane >> 2) & 3) << 6) | (((lane >> 4) & 1) << 5) | (((lane >> 5) & 1) << 8); }
constexpr int v_rd_off(int d0, int ks, int half) { return d0 * 512 + ks * 4096 + half * 2048; }
__device__ __forceinline__ int crow(int r, int hi) { return (r & 3) + 8 * (r >> 2) + 4 * hi; }
__device__ __forceinline__ unsigned cvtpk(float lo, float hi) { unsigned r; asm volatile("v_cvt_pk_bf16_f32 %0, %1, %2" : "=v"(r) : "v"(lo), "v"(hi)); return r; }
__device__ __forceinline__ void mask_tile(f32x16& p0, f32x16& p1, int dq, unsigned W) {
    const float NEG = -__builtin_inff();
#pragma unroll
    for (int r = 0; r < 16; ++r) { const int c = (r & 3) + 8 * (r >> 2);
        if (dq < c) p0[r] = NEG;
        if (dq < c + 32) p1[r] = NEG; }
}
constexpr float THR2 = 8.f;
template <bool FIRST>
__device__ __forceinline__ void partialSM(f32x16& p0, f32x16& p1, float& mref, f32x16& negm, float& alpha) {
    float pmax = p0[0];
#pragma unroll
    for (int r = 1; r < 16; ++r) pmax = fmaxf(pmax, p0[r]);
#pragma unroll
    for (int r = 0; r < 16; ++r) pmax = fmaxf(pmax, p1[r]);
    { auto rr = __builtin_amdgcn_permlane32_swap(__float_as_uint(pmax), __float_as_uint(pmax), false, false);
      pmax = fmaxf(__uint_as_float(rr[0]), __uint_as_float(rr[1])); }
    alpha = 1.f;
    if (FIRST || __builtin_expect(__any(pmax > THR2), 0)) {
        const float dl = FIRST ? pmax : fmaxf(pmax, 0.f);
        mref += dl;
#pragma unroll
        for (int r = 0; r < 16; ++r) { p0[r] -= dl; p1[r] -= dl; }
#pragma unroll
        for (int r = 0; r < 16; ++r) negm[r] = -mref;
        asm volatile("" : "+v"(negm));
        if (!FIRST) alpha = __builtin_amdgcn_exp2f(-dl);
    }
#pragma unroll
    for (int r = 0; r < 16; ++r) p0[r] = __builtin_amdgcn_exp2f(p0[r]);
}
__device__ __forceinline__ void finishSM(f32x16& p0, f32x16& p1, float alpha, float& l_reg, bf16x8& pa0, bf16x8& pa1, bf16x8& pa2, bf16x8& pa3) {
#pragma unroll
    for (int r = 0; r < 16; ++r) p1[r] = __builtin_amdgcn_exp2f(p1[r]);
    float ps = 0;
#pragma unroll
    for (int r = 0; r < 16; ++r) ps += p0[r];
#pragma unroll
    for (int r = 0; r < 16; ++r) ps += p1[r];
    { auto rr = __builtin_amdgcn_permlane32_swap(__float_as_uint(ps), __float_as_uint(ps), false, false);
      ps = __uint_as_float(rr[0]) + __uint_as_float(rr[1]); }
    l_reg = l_reg * alpha + ps;
#define AT_PK4(P, B_, OUT) do { unsigned a0 = cvtpk(P[B_+0], P[B_+1]), a1 = cvtpk(P[B_+2], P[B_+3]);                          \
        unsigned b0 = cvtpk(P[B_+4], P[B_+5]), b1 = cvtpk(P[B_+6], P[B_+7]);                                             \
        auto r0 = __builtin_amdgcn_permlane32_swap(a0, b0, false, false); auto r1 = __builtin_amdgcn_permlane32_swap(a1, b1, false, false); \
        u32x4 w = {r0[0], r1[0], r0[1], r1[1]}; OUT = *reinterpret_cast<bf16x8*>(&w); } while (0)
    AT_PK4(p0, 0, pa0); AT_PK4(p0, 8, pa1); AT_PK4(p1, 0, pa2); AT_PK4(p1, 8, pa3);
#undef AT_PK4
}
template <int KB>
__device__ __forceinline__ void qkt(f32x16& p0, f32x16& p1, const char* K_lds, int r32, int hi, const bf16x8* qr, const f32x16& negm) {
    p0 = negm; p1 = negm;
    const char* kb[4];
#pragma unroll
    for (int dd = 0; dd < 4; ++dd) kb[dd] = K_lds + KB * SHM_K + AT_KSWZ(r32, (dd * 16 + hi * 8) * 2);
#pragma unroll
    for (int d0 = 0; d0 < 6; ++d0) { const char* a = kb[d0 & 3] + (d0 >> 2) * 128;
        bf16x8 b0 = *reinterpret_cast<const bf16x8*>(a);
        bf16x8 b1 = *reinterpret_cast<const bf16x8*>(a + 32 * 256);
        p0 = __builtin_amdgcn_mfma_f32_32x32x16_bf16(b0, qr[d0], p0, 0, 0, 0);
        p1 = __builtin_amdgcn_mfma_f32_32x32x16_bf16(b1, qr[d0], p1, 0, 0, 0); }
}
template <int VB>
__device__ __forceinline__ void pv_tile(f32x16* o, int vb0, bf16x8 pa0, bf16x8 pa1, bf16x8 pa2, bf16x8 pa3) {
#define AT_TRRD(dst, off) asm volatile("ds_read_b64_tr_b16 %0, %1 offset:%2" : "=&v"(dst) : "v"(vb0), "i"(off) : "memory")
#define AT_PV_D0(d0) do { s16x4 l0, l1, l2, l3, h0, h1, h2, h3; constexpr int b_ = VB * SHM_V + v_rd_off(d0, 0, 0); \
        AT_TRRD(l0, b_); AT_TRRD(h0, b_ + 2048); AT_TRRD(l1, b_ + 4096); AT_TRRD(h1, b_ + 6144); AT_TRRD(l2, b_ + 8192); AT_TRRD(h2, b_ + 10240); AT_TRRD(l3, b_ + 12288); AT_TRRD(h3, b_ + 14336); \
        asm volatile("s_waitcnt lgkmcnt(0)" ::: "memory"); AT_SBAR();   \
        o[d0] = __builtin_amdgcn_mfma_f32_32x32x16_bf16(pa0, (bf16x8){l0[0], l0[1], l0[2], l0[3], h0[0], h0[1], h0[2], h0[3]}, o[d0], 0, 0, 0);   \
        o[d0] = __builtin_amdgcn_mfma_f32_32x32x16_bf16(pa1, (bf16x8){l1[0], l1[1], l1[2], l1[3], h1[0], h1[1], h1[2], h1[3]}, o[d0], 0, 0, 0);   \
        o[d0] = __builtin_amdgcn_mfma_f32_32x32x16_bf16(pa2, (bf16x8){l2[0], l2[1], l2[2], l2[3], h2[0], h2[1], h2[2], h2[3]}, o[d0], 0, 0, 0);   \
        o[d0] = __builtin_amdgcn_mfma_f32_32x32x16_bf16(pa3, (bf16x8){l3[0], l3[1], l3[2], l3[3], h3[0], h3[1], h3[2], h3[3]}, o[d0], 0, 0, 0); } while (0)
    AT_PV_D0(0); AT_PV_D0(1);
#undef AT_PV_D0
#undef AT_TRRD
}
struct BlockRef { const bf16_t* Q; const bf16_t* KN; const bf16_t* KR; const bf16_t* V; bf16_t* O; int P0; };
struct Seam { bf16x8 qr[6]; int v_prev, v_cur, v_next; };
#define AT_VMW() asm volatile("s_waitcnt vmcnt(0)" ::: "memory")
#define AT_VMWN(n) asm volatile("s_waitcnt vmcnt(%0)" :: "i"(n) : "memory")
__device__ __forceinline__ void glds16(const void* gsrc, unsigned lds_dst) { unsigned keep;
    asm volatile("s_mov_b32 %0, m0\n\ts_mov_b32 m0, %2\n\ts_nop 0\n\tglobal_load_lds_dwordx4 %1, off\n\ts_mov_b32 m0, %0" : "=&s"(keep) : "v"(gsrc), "s"(lds_dst) : "memory"); }
#define AT_LANE_CONSTS() \
    const int krow_ = 4 * wid + (lane >> 4), kc_ = (lane & 15) ^ (krow_ & 7); const bool isKR = (kc_ >= 8 && kc_ < 12); \
    const unsigned kstrB = isKR ? (unsigned)(KRS * 2) : (unsigned)(KNS * 2), koffB = (unsigned)krow_ * kstrB + (isKR ? (unsigned)(kc_ - 8) * 16u : (kc_ < 8 ? (unsigned)kc_ * 16u : 0u)); \
    const int vkk_ = wid * 8 + ((lane & 31) >> 2), vk_ = (vkk_ & ~0xC) | ((vkk_ & 4) << 1) | ((vkk_ & 8) >> 1); \
    const unsigned voffB = (unsigned)vk_ * (unsigned)(VS * 2) + (unsigned)(((lane >> 5) * 32 + (lane & 3) * 8) * 2); \
    const unsigned lds0 = (unsigned)(uintptr_t)lds
#define AT_DMA_TILE(ref, k0, kslot, vslot) do { \
        const unsigned kd_ = isKR ? (unsigned)((const char*)(ref).KR - (const char*)(ref).KN) : 0u; \
        const char* ks_ = (const char*)(ref).KN + (kd_ + koffB + (unsigned)(k0) * kstrB); \
        glds16(ks_, (unsigned)__builtin_amdgcn_readfirstlane((int)(lds0 + NVS * SHM_V + (kslot) + wid * 1024))); \
        glds16(ks_ + 32u * kstrB, (unsigned)__builtin_amdgcn_readfirstlane((int)(lds0 + NVS * SHM_V + (kslot) + (wid + 8) * 1024))); \
        glds16((const char*)(ref).V + (voffB + (unsigned)(k0) * (unsigned)(VS * 2)), (unsigned)__builtin_amdgcn_readfirstlane((int)(lds0 + (vslot) + wid * 2048))); } while (0)
#define AT_WAIT_SYNC() do { asm volatile("s_waitcnt vmcnt(0)" ::: "memory"); __syncthreads(); } while (0)
__device__ __forceinline__ void prime(const BlockRef& cur, char* lds, Seam& S, int tid) {
    const int wid = __builtin_amdgcn_readfirstlane(tid >> 6), lane = tid & 63, r32 = lane & 31, hi = lane >> 5;
    AT_LANE_CONSTS();
#pragma unroll
    for (int d0 = 0; d0 < 6; ++d0) S.qr[d0] = *(const bf16x8*)((const char*)cur.Q + (unsigned)(((wid * QBLK + r32) * QS + hi * 8) * 2) + d0 * 32);
    AT_DMA_TILE(cur, 0, 0, 0);
    S.v_prev = SHM_V; S.v_cur = 2 * SHM_V; S.v_next = 0;
}
typedef short v4i16_t __attribute__((ext_vector_type(4)));
__device__ __forceinline__ s16x4 vtr(const LAS char* p) { return __builtin_bit_cast(s16x4, __builtin_amdgcn_ds_read_tr16_b64_v4i16((LAS v4i16_t*)p)); }
#define AT_MFMA(a, b, c) __builtin_amdgcn_mfma_f32_32x32x16_bf16(a, b, c, 0, 0, 0)
#define AT_PIN(x) asm volatile("" : "+v"(x))
__device__ __forceinline__ void block(const BlockRef& cur, const BlockRef& nxt, char* lds, Seam& S, int tid) {
    const int wid = __builtin_amdgcn_readfirstlane(tid >> 6), lane = tid & 63, r32 = lane & 31, hi = lane >> 5;
    const int NT = (cur.P0 + QB - 1) / KVBLK + 1;
    const int qlo = cur.P0 + wid * QBLK, qm = qlo + r32 - 4 * hi;
    float* ws = (float*)(lds + NVS * SHM_V + NKS * SHM_K) + wid * 64; float* li_l = ws, * al_l = ws + 32;
    float mref = 0.f, l_reg = 0; f32x16 o[2] = {}; f32x16 negm = {}; AT_PIN(negm);
    AT_LANE_CONSTS();
    const LAS char* lds3 = (const LAS char*)lds;
    const LAS char* kp[4];
#pragma unroll
    for (int dd = 0; dd < 4; ++dd) kp[dd] = lds3 + NVS * SHM_V + AT_KSWZ(r32, (dd * 16 + hi * 8) * 2);
    const LAS char* vp = lds3 + v_rd_base(lane);
#define AT_KBASE(t) ((t) * KVBLK)
#define AT_MASKT(P0_, P1_, t) do { const int kb_ = AT_KBASE(t); if (kb_ + KVBLK - 1 > qlo) mask_tile(P0_, P1_, qm - kb_, WBIG); } while (0)
#define AT_KF(i, KB) (*(const LAS bf16x8*)(kp[((i) >> 1) & 3] + (KB) * SHM_K + ((i) >> 3) * 128 + ((i) & 1) * 8192))
#define AT_VRD(i, VO) do { vlo[i] = vtr(vp + (VO) + v_rd_off((i) >> 2, (i) & 3, 0)); vhi[i] = vtr(vp + (VO) + v_rd_off((i) >> 2, (i) & 3, 1)); } while (0)
#define AT_VFR(i) (bf16x8){vlo[i][0], vlo[i][1], vlo[i][2], vlo[i][3], vhi[i][0], vhi[i][1], vhi[i][2], vhi[i][3]}
#define AT_PAF(k) __builtin_bit_cast(bf16x8, pw##k)
#define AT_SWAPS(PW) do { auto r0_ = __builtin_amdgcn_permlane32_swap(a0, b0, false, false); auto r1_ = __builtin_amdgcn_permlane32_swap(a1, b1, false, false); PW = (u32x4){r0_[0], r1_[0], r0_[1], r1_[1]}; AT_PIN(PW); } while (0)
#define AT_EX4(X, B) do { X[B] = __builtin_amdgcn_exp2f(X[B]); X[B + 1] = __builtin_amdgcn_exp2f(X[B + 1]); X[B + 2] = __builtin_amdgcn_exp2f(X[B + 2]); X[B + 3] = __builtin_amdgcn_exp2f(X[B + 3]); AT_PIN(X); AT_SBAR(); } while (0)
#define AT_ROWMAX(C0, C1, rm) do { float a_ = fmaxf(fmaxf(C0[0], C0[1]), C1[0]), b_ = fmaxf(fmaxf(C0[2], C0[3]), C1[1]); a_ = fmaxf(fmaxf(a_, C1[2]), C1[3]); \
        _Pragma("unroll") for (int r = 4; r < 16; r += 4) { a_ = fmaxf(fmaxf(a_, C0[r]), C0[r + 1]); b_ = fmaxf(fmaxf(b_, C0[r + 2]), C0[r + 3]); a_ = fmaxf(fmaxf(a_, C1[r]), C1[r + 1]); b_ = fmaxf(fmaxf(b_, C1[r + 2]), C1[r + 3]); } \
        rm = fmaxf(a_, b_); { auto rr_ = __builtin_amdgcn_permlane32_swap(__float_as_uint(rm), __float_as_uint(rm), false, false); rm = fmaxf(__uint_as_float(rr_[0]), __uint_as_float(rr_[1])); } } while (0)
#define AT_PHASE_A(C0, C1, P0, P1, KB, VB) do { \
        kf[0] = AT_KF(0, KB); kf[1] = AT_KF(1, KB); kf[2] = AT_KF(2, KB); kf[3] = AT_KF(3, KB); AT_SBAR(); \
        sacc = P0[0] + P0[1]; \
        C0 = AT_MFMA(kf[0], S.qr[0], negm); kf[4] = AT_KF(4, KB); sacc += P0[2]; sacc += P0[3]; a0 = cvt_pk(P0[0], P0[1]); a1 = cvt_pk(P0[2], P0[3]); AT_PIN(a0); AT_PIN(a1); AT_PIN(sacc); AT_SBAR(); \
        C1 = AT_MFMA(kf[1], S.qr[0], negm); kf[5] = AT_KF(5, KB); sacc += P0[4]; sacc += P0[5]; sacc += P0[6]; b0 = cvt_pk(P0[4], P0[5]); b1 = cvt_pk(P0[6], P0[7]); AT_PIN(b0); AT_PIN(b1); AT_PIN(sacc); AT_SBAR(); \
        C0 = AT_MFMA(kf[2], S.qr[1], C0); kf[6] = AT_KF(6, KB); sacc += P0[7]; sacc += P0[8]; sacc += P0[9]; AT_SWAPS(pw0); AT_PIN(sacc); AT_SBAR(); \
        C1 = AT_MFMA(kf[3], S.qr[1], C1); kf[7] = AT_KF(7, KB); sacc += P0[10]; sacc += P0[11]; sacc += P0[12]; a0 = cvt_pk(P0[8], P0[9]); a1 = cvt_pk(P0[10], P0[11]); AT_PIN(a0); AT_PIN(a1); AT_PIN(sacc); AT_SBAR(); \
        C0 = AT_MFMA(kf[4], S.qr[2], C0); kf[8] = AT_KF(8, KB); sacc += P0[13]; sacc += P0[14]; sacc += P0[15]; b0 = cvt_pk(P0[12], P0[13]); b1 = cvt_pk(P0[14], P0[15]); AT_PIN(b0); AT_PIN(b1); AT_PIN(sacc); AT_SBAR(); \
        C1 = AT_MFMA(kf[5], S.qr[2], C1); kf[9] = AT_KF(9, KB); sacc += P1[0]; sacc += P1[1]; sacc += P1[2]; AT_SWAPS(pw1); AT_PIN(sacc); AT_SBAR(); \
        C0 = AT_MFMA(kf[6], S.qr[3], C0); kf[10] = AT_KF(10, KB); sacc += P1[3]; sacc += P1[4]; sacc += P1[5]; a0 = cvt_pk(P1[0], P1[1]); a1 = cvt_pk(P1[2], P1[3]); AT_PIN(a0); AT_PIN(a1); AT_PIN(sacc); AT_SBAR(); \
        C1 = AT_MFMA(kf[7], S.qr[3], C1); kf[11] = AT_KF(11, KB); sacc += P1[6]; sacc += P1[7]; sacc += P1[8]; b0 = cvt_pk(P1[4], P1[5]); b1 = cvt_pk(P1[6], P1[7]); AT_PIN(b0); AT_PIN(b1); AT_PIN(sacc); AT_SBAR(); \
        C0 = AT_MFMA(kf[8], S.qr[4], C0);  sacc += P1[9]; sacc += P1[10]; sacc += P1[11]; AT_SWAPS(pw2); AT_PIN(sacc); AT_SBAR(); \
        C1 = AT_MFMA(kf[9], S.qr[4], C1);  sacc += P1[12]; sacc += P1[13]; sacc += P1[14]; a0 = cvt_pk(P1[8], P1[9]); a1 = cvt_pk(P1[10], P1[11]); AT_PIN(a0); AT_PIN(a1); AT_PIN(sacc); AT_SBAR(); \
        C0 = AT_MFMA(kf[10], S.qr[5], C0); sacc += P1[15]; b0 = cvt_pk(P1[12], P1[13]); b1 = cvt_pk(P1[14], P1[15]); AT_PIN(b0); AT_PIN(b1); AT_PIN(sacc); AT_SBAR(); \
        C1 = AT_MFMA(kf[11], S.qr[5], C1); AT_SWAPS(pw3); AT_SBAR(); \
        l_reg += sacc; } while (0)
#define AT_DECIDE(C0, C1) do { float rm_; AT_ROWMAX(C0, C1, rm_); resc = false; \
        if (__builtin_expect(__any(rm_ > THR2), 0)) { const float dl_ = fmaxf(rm_, 0.f); mref += dl_; \
            _Pragma("unroll") for (int r = 0; r < 16; ++r) { C0[r] -= dl_; C1[r] -= dl_; } \
            _Pragma("unroll") for (int r = 0; r < 16; ++r) negm[r] = -mref; AT_PIN(negm); \
            fsc = __builtin_amdgcn_exp2f(-dl_); l_reg *= fsc; resc = true; } AT_SBAR(); } while (0)
#define AT_PHASE_B(C0, C1, VB) do { AT_VRD(0, VB); AT_VRD(4, VB); AT_SBAR(); \
        o[0] = AT_MFMA(AT_PAF(0), AT_VFR(0), o[0]); AT_VRD(1, VB); AT_EX4(C0, 0); \
        o[1] = AT_MFMA(AT_PAF(0), AT_VFR(4), o[1]); AT_VRD(5, VB); AT_EX4(C0, 4); \
        o[0] = AT_MFMA(AT_PAF(1), AT_VFR(1), o[0]); AT_VRD(2, VB); AT_EX4(C0, 8); \
        o[1] = AT_MFMA(AT_PAF(1), AT_VFR(5), o[1]); AT_VRD(6, VB); AT_EX4(C0, 12); \
        o[0] = AT_MFMA(AT_PAF(2), AT_VFR(2), o[0]); AT_VRD(3, VB); AT_EX4(C1, 0); \
        o[1] = AT_MFMA(AT_PAF(2), AT_VFR(6), o[1]); AT_VRD(7, VB); AT_EX4(C1, 4); \
        o[0] = AT_MFMA(AT_PAF(3), AT_VFR(3), o[0]); AT_EX4(C1, 8); \
        o[1] = AT_MFMA(AT_PAF(3), AT_VFR(7), o[1]); AT_EX4(C1, 12); } while (0)
#define AT_RESC() do { if (resc) { if (hi == 0) al_l[r32] = fsc; asm volatile("s_waitcnt lgkmcnt(0)" ::: "memory");              \
                     for (int d_ = 0; d_ < 2; ++d_) for (int r = 0; r < 16; ++r) o[d_][r] *= al_l[crow(r, hi)]; } } while (0)
    f32x16 pA0, pA1, pB0, pB1; bf16x8 kf[12]; s16x4 vlo[8], vhi[8]; u32x4 pw0, pw1, pw2, pw3; unsigned a0, a1, b0, b1; float sacc, fsc = 1.f; bool resc = false;
    int v_prev = S.v_prev, v_cur = S.v_cur, v_next = S.v_next;
#define AT_ROT() do { v_prev = v_cur; v_cur = v_next; v_next = (v_next == (NVS - 1) * SHM_V) ? 0 : v_next + SHM_V; } while (0)
    AT_WAIT_SYNC(); AT_ROT();
    AT_DMA_TILE(cur, AT_KBASE(1), SHM_K, v_next);
#pragma unroll
    for (int i = 0; i < 12; ++i) kf[i] = AT_KF(i, 0);
    pA0 = AT_MFMA(kf[0], S.qr[0], negm); pA1 = AT_MFMA(kf[1], S.qr[0], negm);
#pragma unroll
    for (int i = 2; i < 12; i += 2) { pA0 = AT_MFMA(kf[i], S.qr[i >> 1], pA0); pA1 = AT_MFMA(kf[i + 1], S.qr[i >> 1], pA1); }
    AT_MASKT(pA0, pA1, 0);
    { float rm_; AT_ROWMAX(pA0, pA1, rm_); mref = rm_;
#pragma unroll
      for (int r = 0; r < 16; ++r) { pA0[r] -= rm_; pA1[r] -= rm_; }
#pragma unroll
      for (int r = 0; r < 16; ++r) negm[r] = -mref;
      AT_PIN(negm);
#pragma unroll
      for (int r = 0; r < 16; ++r) { pA0[r] = __builtin_amdgcn_exp2f(pA0[r]); pA1[r] = __builtin_amdgcn_exp2f(pA1[r]); } }
    AT_WAIT_SYNC(); AT_ROT();
#define AT_STEP(C0, C1, P0, P1, t, KB) do { AT_SBAR();                                                                         \
        AT_DMA_TILE(cur, AT_KBASE((t) + 1), (1 - (KB)) * SHM_K, v_next); AT_SBAR();                                            \
        AT_PHASE_A(C0, C1, P0, P1, KB, 0);                                                                                    \
        AT_MASKT(C0, C1, (t)); AT_DECIDE(C0, C1);                                                                             \
        AT_PHASE_B(C0, C1, v_prev);                                                                                           \
        AT_RESC(); AT_WAIT_SYNC(); AT_ROT(); } while (0)
    for (int t = 1; t + 1 < NT; t += 2) {
        AT_STEP(pB0, pB1, pA0, pA1, t, 1);
        AT_STEP(pA0, pA1, pB0, pB1, t + 1, 0);
    }
    AT_SBAR();
    BlockRef nx = nxt;
    asm volatile("" : "+s"(nx.Q), "+s"(nx.KN), "+s"(nx.KR), "+s"(nx.V));
    AT_DMA_TILE(nx, 0, 0, v_next); AT_SBAR();
    AT_PHASE_A(pB0, pB1, pA0, pA1, 1, 0);
#pragma unroll
    for (int d0 = 0; d0 < 6; ++d0) S.qr[d0] = *(const bf16x8*)((const char*)nx.Q + (unsigned)(((wid * QBLK + r32) * QS + hi * 8) * 2) + d0 * 32);
    AT_SBAR();
    AT_MASKT(pB0, pB1, NT - 1); AT_DECIDE(pB0, pB1);
    AT_PHASE_B(pB0, pB1, v_prev);
    AT_RESC();
    { sacc = pB0[0] + pB0[1];
#pragma unroll
      for (int r = 2; r < 16; ++r) sacc += pB0[r];
#pragma unroll
      for (int r = 0; r < 16; ++r) sacc += pB1[r];
      l_reg += sacc;
#pragma unroll
      for (int i = 0; i < 8; ++i) AT_VRD(i, v_cur);
      a0 = cvt_pk(pB0[0], pB0[1]); a1 = cvt_pk(pB0[2], pB0[3]); b0 = cvt_pk(pB0[4], pB0[5]); b1 = cvt_pk(pB0[6], pB0[7]); AT_SWAPS(pw0);
      a0 = cvt_pk(pB0[8], pB0[9]); a1 = cvt_pk(pB0[10], pB0[11]); b0 = cvt_pk(pB0[12], pB0[13]); b1 = cvt_pk(pB0[14], pB0[15]); AT_SWAPS(pw1);
      a0 = cvt_pk(pB1[0], pB1[1]); a1 = cvt_pk(pB1[2], pB1[3]); b0 = cvt_pk(pB1[4], pB1[5]); b1 = cvt_pk(pB1[6], pB1[7]); AT_SWAPS(pw2);
      a0 = cvt_pk(pB1[8], pB1[9]); a1 = cvt_pk(pB1[10], pB1[11]); b0 = cvt_pk(pB1[12], pB1[13]); b1 = cvt_pk(pB1[14], pB1[15]); AT_SWAPS(pw3);
      o[0] = AT_MFMA(AT_PAF(0), AT_VFR(0), o[0]); o[1] = AT_MFMA(AT_PAF(0), AT_VFR(4), o[1]); o[0] = AT_MFMA(AT_PAF(1), AT_VFR(1), o[0]); o[1] = AT_MFMA(AT_PAF(1), AT_VFR(5), o[1]);
      o[0] = AT_MFMA(AT_PAF(2), AT_VFR(2), o[0]); o[1] = AT_MFMA(AT_PAF(2), AT_VFR(6), o[1]); o[0] = AT_MFMA(AT_PAF(3), AT_VFR(3), o[0]); o[1] = AT_MFMA(AT_PAF(3), AT_VFR(7), o[1]); }
    S.v_prev = v_prev; S.v_cur = v_cur; S.v_next = v_next;
    { auto rr = __builtin_amdgcn_permlane32_swap(__float_as_uint(l_reg), __float_as_uint(l_reg), false, false); l_reg = __uint_as_float(rr[0]) + __uint_as_float(rr[1]); }
    if (hi == 0) li_l[r32] = l_reg; asm volatile("s_waitcnt lgkmcnt(0)" ::: "memory");
    float rli[16];
#pragma unroll
    for (int r = 0; r < 16; ++r) rli[r] = __builtin_amdgcn_rcpf(li_l[crow(r, hi)]);
    bf16_t* Oc = cur.O; asm volatile("" : "+s"(Oc));
    bf16_t* Ow = Oc + (size_t)(wid * QBLK) * OS;
#pragma unroll
    for (int r = 0; r < 16; ++r) { const int orow = crow(r, hi);
#pragma unroll
        for (int d0 = 0; d0 < 2; ++d0) { const float v = o[d0][r] * rli[r]; const float vn = __shfl_xor(v, 1);
            if ((r32 & 1) == 0) *(unsigned*)((char*)Ow + (unsigned)((orow * OS + d0 * 32 + r32) * 2)) = cvtpk(v, vn); } }
#undef AT_RESC
#undef AT_ROT
#undef AT_KBASE
#undef AT_MASKT
#undef AT_STEP
#undef AT_PHASE_A
#undef AT_PHASE_B
#undef AT_DECIDE
#undef AT_ROWMAX
#undef AT_EX4
#undef AT_SWAPS
#undef AT_PAF
#undef AT_VFR
#undef AT_VRD
#undef AT_KF
}
__device__ __forceinline__ BlockRef make_ref(int L, int pass, const bf16_t* Q, const bf16_t* KN, const bf16_t* KR, const bf16_t* V, bf16_t* O) {
    const int bh = L >> 3, x = L & 7, b = bh >> 3, h = bh & 7, qb = pass ? 15 - x : x;
    BlockRef r; const size_t row0 = (size_t)b * S;
    r.Q = Q + (row0 + (size_t)qb * QB) * QS + h * 96; r.O = O + (row0 + (size_t)qb * QB) * OS + h * 64;
    r.KN = KN + row0 * KNS + h * 64; r.KR = KR + row0 * KRS; r.V = V + row0 * VS + h * 64; r.P0 = qb * QB;
    return r;
}
__device__ __forceinline__ void phase(char* lds, int tid, int vcu, int G, const bf16_t* Q, const bf16_t* KN, const bf16_t* KR, const bf16_t* V, bf16_t* O) {
    const int total = NB * NH * 8;
    int L = vcu; if (L >= total) return;
    if (__builtin_amdgcn_readfirstlane(tid >> 6) >= 4) __builtin_amdgcn_s_setprio(1);
    int pass = 0;
    BlockRef cur = make_ref(L, 0, Q, KN, KR, V, O);
    Seam S;
    prime(cur, lds, S, tid);
    for (;;) {
        const bool more_pass = pass == 0, more_item = L + G < total, last = !more_pass && !more_item;
        int passn = pass + 1, Ln = L;
        if (!more_pass) { passn = 0; Ln = more_item ? L + G : L; }
        const BlockRef nxt = last ? cur : make_ref(Ln, passn, Q, KN, KR, V, O);
        block(cur, nxt, lds, S, tid);
        if (last) break;
        cur = nxt; pass = passn; L = Ln;
    }
    __builtin_amdgcn_s_setprio(0);
}
#undef AT_VMW
#undef AT_VMWN
#undef AT_LANE_CONSTS
#undef AT_DMA_TILE
#undef AT_WAIT_SYNC
#undef AT_KSWZ
#undef AT_SBAR
}

__device__ __forceinline__ void moe_tables(Frame& F, int l) {
    const int tid_ = fresh_tid(F.wave);
    LAS int* base = (LAS int*)(F.lds + TAB_OFF); LAS int* cntl = (LAS int*)(F.lds + TAB_OFF + 192);
    LAS unsigned char* tile_e = (LAS unsigned char*)(F.lds + TAB_OFF + 320); LAS unsigned short* tile_r = (LAS unsigned short*)(F.lds + TAB_OFF + 896);
    __syncthreads();
    if (F.wave == 0) {
        const int lane = tid_ & 63;
        const int c = lane < NE ? (int)__hip_atomic_load(((unsigned*)F.ws) + CW_CNT + (l * NE + lane) * 64, __ATOMIC_RELAXED, __HIP_MEMORY_SCOPE_AGENT) : 0;
        const int nt = (c + 255) >> 8; int incl = nt;
#pragma unroll
        for (int o = 1; o < 32; o <<= 1) { const int v = __shfl_up(incl, o); if (lane >= o) incl += v; }
        const int excl = incl - nt;
        if (lane < NE) { base[lane] = excl * 256; cntl[lane] = c; for (int k = 0; k < nt; ++k) { tile_e[excl + k] = (unsigned char)lane; tile_r[excl + k] = (unsigned short)k; } }
        if (lane == NE - 1) { base[NE] = incl * 256; base[NE + 1] = incl; } }
    __syncthreads();
}
__device__ __forceinline__ void route_pass(Frame& F, int l, const bf16_t* X, const bool dry) {
    const int tid_ = fresh_tid(F.wave), lane_ = tid_ & 63, c16 = lane_ & 15, q = lane_ >> 4;
    LAS float* LG = (LAS float*)(F.lds + F.wave * 4096);
    const bf16_t* WH = (const bf16_t*)(F.ws + WS_WRT); const bf16_t* WL = WH + 48 * 1024;
    const float* bg = F.in[18] + l * 4; const float* be = F.in[20] + l * NE; const float* gain = F.in[16] + l * D;
    unsigned* rec = (unsigned*)(F.ws + WS_REC); unsigned* list = (unsigned*)(F.ws + WS_LIST); float* rl = (float*)(F.ws + WS_RL);
    const int gw_ = (int)blockIdx.x * NWAVES + F.wave, ngw_ = F.G * NWAVES;
    for (int tile0 = gw_; tile0 < T / 16; tile0 += 2 * ngw_) {
        const int tile1 = tile0 + ngw_; const bool has1 = tile1 < T / 16;
        const int rowA = tile0 * 16 + c16, rowB = (has1 ? tile1 : tile0) * 16 + c16;
        const bf16_t* xa = X + (size_t)rowA * D + 8 * q; const bf16_t* xb = X + (size_t)rowB * D + 8 * q; const float* gr = gain + 8 * q;
        const bf16_t* wh = WH + (size_t)c16 * 1024 + 8 * q; const bf16_t* wl = WL + (size_t)c16 * 1024 + 8 * q;
        f32x4 accA[3], accB[3]; accA[0] = (f32x4){0.f, 0.f, 0.f, 0.f}; accA[1] = accA[0]; accA[2] = accA[0]; accB[0] = accA[0]; accB[1] = accA[0]; accB[2] = accA[0]; float ssA = 0.f, ssB = 0.f;
#pragma unroll 4
        for (int ks = 0; ks < 32; ++ks) {
            const u32x4 xwa = *(const u32x4*)(xa + 32 * ks), xwb = *(const u32x4*)(xb + 32 * ks);
            const f32x4 g0 = *(const f32x4*)(gr + 32 * ks), g1 = *(const f32x4*)(gr + 32 * ks + 4);
            bf16x8 Bh[3], Bl[3];
#pragma unroll
            for (int nt = 0; nt < 3; ++nt) { Bh[nt] = *(const bf16x8*)(wh + (size_t)nt * 16 * 1024 + 32 * ks); Bl[nt] = *(const bf16x8*)(wl + (size_t)nt * 16 * 1024 + 32 * ks); }
#pragma unroll
            for (int h = 0; h < 2; ++h) { const u32x4 xw = h ? xwb : xwa;
                const f32x4 x0 = (f32x4){lo16(xw.x), hi16(xw.x), lo16(xw.y), hi16(xw.y)}, x1 = (f32x4){lo16(xw.z), hi16(xw.z), lo16(xw.w), hi16(xw.w)};
                if (h) ssB += dot8(x0, x1); else ssA += dot8(x0, x1);
                const f32x4 h0 = x0 * g0, h1 = x1 * g1;
                const u32x4 ph = pack8(h0, h1);
                const f32x4 r0 = h0 - (f32x4){lo16(ph.x), hi16(ph.x), lo16(ph.y), hi16(ph.y)}, r1 = h1 - (f32x4){lo16(ph.z), hi16(ph.z), lo16(ph.w), hi16(ph.w)};
                const u32x4 pl = pack8(r0, r1);
                const bf16x8 Ah = __builtin_bit_cast(bf16x8, ph), Al = __builtin_bit_cast(bf16x8, pl);
#pragma unroll
                for (int nt = 0; nt < 3; ++nt) { f32x4 a_ = h ? accB[nt] : accA[nt];
                    a_ = __builtin_amdgcn_mfma_f32_16x16x32_bf16(Ah, Bh[nt], a_, 0, 0, 0);
                    a_ = __builtin_amdgcn_mfma_f32_16x16x32_bf16(Ah, Bl[nt], a_, 0, 0, 0);
                    a_ = __builtin_amdgcn_mfma_f32_16x16x32_bf16(Al, Bh[nt], a_, 0, 0, 0);
                    if (h) accB[nt] = a_; else accA[nt] = a_; } } }
        auto finish = [&](const f32x4 (&acc)[3], float ss, const int row) {
        ss += __shfl_xor(ss, 16); ss += __shfl_xor(ss, 32);
        const float rstd = rsqrtf(ss * (1.f / D) + EPS);
#pragma unroll
        for (int nt = 0; nt < 3; ++nt)
#pragma unroll
            for (int r = 0; r < 4; ++r) LG[(4 * q + r) * 48 + 16 * nt + c16] = acc[nt][r];
        LDS_WAIT(); asm volatile("" ::: "memory");
        if (lane_ < 16 && !dry) {
            const LAS float* lr = LG + lane_ * 48;
            float lg[4], le[32];
#pragma unroll
            for (int n = 0; n < 4; ++n) lg[n] = lr[n] * rstd + bg[n];
#pragma unroll
            for (int n = 0; n < 32; ++n) le[n] = lr[4 + n] * rstd + be[n];
            int gi = 0; float gm = lg[0];
#pragma unroll
            for (int n = 1; n < 4; ++n) if (lg[n] > gm) { gm = lg[n]; gi = n; }
            float gs = 0.f;
#pragma unroll
            for (int n = 0; n < 4; ++n) gs += __expf(lg[n] - gm);
            const float gp = 1.f / gs;
            float es[8];
#pragma unroll
            for (int j = 0; j < 8; ++j) es[j] = gi == 0 ? le[j] : (gi == 1 ? le[8 + j] : (gi == 2 ? le[16 + j] : le[24 + j]));
            int i0 = 0; float m0 = es[0];
#pragma unroll
            for (int j = 1; j < 8; ++j) if (es[j] > m0) { m0 = es[j]; i0 = j; }
            int i1 = -1; float m1 = -3.0e38f;
#pragma unroll
            for (int j = 0; j < 8; ++j) if (j != i0 && es[j] > m1) { m1 = es[j]; i1 = j; }
            const float p1 = __expf(m1 - m0);
            const float w0 = gp / (1.f + p1), w1 = gp * p1 / (1.f + p1);
            const int e0 = gi * 8 + i0, e1 = gi * 8 + i1;
            const unsigned pos0 = __hip_atomic_fetch_add(((unsigned*)F.ws) + CW_CNT + (l * NE + e0) * 64, 1u, __ATOMIC_RELAXED, __HIP_MEMORY_SCOPE_AGENT);
            const unsigned pos1 = __hip_atomic_fetch_add(((unsigned*)F.ws) + CW_CNT + (l * NE + e1) * 64, 1u, __ATOMIC_RELAXED, __HIP_MEMORY_SCOPE_AGENT);
            u32x4 r0 = {(unsigned)e0, pos0, (unsigned)e1, pos1}, r1 = {__float_as_uint(w0), __float_as_uint(w1), __float_as_uint(rstd), 0u};
            *(u32x4*)(rec + (size_t)row * 8) = r0; *(u32x4*)(rec + (size_t)row * 8 + 4) = r1;
            list[(size_t)e0 * T + pos0] = (unsigned)row; rl[(size_t)e0 * T + pos0] = rstd; list[(size_t)e1 * T + pos1] = (unsigned)row; rl[(size_t)e1 * T + pos1] = rstd;
        }
        LDS_WAIT(); asm volatile("" ::: "memory");
        };
        finish(accA, ssA, rowA);
        if (has1) finish(accB, ssB, rowB);
    }
}
__device__ __forceinline__ void prep_small(Frame& F, int l) {
    const int tid_ = fresh_tid(F.wave); const int gt = blockIdx.x * NTHREADS + tid_, nt = F.G * NTHREADS;
    const float* wsrc = F.in[9] + (size_t)l * 4 * 128 * 128; bf16_t* WSG = (bf16_t*)(F.ws + WS_WSG);
    for (int idx = gt; idx < 4 * 128 * 128; idx += nt) { const int t = (idx >> 7) & 127, sidx = idx & 127; WSG[idx] = (bf16_t)f2bf(sidx <= t ? wsrc[idx] : 0.f); }
    const float* wg = F.in[17] + (size_t)l * D * 4; const float* we = F.in[19] + (size_t)l * D * NE; bf16_t* WH = (bf16_t*)(F.ws + WS_WRT); bf16_t* WL = WH + 48 * 1024;
    for (int idx = gt; idx < 48 * 1024; idx += nt) { const int n = idx >> 10, k = idx & 1023;
        const float v = n < 4 ? wg[k * 4 + n] : (n < 36 ? we[k * NE + (n - 4)] : 0.f);
        const unsigned h = f2bf(v); WH[idx] = (bf16_t)h; WL[idx] = (bf16_t)f2bf(v - bf2f(h)); }
}
__device__ __forceinline__ void combine_pass(Frame& F, const bf16_t* Xin, float* RS, float* OUT, const float* gain, bf16_t* H, unsigned char* H8, bool final_out) {
    const int tid_ = fresh_tid(F.wave), lane_ = tid_ & 63; (void)lane_;
    const LAS int* base = (const LAS int*)(F.lds + TAB_OFF); const unsigned* rec = (const unsigned*)(F.ws + WS_REC); const unsigned char* YB = F.ws + WS_YB;
    constexpr int RB = 4;
    f32x4 g[4];
#pragma unroll
    for (int j = 0; j < 4; ++j) g[j] = ((const f32x4*)gain)[lane_ + 64 * j];
    for (int m0 = ((int)blockIdx.x * NWAVES + F.wave); m0 < T; m0 += RB * (F.G * NWAVES)) {
        u32x4 r0[RB], r1[RB]; u32x2 xv[RB][4]; unsigned ya[RB][4], yb[RB][4];
#pragma unroll
        for (int r = 0; r < RB; ++r) { const int m = m0 + r * (F.G * NWAVES); if (m < T) { r0[r] = *(const u32x4*)(rec + (size_t)m * 8); r1[r] = *(const u32x4*)(rec + (size_t)m * 8 + 4); } }
#pragma unroll
        for (int r = 0; r < RB; ++r) { const int m = m0 + r * (F.G * NWAVES); if (m < T) {
            const size_t s0 = (size_t)base[r0[r].x] + r0[r].y, s1 = (size_t)base[r0[r].z] + r0[r].w;
            const u32x2* xr = (const u32x2*)(Xin + (size_t)m * D) + lane_;
            const unsigned* y0 = (const unsigned*)(YB + s0 * D) + lane_; const unsigned* y1 = (const unsigned*)(YB + s1 * D) + lane_;
#pragma unroll
            for (int j = 0; j < 4; ++j) { xv[r][j] = xr[64 * j]; ya[r][j] = y0[64 * j]; yb[r][j] = y1[64 * j]; } } }
#pragma unroll
        for (int r = 0; r < RB; ++r) { const int m = m0 + r * (F.G * NWAVES); if (m < T) {
            const float w0 = __uint_as_float(r1[r].x), w1 = __uint_as_float(r1[r].y); float ss = 0.f; f32x4 v[4];
#pragma unroll
            for (int j = 0; j < 4; ++j) { const u32x2 x_ = xv[r][j];
                const f32x2 a0 = __builtin_amdgcn_cvt_pk_f32_fp8((int)ya[r][j], false), a1 = __builtin_amdgcn_cvt_pk_f32_fp8((int)ya[r][j], true), b0 = __builtin_amdgcn_cvt_pk_f32_fp8((int)yb[r][j], false), b1 = __builtin_amdgcn_cvt_pk_f32_fp8((int)yb[r][j], true);
                v[j].x = lo16(x_.x) + w0 * a0[0] + w1 * b0[0]; v[j].y = hi16(x_.x) + w0 * a0[1] + w1 * b0[1]; v[j].z = lo16(x_.y) + w0 * a1[0] + w1 * b1[0]; v[j].w = hi16(x_.y) + w0 * a1[1] + w1 * b1[1];
                ss += (v[j].x * v[j].x + v[j].y * v[j].y) + (v[j].z * v[j].z + v[j].w * v[j].w); }
            const float ms = wave_sum(ss) * (1.f / D) + EPS, rstd = rsqrtf(ms);
            if (final_out) { f32x4* o = (f32x4*)(OUT + (size_t)m * D) + lane_;
#pragma unroll
                for (int j = 0; j < 4; ++j) o[64 * j] = (f32x4){v[j].x * rstd * g[j].x, v[j].y * rstd * g[j].y, v[j].z * rstd * g[j].z, v[j].w * rstd * g[j].w};
            } else {
                u32x2* o = (u32x2*)(H + (size_t)m * D) + lane_; if (lane_ == 0) RS[m] = ms * rstd;
#pragma unroll
                for (int j = 0; j < 4; ++j) { u32x2 w;
                    w.x = cvt_pk(v[j].x * rstd * g[j].x, v[j].y * rstd * g[j].y); w.y = cvt_pk(v[j].z * rstd * g[j].z, v[j].w * rstd * g[j].w); o[64 * j] = w; }
                unsigned* o8 = (unsigned*)(H8 + (size_t)m * D) + lane_;
#pragma unroll
                for (int j = 0; j < 4; ++j) o8[64 * j] = pk4f8(v[j].x * rstd * g[j].x, v[j].y * rstd * g[j].y, v[j].z * rstd * g[j].z, v[j].w * rstd * g[j].w);
            } } }
    }
}
template <int KK, int NperE, bool FP8 = false, class Fn>
__device__ __forceinline__ void gemm_moe(Frame& F, const bf16_t* A, const bf16_t* Bt, const Fn& f) {
    const LAS int* base = (const LAS int*)(F.lds + TAB_OFF);
    pg8::Gemm g{A, Bt}; pg8::MoeOrder So{(const LAS unsigned char*)(F.lds + TAB_OFF + 320), base[NE + 1], NperE / 256, F.G, (int)blockIdx.x};
    pg8::Epi8<Fn> E{f};
    pg8::gemm_phase<pg8::Epi8<Fn>, pg8::MoeOrder, KK, KK, KK, true, false, FP8>(F.lds, F.wave, g, So, E);
}

constexpr int PH_PER_LAYER = 9, N_PHASES = 1 + DEPTH * PH_PER_LAYER;
struct Args { const float* in[24]; float* out; unsigned char* ws; int ph_lo, ph_hi; };
#ifndef PHSEL
#define PHSEL -1
#endif
#ifndef REPEAT_MASK
#define REPEAT_MASK 0
#endif
#define REP(k) for (int rep_ = 0; rep_ < 1 + ((REPEAT_MASK >> (k)) & 1); ++rep_)
#define PHOK(j) (PHSEL < 0 || PHSEL == (j))
#define IN(k) (lo <= (k) && (k) < hi)
#define SEAM(k) do { if (IN(k) && IN((k) + 1)) xcd_barrier(bar, fresh_tid(F.wave) == 0); } while (0)
template <int l>
__device__ __forceinline__ void layer_body(Frame& F, const XcdBarrier& bar, const int lo, const int hi) {
    unsigned char* ws = F.ws; unsigned char* wt = ws + WS_WT;
    bf16_t* H = (bf16_t*)(ws + WS_H);
    constexpr int pb = 1 + l * PH_PER_LAYER;
    bf16_t* XS = (bf16_t*)F.out;
    bf16_t* xnew = (l + 1 < DEPTH) ? XS : (bf16_t*)(ws + WS_X1);
    if (PHOK(1) && IN(pb + 0)) {
        { EpiP1<true> E{(bf16_t*)(ws + WS_T0), (bf16_t*)(ws + WS_SGU), (bf16_t*)(ws + WS_GV), (bf16_t*)(ws + WS_CB), (bf16_t*)(ws + WS_Z), (float*)(ws + WS_ST0), (float*)(ws + WS_STV)};
          REP(0) gemm_dense<D / 2, D / 2, N_F8A, D / 2, true>(F, (const bf16_t*)(ws + WS_H8), (const bf16_t*)(wt + WT_WT8), E); }
        { EpiP1<false> E{(bf16_t*)(ws + WS_T0), (bf16_t*)(ws + WS_SGU), (bf16_t*)(ws + WS_GV), (bf16_t*)(ws + WS_CB), (bf16_t*)(ws + WS_Z), (float*)(ws + WS_ST0), (float*)(ws + WS_STV)};
          REP(0) gemm_dense<D, D, N_P1 - N_F8A, D>(F, H, (const bf16_t*)(wt + WT_WIN) + (size_t)N_F8A * D, E); } }
    SEAM(pb + 0);
    if (PHOK(2) && IN(pb + 1)) {
        const bool pass_first = (((int)blockIdx.x >> 3) & 1) != 0;
        if (pass_first) { sgmix_pass(F, l, (bf16_t*)(ws + WS_SGU)); conv_pass(F, l, (bf16_t*)(ws + WS_CB)); krope_pass(F); asm volatile("s_waitcnt vmcnt(0)" ::: "memory"); __syncthreads(); }
        { pg8::Epi8L<FnQ8, 2> E{{(bf16_t*)(ws + WS_Q), (const float*)(ws + WS_ST0), (const float*)(ws + WS_ROPE)}};
          REP(1) gemm_dense<T0W / 2, WQ8_LD / 2, 768, WQ8_LD / 2, true>(F, (const bf16_t*)(ws + WS_T0 + 256), (const bf16_t*)(wt + WT_WQ), E); }
        { pg8::Epi8A<FnKV8> E{{(bf16_t*)(ws + WS_KN), (bf16_t*)(ws + WS_V), (const float*)(ws + WS_ST0)}};
          REP(1) gemm_dense<T0W / 2, KVR / 2, 1024, KVR / 2, true>(F, (const bf16_t*)(ws + WS_T0), (const bf16_t*)(wt + WT_WKV), E); }
        if ((REPEAT_MASK >> 12) & 1) sgmix_pass(F, l, (bf16_t*)(ws + WS_GB)); if ((REPEAT_MASK >> 13) & 1) conv_pass(F, l, (bf16_t*)(ws + WS_GB));
        if (!pass_first) { sgmix_pass(F, l, (bf16_t*)(ws + WS_SGU)); conv_pass(F, l, (bf16_t*)(ws + WS_CB)); REP(11) krope_pass(F); }
    }
    SEAM(pb + 1);
    if (PHOK(3) && IN(pb + 2)) {
        const bool attn_first = (((int)blockIdx.x >> 3) & 1) != 0;
        const int vcu = (F.G % 8 == 0) ? ((int)blockIdx.x % 8) * (F.G / 8) + (int)blockIdx.x / 8 : (int)blockIdx.x;
        if (attn_first) { REP(3) att::phase((char*)F.lds_generic, fresh_tid(F.wave), vcu, F.G, (const bf16_t*)(ws + WS_Q), (const bf16_t*)(ws + WS_KN), (const bf16_t*)(ws + WS_KR), (const bf16_t*)(ws + WS_V), (bf16_t*)(ws + WS_O));
            asm volatile("s_waitcnt vmcnt(0)" ::: "memory"); __syncthreads(); }
        { pg8::Epi8<FnGates8> E{{ws}};
          REP(2) gemm_dense<D / 2, D / 2, N_GATES, D / 2, true>(F, (const bf16_t*)(ws + WS_H8), (const bf16_t*)(wt + WT_WG8), E); }
        if (!attn_first) { REP(3) att::phase((char*)F.lds_generic, fresh_tid(F.wave), vcu, F.G, (const bf16_t*)(ws + WS_Q), (const bf16_t*)(ws + WS_KN), (const bf16_t*)(ws + WS_KR), (const bf16_t*)(ws + WS_V), (bf16_t*)(ws + WS_O)); }
    }
    SEAM(pb + 2);
    if (PHOK(4) && IN(pb + 3)) {
        REP(4) {
        pg8::Gemm g{(const bf16_t*)ws, (const bf16_t*)ws};
        constexpr size_t TS = (size_t)256 * 512 * 2;
        static_assert(WS_SGU % TS == 0 && WS_CB % TS == 0 && WS_O % TS == 0 && (WS_WT + WT_WA) % TS == 0 && (WS_WT + WT_WB) % TS == 0 && (WS_WT + WT_WC) % TS == 0, "branch buffers must sit on 256 KiB boundaries");
        pg8::ChainOrder So; So.so.init(T, D, F.G, (int)blockIdx.x);
        EpiChain E{(bf16_t*)(ws + WS_MRG), ws};
        pg8::gemm_phase<EpiChain, pg8::ChainOrder, 512, 512, 512>(F.lds, F.wave, g, So, E);
        }
    }
    SEAM(pb + 3);
    if (PHOK(5) && IN(pb + 4)) {
        EpiResH E{H, (const float*)(ws + WS_RS), F.in[2] + l * D, xnew, ws + WS_XB};
        REP(5) gemm_dense<D, D, D, D>(F, (const bf16_t*)(ws + WS_MRG), (const bf16_t*)(wt + WT_WO), E); }
    SEAM(pb + 4);
    if (PHOK(6) && IN(pb + 5)) { REP(8) convert_moe_weights(F, l); if ((REPEAT_MASK >> 10) & 1) route_pass(F, l, xnew, true); route_pass(F, l, xnew, false); }
    SEAM(pb + 5);
    if (PHOK(7) && IN(pb + 6)) { moe_tables(F, l);
        const LAS int* base = (const LAS int*)(F.lds + TAB_OFF);
        pg8::Gemm g{(const bf16_t*)(ws + WS_XB), (const bf16_t*)(ws + WS_WGU)};
        pg8::MoeGatherOrder So{(const LAS unsigned char*)(F.lds + TAB_OFF + 320), (const LAS unsigned short*)(F.lds + TAB_OFF + 896), (const LAS int*)(F.lds + TAB_OFF + 192), (const unsigned*)(ws + WS_LIST), base[NE + 1], 2, F.G, (int)blockIdx.x};
        pg8::Epi8A<FnMoe1G> E{{(bf16_t*)(ws + WS_ACT), (const float*)(ws + WS_RL)}};
        REP(6) pg8::gemm_phase<pg8::Epi8A<FnMoe1G>, pg8::MoeGatherOrder, D / 2, D / 2, D / 2, true, true, true>(F.lds, F.wave, g, So, E); }
    SEAM(pb + 6);
    if (PHOK(8) && IN(pb + 7)) { moe_tables(F, l); FnMoe2_8 f{ws + WS_YB}; REP(7) gemm_moe<DE / 2, D, true>(F, (const bf16_t*)(ws + WS_ACT), (const bf16_t*)(ws + WS_WD), f);
        if (l + 1 < DEPTH) { convert_mixer_weights(F, l + 1); prep_small(F, l + 1); } }
    SEAM(pb + 7);
    if (PHOK(9) && IN(pb + 8)) { moe_tables(F, l);
        if (l + 1 < DEPTH) combine_pass(F, xnew, (float*)(ws + WS_RS), nullptr, F.in[2] + (l + 1) * D, H, ws + WS_H8, false); else combine_pass(F, xnew, nullptr, F.out, F.in[23], H, ws + WS_H8, true); }
    SEAM(pb + 8);
}
__global__ void __launch_bounds__(NTHREADS, 2) fwd(Args args) {
    extern __shared__ __attribute__((aligned(16))) unsigned char lds_raw[];
    Frame F;
    F.lds = (LAS unsigned char*)lds_raw; F.lds_generic = lds_raw; F.ws = args.ws;
    F.wave = __builtin_amdgcn_readfirstlane((int)threadIdx.x >> 6); F.G = gridDim.x;
    F.in = args.in;
    F.out = args.out;
    volatile LAS unsigned* MISC = (volatile LAS unsigned*)(F.lds + MISC_OFF);
    if (threadIdx.x < 32) MISC[threadIdx.x] = 0u;
    __syncthreads();
    XcdBarrier bar; bar.bar = ((unsigned*)F.ws) + CW_BAR; bar.x = 0; bar.st = nullptr;
    const int lo = args.ph_lo, hi = args.ph_hi;
    if (hi - lo > 1) bar = xcd_barrier_post(((unsigned*)F.ws) + CW_BAR, MISC + 8);
    if (PHOK(0) && IN(0)) REP(9) { convert_mixer_weights(F, 0); prep_small(F, 0); rope_table(F); norm_rows_bf16(F, F.in[0], F.in[2], (bf16_t*)(F.ws + WS_H), F.ws + WS_H8, (float*)(F.ws + WS_RS)); }
    SEAM(0);
    layer_body<0>(F, bar, lo, hi);
    layer_body<1>(F, bar, lo, hi);
}
#undef IN
#undef SEAM

extern "C" void kernel_launch(void* const* d_in, const int* in_sizes, int n_in, void* d_out, int out_size, void* d_ws, size_t ws_size, hipStream_t stream) {
    static int grid = 0;
    if (grid == 0) {
        if (n_in != 24 || out_size != T * D || ws_size < WS_END) { fprintf(stderr, "kernel_launch: unexpected shapes (n_in %d, out %d, ws %zu)\n", n_in, out_size, ws_size); grid = -1; return; }
        int dev = 0, cus = 0;
        if (hipGetDevice(&dev) != hipSuccess || hipDeviceGetAttribute(&cus, hipDeviceAttributeMultiprocessorCount, dev) != hipSuccess) { grid = -1; return; }
        if (hipFuncSetAttribute((const void*)fwd, hipFuncAttributeMaxDynamicSharedMemorySize, LDS_BYTES) != hipSuccess) { fprintf(stderr, "kernel_launch: hipFuncSetAttribute failed\n"); grid = -1; return; }
        int per_cu = 0;
        if (hipOccupancyMaxActiveBlocksPerMultiprocessor(&per_cu, (const void*)fwd, NTHREADS, LDS_BYTES) != hipSuccess || per_cu < 1) fprintf(stderr, "kernel_launch: occupancy query says %d\n", per_cu);
        (void)hipGetLastError();
        grid = cus;
    }
    if (grid < 0) return;
    (void)hipMemsetAsync((char*)d_ws + WS_CTL, 0, CTL_ZERO_BYTES, stream);
    Args a{};
    for (int i = 0; i < 24; ++i) a.in[i] = (const float*)d_in[i];
    a.out = (float*)d_out; a.ws = (unsigned char*)d_ws;
#if MK_ONE_LAUNCH
    a.ph_lo = 0; a.ph_hi = N_PHASES;
    hipLaunchKernelGGL(fwd, dim3(grid), dim3(NTHREADS), LDS_BYTES, stream, a);
#else
    for (int p = 0; p < N_PHASES; ++p) { a.ph_lo = p; a.ph_hi = p + 1; hipLaunchKernelGGL(fwd, dim3(grid), dim3(NTHREADS), LDS_BYTES, stream, a); }
#endif
}
```

```cpp
#include <hip/hip_runtime.h>
#include <cstdio>
#include <cstdint>

#ifndef MK_ONE_LAUNCH
#define MK_ONE_LAUNCH 1
#endif
#ifndef FAST_ATTN
#define FAST_ATTN 1
#endif

#define GAS __attribute__((address_space(1)))
#define LAS __attribute__((address_space(3)))
typedef unsigned short bf16_t;
typedef short bf16x8 __attribute__((ext_vector_type(8)));
typedef float f32x4 __attribute__((ext_vector_type(4)));
typedef float f32x2 __attribute__((ext_vector_type(2)));
typedef unsigned u32x4 __attribute__((ext_vector_type(4)));
typedef unsigned u32x2 __attribute__((ext_vector_type(2)));

constexpr int D = 1024, NB = 16, S = 4096, T = NB * S, DEPTH = 2;
constexpr int NH = 8, NOPE = 64, ROPE = 32, QKH = 96, VH = 64, QR = 384, KVR = 256;
constexpr int SGW = 512, CW = 512, DIN = 6304, NE = 32, DE = 256;
constexpr float EPS = 1e-6f;
constexpr int C_CQ = 0, C_CKV = 384, C_KR = 640, C_SGU = 672, C_SGV = 1184, C_CB = 1696, C_CC = 2208, C_CH = 2720, C_GA = 3232, C_GB = 4256, C_GC = 5280;
constexpr int N_P1 = 3328, N_GATES = 3072, N_WIN = N_P1 + N_GATES;
constexpr int T0W = 768;
constexpr int N_F8A = 1280;
constexpr int WQ8_LD = 512;

constexpr size_t MiB = 1u << 20;
constexpr size_t WS_CTL = 0, CTL_ZERO_BYTES = 1 * MiB;
constexpr size_t WS_WSG = 1 * MiB;
constexpr size_t WS_WRT = 1 * MiB + 128 * 1024;
constexpr size_t WS_ROPE = 2 * MiB;
constexpr size_t WS_WT = 10 * MiB;
constexpr size_t WT_WIN = 0, WT_WQ = 13 * MiB, WT_WKV = 14 * MiB, WT_WA = 15 * MiB, WT_WB = 16 * MiB, WT_WC = 17 * MiB, WT_WO = 18 * MiB;
constexpr size_t WS_REC = 30 * MiB;
constexpr size_t WS_H = 32 * MiB;
constexpr size_t WS_T0 = 160 * MiB;
constexpr size_t WS_GV = 256 * MiB;
constexpr size_t WS_Z = 320 * MiB;
constexpr size_t WS_SGU = 384 * MiB;
constexpr size_t WS_CB = 448 * MiB;
constexpr size_t WS_KN = 512 * MiB;
constexpr size_t WS_V = 576 * MiB;
constexpr size_t WS_GB = 640 * MiB;
constexpr size_t WS_GC = 768 * MiB;
constexpr size_t WS_Q = 896 * MiB;
constexpr size_t WS_KR = 992 * MiB;
constexpr size_t WS_ST0 = 996 * MiB;
constexpr size_t WS_STV = 1000 * MiB;
constexpr size_t WS_RS = 1002 * MiB;
constexpr size_t WS_END = 1003 * MiB;
constexpr size_t WS_GA = WS_T0, WS_O = WS_Z, WS_MRG = WS_KN;
constexpr size_t WS_H8 = 704 * MiB;
constexpr size_t WT_WT8 = 10 * MiB + 512 * 1024;
constexpr size_t WT_WG8 = 7 * MiB;
constexpr float W8_SCALE = 32.f;
constexpr size_t WS_WGU = 32 * MiB, WS_WD = 64 * MiB, WS_ACT = 80 * MiB;
constexpr size_t WS_XB = 160 * MiB, WS_YB = 432 * MiB;
constexpr size_t WS_X1 = 832 * MiB;
constexpr size_t WS_LIST = 288 * MiB, WS_RL = 296 * MiB;
constexpr int MAX_TILES = 544;
constexpr int CW_TMO = 0, CW_BAR = 4096, CW_CNT = 8192;

#define LDS_WAIT() asm volatile("s_waitcnt lgkmcnt(0)" ::: "memory")
#define VM_WAIT() asm volatile("s_waitcnt vmcnt(0)" ::: "memory")
__device__ __forceinline__ float bf2f(unsigned v) { return __uint_as_float(v << 16); }
__device__ __forceinline__ unsigned f2bf(float f) { unsigned u = __float_as_uint(f); return (u + 0x7fffu + ((u >> 16) & 1u)) >> 16; }
__device__ __forceinline__ unsigned pk2(float lo, float hi) { return f2bf(lo) | (f2bf(hi) << 16); }
__device__ __forceinline__ float lo16(unsigned w) { return __uint_as_float(w << 16); }
__device__ __forceinline__ float hi16(unsigned w) { return __uint_as_float(w & 0xffff0000u); }
__device__ __forceinline__ float wave_sum(float v) {
#pragma unroll
    for (int o = 1; o < 64; o <<= 1) v += __shfl_xor(v, o);
    return v;
}
__device__ __forceinline__ float sigmoidf_(float x) { return 1.f / (1.f + __expf(-x)); }
__device__ __forceinline__ float gelu_tanh(float x) { const float u = 0.7978845608028654f * (x + 0.044715f * x * x * x); return x / (1.f + __expf(-2.f * u)); }
__device__ __forceinline__ float siluf_(float x) { return x / (1.f + __expf(-x)); }
typedef __bf16 bf16x2_t __attribute__((ext_vector_type(2)));
__device__ __forceinline__ unsigned cvt_pk(float lo, float hi) { const f32x2 v = {lo, hi}; const bf16x2_t b = __builtin_convertvector(v, bf16x2_t); return __builtin_bit_cast(unsigned, b); }
__device__ __forceinline__ unsigned pk4f8(float a, float b, float c, float d) { int w = 0; w = __builtin_amdgcn_cvt_pk_fp8_f32(a, b, w, false); w = __builtin_amdgcn_cvt_pk_fp8_f32(c, d, w, true); return (unsigned)w; }
__device__ __forceinline__ u32x4 pack8(const f32x4 a, const f32x4 b) { u32x4 w; w.x = cvt_pk(a[0], a[1]); w.y = cvt_pk(a[2], a[3]); w.z = cvt_pk(b[0], b[1]); w.w = cvt_pk(b[2], b[3]); return w; }
__device__ __forceinline__ float fsigmoid(float x) { return __builtin_amdgcn_rcpf(1.f + __builtin_amdgcn_exp2f(-1.4426950408889634f * x)); }
__device__ __forceinline__ float fgelu(float x) { const float t = x * x; return x * __builtin_amdgcn_rcpf(1.f + __builtin_amdgcn_exp2f(x * (-2.302208198f + -0.102943240f * t))); }
__device__ __forceinline__ f32x4 fgelu4(const f32x4 v) { return (f32x4){fgelu(v[0]), fgelu(v[1]), fgelu(v[2]), fgelu(v[3])}; }
__device__ __forceinline__ float dot8(const f32x4 a, const f32x4 b) { return ((a[0] * a[0] + a[1] * a[1]) + (a[2] * a[2] + a[3] * a[3])) + ((b[0] * b[0] + b[1] * b[1]) + (b[2] * b[2] + b[3] * b[3])); }

#define XB_TMO      128
#define XB_XCNT(j)  (256  + 64 * (j))
#define XB_XSUB(j)  (1280 + 64 * (j))
#define XB_XGEN(j)  (2304 + 64 * (j))
#define XB_TOP      3328
#define XB_TOPGEN   3392
#define XCD_BAR_WORDS 3456
#define XB_SPIN_CAP (1u << 18)
__device__ __forceinline__ unsigned xb_ld(unsigned* p)              { return __hip_atomic_load(p, __ATOMIC_RELAXED, __HIP_MEMORY_SCOPE_AGENT); }
__device__ __forceinline__ unsigned xb_add(unsigned* p, unsigned v) { return __hip_atomic_fetch_add(p, v, __ATOMIC_RELAXED, __HIP_MEMORY_SCOPE_AGENT); }
__device__ __forceinline__ unsigned xb_xcc_id() { return (unsigned)__builtin_amdgcn_s_getreg((3 << 11) | 20) & 0xFu; }
#define XB_SPIN(cond, bar) do { unsigned _sp = 0; while (cond) { __builtin_amdgcn_s_sleep(1); \
    if ((++_sp & 255u) == 0u) { if (xb_ld(&(bar)[XB_TMO])) break; if (_sp > XB_SPIN_CAP) { atomicAdd(&(bar)[XB_TMO], 1u); break; } } } } while (0)
struct XcdBarrier { unsigned* bar; unsigned x; volatile LAS unsigned* st; };
__device__ __forceinline__ XcdBarrier xcd_barrier_post(unsigned* bar, volatile LAS unsigned* st) {
    XcdBarrier b; b.bar = bar; b.x = xb_xcc_id(); b.st = st;
    if (threadIdx.x == 0) (void)xb_add(&bar[XB_XCNT(b.x)], 1u);
    return b;
}
__device__ __forceinline__ void xcd_barrier_complete(unsigned* bar, unsigned x, unsigned& nloc, unsigned& nx) {
    const unsigned G = gridDim.x * gridDim.y * gridDim.z;
    unsigned sum, cnt, mine, sp = 0u;
    for (;;) {
        sum = 0u; cnt = 0u; mine = 0u;
#pragma unroll
        for (unsigned j = 0; j < 16; ++j) { const unsigned c = xb_ld(&bar[XB_XCNT(j)]); sum += c; cnt += (c > 0u) ? 1u : 0u; mine = (j == x) ? c : mine; }
        if (sum == G) break;
        __builtin_amdgcn_s_sleep(1);
        if ((++sp & 255u) == 0u) { if (xb_ld(&bar[XB_TMO])) break; if (sp > XB_SPIN_CAP) { atomicAdd(&bar[XB_TMO], 1u); break; } }
    }
    nloc = mine > 0u ? mine : 1u; nx = cnt > 0u ? cnt : 1u;
}
__device__ __forceinline__ void xcd_barrier(const XcdBarrier& b, const bool is_t0) {
    asm volatile("s_waitcnt vmcnt(0)" ::: "memory");
    __syncthreads();
    if (is_t0) {
        unsigned* bar = b.bar;
        __builtin_amdgcn_s_waitcnt(0);
        unsigned nloc = b.st[0], nx = b.st[1];
        if (nloc == 0u) { xcd_barrier_complete(bar, b.x, nloc, nx); b.st[0] = nloc; b.st[1] = nx; }
        const unsigned old = xb_add(&bar[XB_XSUB(b.x)], 1u);
        const unsigned gen = old / nloc;
        if (old + 1u == (gen + 1u) * nloc) {
            __builtin_amdgcn_fence(__ATOMIC_RELEASE, "agent");
            asm volatile("s_waitcnt vmcnt(0)" ::: "memory");
            const unsigned og = xb_add(&bar[XB_TOP], 1u);
            const unsigned tg = og / nx;
            if (og + 1u == (tg + 1u) * nx) xb_add(&bar[XB_TOPGEN], 1u);
            else XB_SPIN(xb_ld(&bar[XB_TOPGEN]) == tg, bar);
            __builtin_amdgcn_fence(__ATOMIC_ACQUIRE, "agent");
            xb_add(&bar[XB_XGEN(b.x)], 1u);
            asm volatile("s_waitcnt vmcnt(0)" ::: "memory");
        } else {
            XB_SPIN(xb_ld(&bar[XB_XGEN(b.x)]) == gen, bar);
            __builtin_amdgcn_fence(__ATOMIC_ACQUIRE, "agent");
            asm volatile("s_waitcnt vmcnt(0)" ::: "memory");
        }
    }
    __syncthreads();
}

constexpr int RING_BYTES = 131072;
constexpr int TAB_OFF = RING_BYTES;
constexpr int TAB_BYTES = 2048;
constexpr int MISC_OFF = TAB_OFF + TAB_BYTES;
constexpr int LDS_BYTES = 147456;
constexpr int NWAVES = 8, NTHREADS = 512;

__device__ __forceinline__ int fresh_tid(int wave) { int lane; asm volatile("v_mbcnt_lo_u32_b32 %0, -1, 0\n\tv_mbcnt_hi_u32_b32 %0, -1, %0" : "=v"(lane)); return wave * 64 + lane; }
struct Frame {
    LAS unsigned char* lds;
    unsigned char* lds_generic;
    unsigned char* ws;
    int wave, G;
    const float* const* in;
    float* out;
};

struct MapIdent { __device__ __forceinline__ int operator()(int n) const { return n; } };
struct MapWin {
    __device__ __forceinline__ int operator()(int n) const {
        if (n < 256) return C_CKV + n;
        if (n < 640) return C_CQ + (n - 256);
        if (n < 672) return C_KR + (n - 640);
        if (n < 768) return -1;
        if (n < 1280) return C_SGV + (n - 768);
        if (n < 1792) return C_SGU + (n - 1280);
        if (n < 2304) return C_CB + (n - 1792);
        if (n < 3328) { const int j = (n - 2304) >> 1; return (n & 1) ? C_CH + j : C_CC + j; }
        if (n < 4352) return C_GA + (n - 3328);
        if (n < 5376) return C_GB + (n - 4352);
        return C_GC + (n - 5376);
    }
};
struct MapGates { __device__ __forceinline__ int operator()(int n) const { return C_GA + n; } };
struct MapWq {
    __device__ __forceinline__ int operator()(int n) const { const int h = n / 96, d = n - h * 96; if (d < 64) return n; const int j = d - 64, i = j >> 1; return h * 96 + 64 + ((j & 1) ? 16 + i : i); }
};
struct MapWkv {
    __device__ __forceinline__ int operator()(int n) const { const int part = n >> 9, r = n & 511, h = r >> 6, j = r & 63; return h * 128 + part * 64 + j; }
};
struct MapWgu {
    __device__ __forceinline__ int operator()(int n) const { const int j = n >> 1; return (n & 1) ? 256 + j : j; }
};
template <class Map, bool FP8 = false>
__device__ __forceinline__ void transpose_mat(const float* W, int K, int Nsrc, bf16_t* WT, int ndest, const Map map, const float* kscale,
                                              LAS float* scr, int gw, int ngw, int lane, int nmat, size_t src_stride, size_t dst_stride, int ldk = 0  ) {
    const int nblk = ndest / 32, kblk = K / 64, per = nblk * kblk;
    for (int it = gw; it < per * nmat; it += ngw) {
        const int mat = it / per, r = it - mat * per, kb = r / nblk, nb = r - kb * nblk, k0 = kb * 64, n0 = nb * 32;
        const float* Wm = W + (size_t)mat * src_stride; bf16_t* WTm = WT + (size_t)mat * dst_stride;
        const int sc = map(n0 + (lane & 31)); const float msk = sc >= 0 ? 1.f : 0.f;
        const float* src = Wm + (size_t)(k0 + (lane >> 5)) * Nsrc + (sc >= 0 ? sc : 0);
        float v[32];
#pragma unroll
        for (int i = 0; i < 32; ++i) v[i] = src[(size_t)(2 * i) * Nsrc];
        const int c = lane & 7;
        f32x4 ka = {1.f, 1.f, 1.f, 1.f}, kb4 = ka;
        if (kscale) { ka = *(const f32x4*)(kscale + k0 + 8 * c); kb4 = *(const f32x4*)(kscale + k0 + 8 * c + 4); }
        if constexpr (FP8) { ka *= W8_SCALE; kb4 *= W8_SCALE; }
#pragma unroll
        for (int i = 0; i < 32; ++i) scr[(2 * i + (lane >> 5)) * 33 + (lane & 31)] = v[i] * msk;
        LDS_WAIT(); asm volatile("" ::: "memory");
#pragma unroll
        for (int j = 0; j < 4; ++j) { const int n = (lane >> 3) + 8 * j; const LAS float* s = scr + (8 * c) * 33 + n;
            if constexpr (FP8) { u32x2 o; o.x = pk4f8(s[0 * 33] * ka[0], s[1 * 33] * ka[1], s[2 * 33] * ka[2], s[3 * 33] * ka[3]); o.y = pk4f8(s[4 * 33] * kb4[0], s[5 * 33] * kb4[1], s[6 * 33] * kb4[2], s[7 * 33] * kb4[3]);
                *(u32x2*)((unsigned char*)WT + (size_t)mat * dst_stride + (size_t)(n0 + n) * (ldk ? ldk : K) + k0 + 8 * c) = o; }
            else { u32x4 o; o.x = pk2(s[0 * 33] * ka[0], s[1 * 33] * ka[1]); o.y = pk2(s[2 * 33] * ka[2], s[3 * 33] * ka[3]); o.z = pk2(s[4 * 33] * kb4[0], s[5 * 33] * kb4[1]); o.w = pk2(s[6 * 33] * kb4[2], s[7 * 33] * kb4[3]);
            *(u32x4*)(WTm + (size_t)(n0 + n) * K + k0 + 8 * c) = o; } }
        LDS_WAIT(); asm volatile("" ::: "memory");
    }
}
__device__ __forceinline__ void convert_mixer_weights(Frame& F, int l) {
    const int tid_ = fresh_tid(F.wave), lane_ = tid_ & 63; (void)lane_;
    LAS float* scr = (LAS float*)(F.lds + F.wave * 16384);
    unsigned char* wt = F.ws + WS_WT;
    transpose_mat(F.in[3] + (size_t)l * D * DIN, D, DIN, (bf16_t*)(wt + WT_WIN), N_P1, MapWin(), nullptr, scr, ((int)blockIdx.x * NWAVES + F.wave), (F.G * NWAVES), lane_, 1, 0, 0);
    transpose_mat<MapGates, true>(F.in[3] + (size_t)l * D * DIN, D, DIN, (bf16_t*)(wt + WT_WG8), N_GATES, MapGates(), nullptr, scr, ((int)blockIdx.x * NWAVES + F.wave), (F.G * NWAVES), lane_, 1, 0, 0);
    transpose_mat<MapWin, true>(F.in[3] + (size_t)l * D * DIN, D, DIN, (bf16_t*)(wt + WT_WT8), N_F8A, MapWin(), nullptr, scr, ((int)blockIdx.x * NWAVES + F.wave), (F.G * NWAVES), lane_, 1, 0, 0);
    transpose_mat<MapWq, true>(F.in[5] + (size_t)l * QR * 768, QR, 768, (bf16_t*)(wt + WT_WQ), 768, MapWq(), F.in[4] + l * QR, scr, ((int)blockIdx.x * NWAVES + F.wave), (F.G * NWAVES), lane_, 1, 0, 0, WQ8_LD);
    for (int idx = (int)blockIdx.x * NTHREADS + tid_; idx < 768 * 32; idx += F.G * NTHREADS) *(unsigned*)(wt + WT_WQ + (size_t)(idx >> 5) * WQ8_LD + QR + (idx & 31) * 4) = 0u;
    transpose_mat<MapWkv, true>(F.in[7] + (size_t)l * KVR * 1024, KVR, 1024, (bf16_t*)(wt + WT_WKV), 1024, MapWkv(), F.in[6] + l * KVR, scr, ((int)blockIdx.x * NWAVES + F.wave), (F.G * NWAVES), lane_, 1, 0, 0);
    transpose_mat(F.in[12] + (size_t)l * 512 * D, 512, D, (bf16_t*)(wt + WT_WA), D, MapIdent(), nullptr, scr, ((int)blockIdx.x * NWAVES + F.wave), (F.G * NWAVES), lane_, 1, 0, 0);
    transpose_mat(F.in[13] + (size_t)l * 512 * D, 512, D, (bf16_t*)(wt + WT_WB), D, MapIdent(), nullptr, scr, ((int)blockIdx.x * NWAVES + F.wave), (F.G * NWAVES), lane_, 1, 0, 0);
    transpose_mat(F.in[14] + (size_t)l * 512 * D, 512, D, (bf16_t*)(wt + WT_WC), D, MapIdent(), nullptr, scr, ((int)blockIdx.x * NWAVES + F.wave), (F.G * NWAVES), lane_, 1, 0, 0);
    transpose_mat(F.in[15] + (size_t)l * D * D, D, D, (bf16_t*)(wt + WT_WO), D, MapIdent(), nullptr, scr, ((int)blockIdx.x * NWAVES + F.wave), (F.G * NWAVES), lane_, 1, 0, 0);
}
__device__ __forceinline__ void convert_moe_weights(Frame& F, int l) {
    const int tid_ = fresh_tid(F.wave), lane_ = tid_ & 63; (void)lane_;
    LAS float* scr = (LAS float*)(F.lds + F.wave * 16384);
    transpose_mat<MapWgu, true>(F.in[21] + (size_t)l * NE * D * 512, D, 512, (bf16_t*)(F.ws + WS_WGU), 512, MapWgu(), F.in[16] + l * D  , scr, ((int)blockIdx.x * NWAVES + F.wave), (F.G * NWAVES), lane_, NE, (size_t)D * 512, (size_t)512 * D  );
    transpose_mat<MapIdent, true>(F.in[22] + (size_t)l * NE * DE * D, DE, D, (bf16_t*)(F.ws + WS_WD), D, MapIdent(), nullptr, scr, ((int)blockIdx.x * NWAVES + F.wave), (F.G * NWAVES), lane_, NE, (size_t)DE * D, (size_t)D * DE  );
}

__device__ __forceinline__ void norm_rows_bf16(Frame& F, const float* X, const float* gain, bf16_t* H, unsigned char* H8, float* RS) {
    const int tid_ = fresh_tid(F.wave), lane_ = tid_ & 63; (void)lane_;
    constexpr int RB = 4;
    f32x4 g[4];
#pragma unroll
    for (int j = 0; j < 4; ++j) g[j] = ((const f32x4*)gain)[lane_ + 64 * j];
    for (int m0 = ((int)blockIdx.x * NWAVES + F.wave); m0 < T; m0 += RB * (F.G * NWAVES)) {
        f32x4 v[RB][4];
#pragma unroll
        for (int r = 0; r < RB; ++r) { const int m = m0 + r * (F.G * NWAVES); if (m < T) { const f32x4* xr = (const f32x4*)(X + (size_t)m * D) + lane_;
#pragma unroll
            for (int j = 0; j < 4; ++j) v[r][j] = xr[64 * j]; } }
#pragma unroll
        for (int r = 0; r < RB; ++r) { const int m = m0 + r * (F.G * NWAVES); if (m < T) { float s = 0.f;
#pragma unroll
            for (int j = 0; j < 4; ++j) s += (v[r][j].x * v[r][j].x + v[r][j].y * v[r][j].y) + (v[r][j].z * v[r][j].z + v[r][j].w * v[r][j].w);
            const float ms = wave_sum(s) * (1.f / D) + EPS, rstd = rsqrtf(ms);
            if (lane_ == 0) RS[m] = ms * rstd;
            u32x2* o = (u32x2*)(H + (size_t)m * D) + lane_;
#pragma unroll
            for (int j = 0; j < 4; ++j) { u32x2 w; w.x = cvt_pk(v[r][j].x * rstd * g[j].x, v[r][j].y * rstd * g[j].y); w.y = cvt_pk(v[r][j].z * rstd * g[j].z, v[r][j].w * rstd * g[j].w); o[64 * j] = w; }
            unsigned* o8 = (unsigned*)(H8 + (size_t)m * D) + lane_;
#pragma unroll
            for (int j = 0; j < 4; ++j) o8[64 * j] = pk4f8(v[r][j].x * rstd * g[j].x, v[r][j].y * rstd * g[j].y, v[r][j].z * rstd * g[j].z, v[r][j].w * rstd * g[j].w); } }
    }
}
__device__ __forceinline__ void rope_table(Frame& F) {
    const int tid_ = fresh_tid(F.wave), lane_ = tid_ & 63; (void)lane_;
    const int* pos = (const int*)F.in[1]; float* R = (float*)(F.ws + WS_ROPE);
    const int gt = blockIdx.x * NTHREADS + tid_, nt = F.G * NTHREADS;
    const int i = gt & 15; const double c = exp2(-0.83048202372184059 * (double)i) * 0.15915494309189535;
    for (int idx = gt; idx < T * 16; idx += nt) { const int t = idx >> 4;
        double rd = (double)pos[t] * c; rd -= floor(rd); const float r = (float)rd;
        R[t * 32 + i] = __builtin_amdgcn_cosf(r); R[t * 32 + 16 + i] = __builtin_amdgcn_sinf(r); }
}
namespace pg8 {
constexpr int BM = 256, BK = 64, HALF = 128, HTB = HALF * BK * 2, STAGE_BYTES = 8 * HTB, NXCD = 8, WGM = 8;
__host__ __device__ __forceinline__ int lds_byte(int r, int c) { const int st = (r >> 4) * 2 + (c >> 5), rr = r & 15, cc = c & 31, ob = rr * 64 + cc * 2; return st * 1024 + (ob ^ (((ob >> 9) & 1) << 5)); }
__host__ __device__ __forceinline__ void stage_rc(int b, int& R, int& C) { const int st = b / 1024, sb = b % 1024, swz = sb ^ (((sb >> 9) & 1) << 5); R = (st >> 1) * 16 + swz / 64; C = (st & 1) * 32 + (swz % 64) / 2; }
__host__ __device__ __forceinline__ int perm32(int rho) { const int n = rho >> 4, i = rho & 15; return 8 * (i >> 2) + 4 * n + (i & 3); }
struct Unit { int pm, pn, aux, rm, rn; };
struct Gemm { const bf16_t* A; const bf16_t* Bt; };
struct StaticOrder {
    int nM, nN, nwg, G, c;
    __host__ __device__ void init(int M, int N, int G_, int c_) { nM = M / BM; nN = N / BM; nwg = nM * nN; G = G_; c = c_; }
    __host__ __device__ bool next(int i, Unit& u) const {
        const long L = (long)i * G + c; if (L >= nwg) return false;
        int wgid = (int)L; { const int q = nwg / NXCD, r = nwg % NXCD, xcd = wgid % NXCD, off = wgid / NXCD; wgid = (xcd < r ? xcd * (q + 1) : r * (q + 1) + (xcd - r) * q) + off; }
        const int nig = WGM * nN, gid = wgid / nig, fm = gid * WGM, gsz = (nM - fm) < WGM ? (nM - fm) : WGM;
        u.pm = fm + ((wgid % nig) % gsz); u.pn = (wgid % nig) / gsz; return true;
    }
};
struct MoeOrder {
    const LAS unsigned char* tile_e; int ntiles, ntn, G, c;
    __device__ bool next(int i, Unit& u) const {
        const int L = i * G + c; if (L >= ntiles * ntn) return false;
        const int tile = L / ntn, pn = L - tile * ntn; u.pm = tile; u.pn = __builtin_amdgcn_readfirstlane((int)tile_e[tile]) * ntn + pn; return true;
    }
};
struct MoeGatherOrder {
    const LAS unsigned char* tile_e; const LAS unsigned short* tile_r; const LAS int* cnt; const unsigned* list; int ntiles, ntn, G, c;
    __device__ bool next(int i, Unit& u) const {
        const int L = i * G + c; if (L >= ntiles * ntn) return false;
        const int tile = L / ntn, pn = L - tile * ntn, e = __builtin_amdgcn_readfirstlane((int)tile_e[tile]), rt = __builtin_amdgcn_readfirstlane((int)tile_r[tile]);
        u.pm = tile; u.pn = e * ntn + pn; u.aux = e; u.rm = rt; u.rn = __builtin_amdgcn_readfirstlane(cnt[e]); return true;
    }
    __device__ __forceinline__ unsigned rowoff(const Unit& u, int r) const { const int idx = u.rm * 256 + r; const unsigned tok = idx < u.rn ? list[(size_t)u.aux * T + idx] : 0u; return tok * (unsigned)D; }
};
struct ChainOrder {
    StaticOrder so;
    __device__ bool next(int i, Unit& u) const {
        const int it = i / 3, br = i - it * 3; Unit t;
        if (!so.next(it, t)) return false;
        u.rm = t.pm; u.rn = t.pn; u.aux = br;
        constexpr size_t TS = (size_t)256 * 512 * 2;
        constexpr int A0 = (int)(WS_SGU / TS), A1 = (int)(WS_CB / TS), A2 = (int)(WS_O / TS), B0 = (int)((WS_WT + WT_WB) / TS), B1 = (int)((WS_WT + WT_WC) / TS), B2 = (int)((WS_WT + WT_WA) / TS);
        int ao = A0 + br * (A1 - A0), bo = B0 + br * (B1 - B0); if (br == 2) { ao = A2; bo = B2; }
        u.pm = t.pm + ao; u.pn = t.pn + bo; return true;
    }
};
template <class Fn> struct Epi8 {
    static constexpr bool PERM = true, CHAIN = false;
    Fn f;
    __device__ __forceinline__ void operator()(const f32x4 (&acc)[2][2][4][2], const Unit& u, int wr, int wc, int fr, int fq) const {
#pragma unroll
        for (int ai = 0; ai < 2; ++ai)
#pragma unroll
            for (int m = 0; m < 4; ++m) { const int row = u.pm * BM + ai * HALF + wr * 64 + m * 16 + fr;
#pragma unroll
                for (int bj = 0; bj < 2; ++bj) f(u, row, u.pn * BM + bj * HALF + wc * 32 + 8 * fq, acc[ai][bj][m][0], acc[ai][bj][m][1]);
                asm volatile("" ::: "memory"); }
    }
};
template <class Fn, int MB> struct Epi8L {
    static constexpr bool PERM = true, CHAIN = false;
    Fn f;
    __device__ __forceinline__ void operator()(const f32x4 (&acc)[2][2][4][2], const Unit& u, int wr, int wc, int fr, int fq) const {
#pragma unroll
        for (int ai = 0; ai < 2; ++ai)
#pragma unroll
            for (int mb = 0; mb < 4; mb += MB) {
                typename Fn::Pre pre[MB][2];
#pragma unroll
                for (int m = 0; m < MB; ++m)
#pragma unroll
                    for (int bj = 0; bj < 2; ++bj) pre[m][bj] = f.pre(u, u.pm * BM + ai * HALF + wr * 64 + (mb + m) * 16 + fr, u.pn * BM + bj * HALF + wc * 32 + 8 * fq);
                asm volatile("" ::: "memory");
#pragma unroll
                for (int m = 0; m < MB; ++m)
#pragma unroll
                    for (int bj = 0; bj < 2; ++bj) f.post(u, u.pm * BM + ai * HALF + wr * 64 + (mb + m) * 16 + fr, u.pn * BM + bj * HALF + wc * 32 + 8 * fq, acc[ai][bj][mb + m][0], acc[ai][bj][mb + m][1], pre[m][bj]);
                asm volatile("" ::: "memory"); }
    }
};
template <class Fn> struct Epi8A {
    static constexpr bool PERM = true, CHAIN = false;
    Fn f;
    __device__ __forceinline__ void operator()(const f32x4 (&acc)[2][2][4][2], const Unit& u, int wr, int wc, int fr, int fq) const {
        typename Fn::Pre pre[2][4][2];
#pragma unroll
        for (int ai = 0; ai < 2; ++ai)
#pragma unroll
            for (int m = 0; m < 4; ++m)
#pragma unroll
                for (int bj = 0; bj < 2; ++bj) pre[ai][m][bj] = f.pre(u, u.pm * BM + ai * HALF + wr * 64 + m * 16 + fr, u.pn * BM + bj * HALF + wc * 32 + 8 * fq);
        asm volatile("" ::: "memory");
#pragma unroll
        for (int ai = 0; ai < 2; ++ai)
#pragma unroll
            for (int m = 0; m < 4; ++m) {
#pragma unroll
                for (int bj = 0; bj < 2; ++bj) f.post(u, u.pm * BM + ai * HALF + wr * 64 + m * 16 + fr, u.pn * BM + bj * HALF + wc * 32 + 8 * fq, acc[ai][bj][m][0], acc[ai][bj][m][1], pre[ai][m][bj]);
                asm volatile("" ::: "memory"); }
    }
};
typedef int i32x4_t __attribute__((ext_vector_type(4)));
typedef int i32x8_t __attribute__((ext_vector_type(8)));
__device__ __forceinline__ i32x8_t cat8(const bf16x8 a, const bf16x8 b) { const i32x4_t x = __builtin_bit_cast(i32x4_t, a), y = __builtin_bit_cast(i32x4_t, b); return __builtin_shufflevector(x, y, 0, 1, 2, 3, 4, 5, 6, 7); }
template <class Epi, class Sched, int LDA, int LDB, int KK, bool ALIGN_EPI = true, bool GATHER = false, bool FP8 = false>
__device__ __forceinline__ void gemm_phase(LAS unsigned char* lds, const int wave, const Gemm g, const Sched& S, const Epi& E) {
    const int tid = fresh_tid(wave), wid = __builtin_amdgcn_readfirstlane(tid >> 6), lane = tid & 63, wr = wid >> 2, wc = wid & 3, fr = lane & 15, fq = lane >> 4;
    constexpr int nt = KK / BK; static_assert(KK % 128 == 0, "K must be a multiple of 128");
    unsigned voffA, voffB;
    { int R, C; stage_rc(tid * 16, R, C); const int Rb = Epi::PERM ? ((R & ~31) + perm32(R & 31)) : R;
      voffA = (unsigned)(R * LDA + C) * 2u; voffB = (unsigned)(Rb * LDB + C) * 2u; }
    constexpr size_t pieceA = (size_t)64 * LDA * 2, pieceB = (size_t)64 * LDB * 2;
    unsigned gc00 = 0, gc01 = 0, gc10 = 0, gc11 = 0, gn00 = 0, gn01 = 0, gn10 = 0, gn11 = 0;
    constexpr size_t kstep = (size_t)(BK * 2);
    constexpr size_t hstepA = (size_t)HALF * LDA * 2, hstepB = (size_t)HALF * LDB * 2;
    constexpr size_t tstepA = 2 * hstepA, tstepB = 2 * hstepB;
    const unsigned ldsw = (unsigned)wid * 1024u;
    const int aoff = lds_byte(wr * 64 + fr, fq * 8), boff = lds_byte(wc * 32 + fr, fq * 8);
#define PG8_SA(b, h) (((b) * 2 + (h)) * HTB)
#define PG8_SB(b, h) ((4 + (b) * 2 + (h)) * HTB)
#define PG8_STAGE(bufoff, gbase, voff) do { \
        __builtin_amdgcn_global_load_lds((const unsigned*)((const char*)(gbase) + voff), (LAS unsigned*)(lds + (bufoff) + ldsw), 16, 0, 0); \
        __builtin_amdgcn_global_load_lds((const unsigned*)((const char*)(gbase) + PG8_PIECE_##voff + voff), (LAS unsigned*)(lds + (bufoff) + ldsw + 8192), 16, 0, 0); } while (0)
#define PG8_GLD(gptr, ldsoff) __builtin_amdgcn_global_load_lds((const unsigned*)(gptr), (LAS unsigned*)(lds + (ldsoff)), 16, 0, 0)
#define PG8_STAGE_A(bufoff, ptr, h, nx) do { if constexpr (GATHER) { \
        const unsigned o0_ = (nx) ? ((h) ? gn10 : gn00) : ((h) ? gc10 : gc00), o1_ = (nx) ? ((h) ? gn11 : gn01) : ((h) ? gc11 : gc01); \
        PG8_GLD((const char*)(ptr) + o0_, (bufoff) + ldsw); PG8_GLD((const char*)(ptr) + o1_, (bufoff) + ldsw + 8192); \
    } else { PG8_STAGE(bufoff, (const char*)(ptr) + (h) * hstepA, voffA); } } while (0)
#define PG8_ROWOFFS(u, o00, o01, o10, o11) do { int gR_, gC_; stage_rc(fresh_tid(wave) * 16, gR_, gC_);     \
        o00 = S.rowoff(u, gR_) + gC_ * 2; o01 = S.rowoff(u, gR_ + 64) + gC_ * 2; o10 = S.rowoff(u, 128 + gR_) + gC_ * 2; o11 = S.rowoff(u, 192 + gR_) + gC_ * 2; } while (0)
#define PG8_PIECE_voffA pieceA
#define PG8_PIECE_voffB pieceB
#define PG8_LDA(dst, b, h) do { _Pragma("unroll") for (int m = 0; m < 4; ++m) _Pragma("unroll") for (int k = 0; k < 2; ++k) dst[m][k] = *(const LAS bf16x8*)(lds + PG8_SA(b, h) + aoff + m * 2048 + k * 1024); } while (0)
#define PG8_LDB(dst, b, h) do { _Pragma("unroll") for (int n = 0; n < 2; ++n) _Pragma("unroll") for (int k = 0; k < 2; ++k) dst[n][k] = *(const LAS bf16x8*)(lds + PG8_SB(b, h) + boff + n * 2048 + k * 1024); } while (0)
#define PG8_MMA(ai, bj, At, Bt) do { __builtin_amdgcn_s_setprio(1); _Pragma("unroll") for (int m = 0; m < 4; ++m) _Pragma("unroll") for (int n = 0; n < 2; ++n) { \
        if constexpr (FP8) asm volatile("v_mfma_f32_16x16x128_f8f6f4 %0, %1, %2, %0" : "+v"(acc[ai][bj][m][n]) : "v"(cat8(Bt[n][0], Bt[n][1])), "v"(cat8(At[m][0], At[m][1])));   \
        else { _Pragma("unroll") for (int k = 0; k < 2; ++k) acc[ai][bj][m][n] = __builtin_amdgcn_mfma_f32_16x16x32_bf16(Bt[n][k], At[m][k], acc[ai][bj][m][n], 0, 0, 0); } } __builtin_amdgcn_s_setprio(0); } while (0)
#define PG8_WAIT_V(n) asm volatile("s_waitcnt vmcnt(" #n ")" ::: "memory")
#define PG8_WAIT_L(n) asm volatile("s_waitcnt lgkmcnt(" #n ")" ::: "memory")
#define PG8_BAR __builtin_amdgcn_s_barrier()
#define PG8_SCHED __builtin_amdgcn_sched_barrier(0)
    Unit cur, nxt; int ui = 0;
    if (!S.next(0, cur)) return;
    f32x4 acc[2][2][4][2];
#pragma unroll
    for (int a = 0; a < 2; ++a)
#pragma unroll
        for (int b = 0; b < 2; ++b)
#pragma unroll
            for (int m = 0; m < 4; ++m)
#pragma unroll
                for (int n = 0; n < 2; ++n) acc[a][b][m][n] = (f32x4){0.f, 0.f, 0.f, 0.f};
    bf16x8 At[4][2], B0[2][2], B1[2][2];
    const char* cA = (const char*)g.A + (GATHER ? (size_t)0 : (size_t)cur.pm * tstepA); const char* cB = (const char*)g.Bt + (size_t)cur.pn * tstepB;
    if constexpr (GATHER) PG8_ROWOFFS(cur, gc00, gc01, gc10, gc11);
    PG8_STAGE(PG8_SB(0, 0), cB, voffB); PG8_STAGE(PG8_SB(0, 1), cB + hstepB, voffB); PG8_STAGE_A(PG8_SA(0, 0), cA, 0, false); PG8_STAGE_A(PG8_SA(0, 1), cA, 1, false);
    if (wr == 1) PG8_BAR;
    PG8_WAIT_V(2); PG8_BAR;
    PG8_STAGE(PG8_SB(1, 0), cB + kstep, voffB); PG8_STAGE_A(PG8_SA(1, 0), cA + kstep, 0, false); PG8_STAGE(PG8_SB(1, 1), cB + hstepB + kstep, voffB);
    PG8_WAIT_V(6); PG8_BAR;
    for (;;) {
        const bool has_next = S.next(ui + 1, nxt);
        const char* nA = (has_next && !GATHER) ? (const char*)g.A + (size_t)nxt.pm * tstepA : cA;
        if constexpr (GATHER) { if (has_next) PG8_ROWOFFS(nxt, gn00, gn01, gn10, gn11); else { gn00 = gc00; gn01 = gc01; gn10 = gc10; gn11 = gc11; } } const char* nB = has_next ? (const char*)g.Bt + (size_t)nxt.pn * tstepB : cB;
#pragma nounroll
        for (int t = 0; t < nt; t += 2) {
            const bool last = (t == nt - 2);
            const char* a1 = cA + (size_t)(t + 1) * kstep;
            const char* a2 = last ? nA : cA + (size_t)(t + 2) * kstep; const char* b2 = last ? nB : cB + (size_t)(t + 2) * kstep;
            const char* a3 = a2 + kstep; const char* b3 = b2 + kstep;
            PG8_LDB(B0, 0, 0); PG8_LDB(B1, 0, 1); PG8_SCHED; PG8_LDA(At, 0, 0); PG8_STAGE_A(PG8_SA(1, 1), a1, 1, false);
            PG8_WAIT_V(8); PG8_WAIT_L(0); PG8_BAR; PG8_MMA(0, 0, At, B0); PG8_MMA(0, 1, At, B1); PG8_BAR; PG8_SCHED;
            PG8_LDA(At, 0, 1); PG8_STAGE(PG8_SB(0, 0), b2, voffB); PG8_STAGE(PG8_SB(0, 1), b2 + hstepB, voffB); PG8_STAGE_A(PG8_SA(0, 0), a2, 0, last);
            PG8_WAIT_V(8); PG8_WAIT_L(0); PG8_BAR; PG8_MMA(1, 0, At, B0); PG8_MMA(1, 1, At, B1); PG8_BAR; PG8_SCHED;
            PG8_LDB(B0, 1, 0); PG8_LDB(B1, 1, 1); PG8_SCHED; PG8_LDA(At, 1, 0); PG8_STAGE_A(PG8_SA(0, 1), a2, 1, last);
            PG8_WAIT_V(8); PG8_WAIT_L(0); PG8_BAR; PG8_MMA(0, 0, At, B0); PG8_MMA(0, 1, At, B1); PG8_BAR; PG8_SCHED;
            PG8_LDA(At, 1, 1); PG8_STAGE(PG8_SB(1, 0), b3, voffB); PG8_STAGE(PG8_SB(1, 1), b3 + hstepB, voffB); PG8_STAGE_A(PG8_SA(1, 0), a3, 0, last);
            PG8_WAIT_V(8); PG8_WAIT_L(0); PG8_BAR; PG8_MMA(1, 0, At, B0); PG8_MMA(1, 1, At, B1); PG8_BAR; PG8_SCHED;
        }
        if constexpr (FP8) asm volatile("s_nop 15\n\ts_nop 15" ::: "memory");
        if constexpr (ALIGN_EPI) { if (wr == 0) PG8_BAR; }
        { const int l2 = fresh_tid(wave) & 63; E(acc, cur, wr, wc, l2 & 15, l2 >> 4); }
        if (!has_next) break;
        if (!Epi::CHAIN || cur.aux == 2) {
#pragma unroll
        for (int a = 0; a < 2; ++a)
#pragma unroll
            for (int b = 0; b < 2; ++b)
#pragma unroll
                for (int m = 0; m < 4; ++m)
#pragma unroll
                    for (int n = 0; n < 2; ++n) acc[a][b][m][n] = (f32x4){0.f, 0.f, 0.f, 0.f}; }
        cur = nxt; cA = nA; cB = nB; ++ui;
        if constexpr (GATHER) { gc00 = gn00; gc01 = gn01; gc10 = gn10; gc11 = gn11; }
        if constexpr (ALIGN_EPI) { if (wr == 1) PG8_BAR; }
    }
    PG8_WAIT_V(0);
    if constexpr (!ALIGN_EPI) { if (wr == 0) PG8_BAR; }
    PG8_BAR;
#undef PG8_SA
#undef PG8_SB
#undef PG8_STAGE
#undef PG8_GLD
#undef PG8_STAGE_A
#undef PG8_ROWOFFS
#undef PG8_PIECE_voffA
#undef PG8_PIECE_voffB
#undef PG8_LDA
#undef PG8_LDB
#undef PG8_MMA
#undef PG8_WAIT_V
#undef PG8_WAIT_L
#undef PG8_BAR
#undef PG8_SCHED
}
}

template <int LDA, int LDB, int N, int KK, bool FP8 = false, class Epi>
__device__ __forceinline__ void gemm_dense(Frame& F, const bf16_t* A, const bf16_t* Bt, const Epi& E) {
    pg8::Gemm g{A, Bt}; pg8::StaticOrder So; So.init(T, N, F.G, (int)blockIdx.x);
    pg8::gemm_phase<Epi, pg8::StaticOrder, LDA, LDB, KK, true, false, FP8>(F.lds, F.wave, g, So, E);
}

template <bool F8> struct EpiP1 {
    static constexpr bool PERM = true, CHAIN = false;
    bf16_t *T0, *SGU, *GV, *CB, *Z; float *ST0, *STV;
    __device__ __forceinline__ void operator()(const f32x4 (&acc)[2][2][4][2], const pg8::Unit& u, int wr, int wc, int fr, int fq) const {
        const int pn = F8 ? (u.pn < 3 ? u.pn : u.pn + 2) : (u.pn < 2 ? u.pn + 3 : u.pn + 5);
#pragma unroll
        for (int ai = 0; ai < 2; ++ai)
#pragma unroll
            for (int m = 0; m < 4; ++m) { const int row = u.pm * 256 + ai * 128 + wr * 64 + m * 16 + fr;
                float ss0 = 0.f, ss1 = 0.f;
#pragma unroll
                for (int bj = 0; bj < 2; ++bj) { const int c = bj * 128 + wc * 32 + 8 * fq; f32x4 v0 = acc[ai][bj][m][0], v1 = acc[ai][bj][m][1]; float ss = 0.f;
                    if (F8) { v0 *= (1.f / W8_SCALE); v1 *= (1.f / W8_SCALE); }
                    if (pn < 3) { u32x2 w8; w8.x = pk4f8(v0[0], v0[1], v0[2], v0[3]); w8.y = pk4f8(v1[0], v1[1], v1[2], v1[3]); *(u32x2*)((unsigned char*)T0 + (size_t)row * T0W + pn * 256 + c) = w8; ss = dot8(v0, v1); }
                    else if (pn < 5) { v0 = fgelu4(v0); v1 = fgelu4(v1); *(u32x4*)(SGU + (size_t)row * SGW + (pn - 3) * 256 + c) = pack8(v0, v1); }
                    else if (pn < 7) { v0 = fgelu4(v0); v1 = fgelu4(v1); *(u32x4*)(GV + (size_t)row * SGW + (pn - 5) * 256 + c) = pack8(v0, v1); ss = dot8(v0, v1); }
                    else if (pn < 9) { *(u32x4*)(CB + (size_t)row * CW + (pn - 7) * 256 + c) = pack8(v0, v1); }
                    else { u32x2 w; w.x = cvt_pk(v0[0] * v0[1], v0[2] * v0[3]); w.y = cvt_pk(v1[0] * v1[1], v1[2] * v1[3]); *(u32x2*)(Z + (size_t)row * CW + (pn - 9) * 128 + (c >> 1)) = w; }
                    if (bj == 0) ss0 = ss; else ss1 = ss; }
                if (pn < 3 || (pn >= 5 && pn < 7)) {
                    float sv = (pn == 2) ? ss0 : ss0 + ss1;
                    sv += __shfl_xor(sv, 16); sv += __shfl_xor(sv, 32);
                    if (fq == 0) { if (pn < 3) ST0[(size_t)row * 12 + pn * 4 + wc] = sv; else STV[(size_t)row * 8 + (pn - 5) * 4 + wc] = sv; } }
                asm volatile("" ::: "memory"); }
    }
};
struct FnGates8 {
    unsigned char* ws;
    __device__ __forceinline__ void operator()(const pg8::Unit& u, int row, int col, f32x4 v0, f32x4 v1) const {
        const int w = u.pn >> 2; size_t off = WS_GB + (size_t)(w - 1) * (WS_GC - WS_GB); if (w == 0) off = WS_GA;
        constexpr float KS = -1.4426950408889634f / W8_SCALE;
        u32x2 pk = {0u, 0u};
#pragma unroll
        for (int j = 0; j < 4; ++j) {
            pk.x = __builtin_amdgcn_cvt_pk_u8_f32(__builtin_amdgcn_rcpf(1.f + __builtin_amdgcn_exp2f(KS * v0[j])) * 255.f + 0.5f, j, pk.x);
            pk.y = __builtin_amdgcn_cvt_pk_u8_f32(__builtin_amdgcn_rcpf(1.f + __builtin_amdgcn_exp2f(KS * v1[j])) * 255.f + 0.5f, j, pk.y); }
        const unsigned char* gb = ws + off; const unsigned vo = (unsigned)row * (unsigned)D + (unsigned)(col & 1023);
        *(u32x2*)(gb + vo) = pk;
    }
};
constexpr float QSCALE = 0.10206207261596577f * 1.4426950408889634f;
struct FnQ8 {
    bf16_t* Q; const float* ST0; const float* rope;
    struct Pre { f32x4 a, b, c, s; };
    __device__ __forceinline__ Pre pre(const pg8::Unit& u, int row, int col) const {
        Pre p; p.a = *(const f32x4*)(ST0 + (size_t)row * 12 + 4); p.b = *(const f32x4*)(ST0 + (size_t)row * 12 + 8);
        const int d = col % 96, i = d >= 64 ? (d - 64) >> 1 : 0;
        p.c = *(const f32x4*)(rope + (size_t)row * 32 + i); p.s = *(const f32x4*)(rope + (size_t)row * 32 + 16 + i);
        if (d < 64) { p.c = (f32x4){1.f, 1.f, 1.f, 1.f}; p.s = (f32x4){0.f, 0.f, 0.f, 0.f}; }
        return p; }
    __device__ __forceinline__ void post(const pg8::Unit& u, int row, int col, f32x4 v0, f32x4 v1, const Pre& p) const {
        const float r = rsqrtf((((p.a[0] + p.a[1]) + (p.a[2] + p.a[3])) + ((p.b[0] + p.b[1]) + (p.b[2] + p.b[3]))) * (1.f / QR) + EPS);
        const f32x4 t0 = v0 * (r * (QSCALE / W8_SCALE)), t1 = v1 * (r * (QSCALE / W8_SCALE)), c = p.c, s = p.s;
        v0[0] = t0[0] * c[0] - t0[1] * s[0]; v0[1] = t0[1] * c[0] + t0[0] * s[0]; v0[2] = t0[2] * c[1] - t0[3] * s[1]; v0[3] = t0[3] * c[1] + t0[2] * s[1];
        v1[0] = t1[0] * c[2] - t1[1] * s[2]; v1[1] = t1[1] * c[2] + t1[0] * s[2]; v1[2] = t1[2] * c[3] - t1[3] * s[3]; v1[3] = t1[3] * c[3] + t1[2] * s[3];
        *(u32x4*)(Q + (size_t)row * 768 + col) = pack8(v0, v1);
    }
};
struct FnKV8 {
    bf16_t *KN, *V; const float* ST0;
    struct Pre { f32x4 a; };
    __device__ __forceinline__ Pre pre(const pg8::Unit& u, int row, int col) const { Pre p; p.a = *(const f32x4*)(ST0 + (size_t)row * 12); return p; }
    __device__ __forceinline__ void post(const pg8::Unit& u, int row, int col, f32x4 v0, f32x4 v1, const Pre& p) const {
        const float r = rsqrtf(((p.a[0] + p.a[1]) + (p.a[2] + p.a[3])) * (1.f / KVR) + EPS) * (1.f / W8_SCALE);
        bf16_t* O = u.pn < 2 ? KN : V;
        *(u32x4*)(O + (size_t)row * 512 + (col & 511)) = pack8(v0 * r, v1 * r);
    }
};
template <bool FIRST> struct FnMerge8 {
    bf16_t* MRG; const bf16_t* G;
    struct Pre { u32x4 g, m; };
    __device__ __forceinline__ Pre pre(const pg8::Unit& u, int row, int col) const {
        const size_t o = (size_t)row * D + col; Pre p; p.g = *(const u32x4*)(G + o);
        if (!FIRST) p.m = *(const u32x4*)(MRG + o); else p.m = (u32x4){0u, 0u, 0u, 0u};
        return p; }
    __device__ __forceinline__ void post(const pg8::Unit& u, int row, int col, f32x4 v0, f32x4 v1, const Pre& p) const {
        const size_t o = (size_t)row * D + col; const u32x4 g = p.g, m = p.m;
        v0 = (f32x4){lo16(g.x) * v0[0], hi16(g.x) * v0[1], lo16(g.y) * v0[2], hi16(g.y) * v0[3]};
        v1 = (f32x4){lo16(g.z) * v1[0], hi16(g.z) * v1[1], lo16(g.w) * v1[2], hi16(g.w) * v1[3]};
        if (!FIRST) { v0 += (f32x4){lo16(m.x), hi16(m.x), lo16(m.y), hi16(m.y)}; v1 += (f32x4){lo16(m.z), hi16(m.z), lo16(m.w), hi16(m.w)}; }
        *(u32x4*)(MRG + o) = pack8(v0, v1);
    }
};
template <bool BASE_F32> struct FnResB {
    const void* base; bf16_t* out; unsigned char* out8;
    struct Pre { f32x4 b0, b1; };
    __device__ __forceinline__ Pre pre(const pg8::Unit& u, int row, int col) const { const size_t o = (size_t)row * D + col; Pre p;
        if (BASE_F32) { p.b0 = *(const f32x4*)((const float*)base + o); p.b1 = *(const f32x4*)((const float*)base + o + 4); }
        else { const u32x4 w = *(const u32x4*)((const bf16_t*)base + o); p.b0 = (f32x4){lo16(w.x), hi16(w.x), lo16(w.y), hi16(w.y)}; p.b1 = (f32x4){lo16(w.z), hi16(w.z), lo16(w.w), hi16(w.w)}; }
        return p; }
    __device__ __forceinline__ void post(const pg8::Unit& u, int row, int col, f32x4 v0, f32x4 v1, const Pre& p) const { v0 += p.b0; v1 += p.b1; *(u32x4*)(out + (size_t)row * D + col) = pack8(v0, v1);
        u32x2 w; w.x = pk4f8(v0[0], v0[1], v0[2], v0[3]); w.y = pk4f8(v1[0], v1[1], v1[2], v1[3]); *(u32x2*)(out8 + (size_t)row * D + col) = w; }
};
struct EpiResH {
    static constexpr bool PERM = true, CHAIN = false;
    const bf16_t* Hn; const float* rs; const float* gain; bf16_t* out; unsigned char* out8;
    __device__ __forceinline__ void operator()(const f32x4 (&acc)[2][2][4][2], const pg8::Unit& u, int wr, int wc, int fr, int fq) const {
        f32x4 ig[2][2]; u32x4 h[2][4][2]; float r[2][4];
#pragma unroll
        for (int bj = 0; bj < 2; ++bj) { const int col = u.pn * 256 + bj * 128 + wc * 32 + 8 * fq; ig[bj][0] = *(const f32x4*)(gain + col); ig[bj][1] = *(const f32x4*)(gain + col + 4); }
#pragma unroll
        for (int ai = 0; ai < 2; ++ai)
#pragma unroll
            for (int m = 0; m < 4; ++m) { const int row = u.pm * 256 + ai * 128 + wr * 64 + m * 16 + fr; r[ai][m] = rs[row];
#pragma unroll
                for (int bj = 0; bj < 2; ++bj) h[ai][m][bj] = *(const u32x4*)(Hn + (size_t)row * D + u.pn * 256 + bj * 128 + wc * 32 + 8 * fq); }
        asm volatile("" ::: "memory");
#pragma unroll
        for (int bj = 0; bj < 2; ++bj)
#pragma unroll
            for (int k = 0; k < 2; ++k) ig[bj][k] = (f32x4){__builtin_amdgcn_rcpf(ig[bj][k][0]), __builtin_amdgcn_rcpf(ig[bj][k][1]), __builtin_amdgcn_rcpf(ig[bj][k][2]), __builtin_amdgcn_rcpf(ig[bj][k][3])};
#pragma unroll
        for (int ai = 0; ai < 2; ++ai)
#pragma unroll
            for (int m = 0; m < 4; ++m) { const int row = u.pm * 256 + ai * 128 + wr * 64 + m * 16 + fr;
#pragma unroll
                for (int bj = 0; bj < 2; ++bj) { const size_t o = (size_t)row * D + u.pn * 256 + bj * 128 + wc * 32 + 8 * fq; const u32x4 w = h[ai][m][bj];
                    const f32x4 v0 = (f32x4){lo16(w.x), hi16(w.x), lo16(w.y), hi16(w.y)} * (ig[bj][0] * r[ai][m]) + acc[ai][bj][m][0];
                    const f32x4 v1 = (f32x4){lo16(w.z), hi16(w.z), lo16(w.w), hi16(w.w)} * (ig[bj][1] * r[ai][m]) + acc[ai][bj][m][1];
                    *(u32x4*)(out + o) = pack8(v0, v1);
                    u32x2 w8; w8.x = pk4f8(v0[0], v0[1], v0[2], v0[3]); w8.y = pk4f8(v1[0], v1[1], v1[2], v1[3]); *(u32x2*)(out8 + o) = w8; }
                asm volatile("" ::: "memory"); }
    }
};
struct FnRes8 {
    const float* base; float* out;
    struct Pre { f32x4 b0, b1; };
    __device__ __forceinline__ Pre pre(const pg8::Unit& u, int row, int col) const { const size_t o = (size_t)row * D + col; Pre p; p.b0 = *(const f32x4*)(base + o); p.b1 = *(const f32x4*)(base + o + 4); return p; }
    __device__ __forceinline__ void post(const pg8::Unit& u, int row, int col, f32x4 v0, f32x4 v1, const Pre& p) const {
        const size_t o = (size_t)row * D + col; *(f32x4*)(out + o) = p.b0 + v0; *(f32x4*)(out + o + 4) = p.b1 + v1;
    }
};
struct EpiChain {
    static constexpr bool PERM = true, CHAIN = true;
    bf16_t* MRG; const unsigned char* ws;
    static __device__ __forceinline__ f32x4 ub4(unsigned w) {
        return (f32x4){fmaxf((float)(w & 255u), 1.f), fmaxf((float)((w >> 8) & 255u), 1.f), fmaxf((float)((w >> 16) & 255u), 1.f), fmaxf((float)(w >> 24), 1.f)}; }
    __device__ __forceinline__ void operator()(f32x4 (&acc)[2][2][4][2], const pg8::Unit& u, int wr, int wc, int fr, int fq) const {
        const int br = u.aux;
        const size_t on = (br == 2) ? WS_GA : WS_GB + (size_t)br * (WS_GC - WS_GB), od = (br == 0) ? WS_GC : WS_GA;
        const unsigned char* Gn = ws + on; const unsigned char* Gd = ws + od;
        u32x2 gna[2][4][2], gda[2][4][2];
#pragma unroll
        for (int ai = 0; ai < 2; ++ai)
#pragma unroll
            for (int m = 0; m < 4; ++m)
#pragma unroll
                for (int bj = 0; bj < 2; ++bj) { const size_t o = (size_t)(u.rm * 256 + ai * 128 + wr * 64 + m * 16 + fr) * D + u.rn * 256 + bj * 128 + wc * 32 + 8 * fq;
                    gna[ai][m][bj] = *(const u32x2*)(Gn + o); if (br != 2) gda[ai][m][bj] = *(const u32x2*)(Gd + o); else gda[ai][m][bj] = (u32x2){0u, 0u}; }
        asm volatile("" ::: "memory");
#pragma unroll
        for (int ai = 0; ai < 2; ++ai) {
            const u32x2 (&gn)[4][2] = gna[ai]; const u32x2 (&gd)[4][2] = gda[ai];
#pragma unroll
            for (int m = 0; m < 4; ++m)
#pragma unroll
                for (int bj = 0; bj < 2; ++bj) { const size_t o = (size_t)(u.rm * 256 + ai * 128 + wr * 64 + m * 16 + fr) * D + u.rn * 256 + bj * 128 + wc * 32 + 8 * fq;
                    f32x4 f0 = ub4(gn[m][bj].x), f1 = ub4(gn[m][bj].y);
                    if (br != 2) { const f32x4 d0 = ub4(gd[m][bj].x), d1 = ub4(gd[m][bj].y);
                        f0 *= (f32x4){__builtin_amdgcn_rcpf(d0[0]), __builtin_amdgcn_rcpf(d0[1]), __builtin_amdgcn_rcpf(d0[2]), __builtin_amdgcn_rcpf(d0[3])};
                        f1 *= (f32x4){__builtin_amdgcn_rcpf(d1[0]), __builtin_amdgcn_rcpf(d1[1]), __builtin_amdgcn_rcpf(d1[2]), __builtin_amdgcn_rcpf(d1[3])};
                        acc[ai][bj][m][0] *= f0; acc[ai][bj][m][1] *= f1;
                    } else { *(u32x4*)(MRG + o) = pack8(acc[ai][bj][m][0] * (f0 * (1.f / 255.f)), acc[ai][bj][m][1] * (f1 * (1.f / 255.f))); } }
            asm volatile("" ::: "memory"); }
    }
};
struct FnMoe1G {
    bf16_t* ACT; const float* rl;
    struct Pre { float rs; };
    __device__ __forceinline__ Pre pre(const pg8::Unit& u, int row, int col) const { Pre p; p.rs = rl[(size_t)u.aux * T + u.rm * 256 + (row - u.pm * 256)] * (1.f / W8_SCALE); return p; }
    __device__ __forceinline__ void post(const pg8::Unit& u, int row, int col, f32x4 v0, f32x4 v1, const Pre& p) const {
        v0 *= p.rs; v1 *= p.rs;
        *(unsigned*)((unsigned char*)ACT + (size_t)row * DE + ((col & 511) >> 1)) = pk4f8(v0[0] * fsigmoid(v0[0]) * v0[1], v0[2] * fsigmoid(v0[2]) * v0[3], v1[0] * fsigmoid(v1[0]) * v1[1], v1[2] * fsigmoid(v1[2]) * v1[3]);
    }
};
struct FnMoe1_8 {
    bf16_t* ACT;
    __device__ __forceinline__ void operator()(const pg8::Unit& u, int row, int col, f32x4 v0, f32x4 v1) const {
        u32x2 w; w.x = cvt_pk(v0[0] * fsigmoid(v0[0]) * v0[1], v0[2] * fsigmoid(v0[2]) * v0[3]); w.y = cvt_pk(v1[0] * fsigmoid(v1[0]) * v1[1], v1[2] * fsigmoid(v1[2]) * v1[3]);
        *(u32x2*)(ACT + (size_t)row * DE + ((col & 511) >> 1)) = w;
    }
};
struct FnMoe2_8 {
    unsigned char* YB;
    __device__ __forceinline__ void operator()(const pg8::Unit& u, int row, int col, f32x4 v0, f32x4 v1) const {
        v0 *= (1.f / W8_SCALE); v1 *= (1.f / W8_SCALE);
        u32x2 w; w.x = pk4f8(v0[0], v0[1], v0[2], v0[3]); w.y = pk4f8(v1[0], v1[1], v1[2], v1[3]);
        *(u32x2*)(YB + (size_t)row * D + (col & 1023)) = w; }
};

__device__ __forceinline__ void sgmix_pass(Frame& F, int l, bf16_t* OUT) {
    typedef float f32x16 __attribute__((ext_vector_type(16)));
    const int tid_ = fresh_tid(F.wave), lane_ = tid_ & 63, r32 = lane_ & 31, hi = lane_ >> 5, wid = F.wave;
    LAS unsigned char* VT = F.lds; LAS float* RV = (LAS float*)(F.lds + TAB_OFF);
    bf16_t* SGU = (bf16_t*)(F.ws + WS_SGU); const bf16_t* GV = (const bf16_t*)(F.ws + WS_GV); const float* stv = (const float*)(F.ws + WS_STV);
    const float* sgn = F.in[8] + l * SGW; const bf16_t* WSG = (const bf16_t*)(F.ws + WS_WSG); const float* bs = F.in[10] + l * 4 * 128;
    for (int chunk = blockIdx.x; chunk < T / 128; chunk += gridDim.x) {
        const int t0 = chunk * 128;
        __syncthreads();
        if (tid_ < 128) { const f32x4 a = *(const f32x4*)(stv + (size_t)(t0 + tid_) * 8), b = *(const f32x4*)(stv + (size_t)(t0 + tid_) * 8 + 4);
            RV[tid_] = rsqrtf((((a[0] + a[1]) + (a[2] + a[3])) + ((b[0] + b[1]) + (b[2] + b[3]))) * (1.f / SGW) + EPS); }
        __syncthreads();
        u32x4 av[8], bv[8];
#pragma unroll
        for (int k = 0; k < 8; ++k) { const int c0 = (wid + 8 * k) * 8, s2 = 2 * lane_;
            av[k] = *(const u32x4*)(GV + (size_t)(t0 + s2) * SGW + c0); bv[k] = *(const u32x4*)(GV + (size_t)(t0 + s2 + 1) * SGW + c0); }
#pragma unroll
        for (int k = 0; k < 8; ++k) { const int cc = wid + 8 * k, c0 = cc * 8, s2 = 2 * lane_, g = c0 >> 7, d0 = c0 & 127;
            const u32x4 a = av[k], b = bv[k];
            const float ra = RV[s2], rb = RV[s2 + 1]; const f32x4 g0 = *(const f32x4*)(sgn + c0), g1 = *(const f32x4*)(sgn + c0 + 4);
            const float ga[8] = {g0[0], g0[1], g0[2], g0[3], g1[0], g1[1], g1[2], g1[3]};
#pragma unroll
            for (int j = 0; j < 8; ++j) { const unsigned wa = a[j >> 1], wb = b[j >> 1];
                const float va = ((j & 1) ? hi16(wa) : lo16(wa)) * ra * ga[j], vb = ((j & 1) ? hi16(wb) : lo16(wb)) * rb * ga[j];
                const int d = d0 + j;
                *(LAS unsigned*)(VT + g * 32768 + d * 256 + ((((s2 >> 3) ^ (d & 15)) << 4) + (s2 & 7) * 2)) = cvt_pk(va, vb); } }
        __syncthreads();
        const int g = wid >> 1;
#pragma unroll 1
        for (int pass = 0; pass < 2; ++pass) { const int tt = (wid & 1) ? 1 + pass : (pass ? 3 : 0);
            f32x16 acc[4] = {};
            const bf16_t* wrow = WSG + ((size_t)(g * 128 + 32 * tt + r32)) * 128 + 8 * hi;
            const LAS unsigned char* vb = VT + g * 32768;
            bf16x8 Af[8];
#pragma unroll
            for (int ks = 0; ks < 8; ++ks) Af[ks] = *(const bf16x8*)(wrow + 16 * ks);
            const int nks = 2 * (tt + 1);
#pragma unroll
            for (int ks = 0; ks < 8; ++ks) if (ks < nks) {
#pragma unroll
                for (int dt = 0; dt < 4; ++dt) { const int d = 32 * dt + r32;
                    const bf16x8 B = *(const LAS bf16x8*)(vb + d * 256 + (((2 * ks + hi) ^ (d & 15)) << 4));
                    acc[dt] = __builtin_amdgcn_mfma_f32_32x32x16_bf16(Af[ks], B, acc[dt], 0, 0, 0); } }
#pragma unroll
            for (int r = 0; r < 16; ++r) { const int t = 32 * tt + (r & 3) + 8 * (r >> 2) + 4 * hi; const float bias = bs[g * 128 + t];
#pragma unroll
                for (int dt = 0; dt < 4; ++dt) { const size_t o_ = (size_t)(t0 + t) * SGW + g * 128 + 32 * dt + r32;
                    OUT[o_] = (bf16_t)f2bf(bf2f(SGU[o_]) * (acc[dt][r] + bias)); } }
        }
    }
    __syncthreads();
}
__device__ __forceinline__ void conv_pass(Frame& F, int l, bf16_t* OUT) {
    const int tid_ = fresh_tid(F.wave);
    bf16_t* CB = (bf16_t*)(F.ws + WS_CB); const bf16_t* Z = (const bf16_t*)(F.ws + WS_Z); const float* cw = F.in[11] + (size_t)l * 3 * CW;
    const int gt = blockIdx.x * NTHREADS + tid_, nt = F.G * NTHREADS;
    for (int idx = gt; idx < (T / 4) * 64; idx += nt) { const int t0 = (idx >> 6) * 4, c8 = (idx & 63) * 8, s0 = t0 & (S - 1);
        u32x4 z[6], b[4];
        z[0] = (u32x4){0, 0, 0, 0}; z[1] = z[0];
        if (s0 >= 2) { z[0] = *(const u32x4*)(Z + (size_t)(t0 - 2) * CW + c8); z[1] = *(const u32x4*)(Z + (size_t)(t0 - 1) * CW + c8); }
#pragma unroll
        for (int i = 0; i < 4; ++i) { z[2 + i] = *(const u32x4*)(Z + (size_t)(t0 + i) * CW + c8); b[i] = *(const u32x4*)(CB + (size_t)(t0 + i) * CW + c8); }
        const f32x4 w00 = *(const f32x4*)(cw + c8), w01 = *(const f32x4*)(cw + c8 + 4), w10 = *(const f32x4*)(cw + CW + c8), w11 = *(const f32x4*)(cw + CW + c8 + 4), w20 = *(const f32x4*)(cw + 2 * CW + c8), w21 = *(const f32x4*)(cw + 2 * CW + c8 + 4);
        const float w0[8] = {w00[0], w00[1], w00[2], w00[3], w01[0], w01[1], w01[2], w01[3]}, w1[8] = {w10[0], w10[1], w10[2], w10[3], w11[0], w11[1], w11[2], w11[3]}, w2[8] = {w20[0], w20[1], w20[2], w20[3], w21[0], w21[1], w21[2], w21[3]};
#pragma unroll
        for (int i = 0; i < 4; ++i) { u32x4 o;
#pragma unroll
            for (int j = 0; j < 4; ++j) {
                const float y0 = w0[2 * j] * lo16(z[i][j]) + w1[2 * j] * lo16(z[i + 1][j]) + w2[2 * j] * lo16(z[i + 2][j]);
                const float y1 = w0[2 * j + 1] * hi16(z[i][j]) + w1[2 * j + 1] * hi16(z[i + 1][j]) + w2[2 * j + 1] * hi16(z[i + 2][j]);
                o[j] = cvt_pk(lo16(b[i][j]) * y0, hi16(b[i][j]) * y1); }
            *(u32x4*)(OUT + (size_t)(t0 + i) * CW + c8) = o; } }
}
__device__ __forceinline__ void krope_pass(Frame& F) {
    const int tid_ = fresh_tid(F.wave), lane_ = tid_ & 63; (void)lane_;
    const unsigned char* T8 = F.ws + WS_T0; bf16_t* KR = (bf16_t*)(F.ws + WS_KR); const float* rope = (const float*)(F.ws + WS_ROPE);
    const int gt = blockIdx.x * NTHREADS + tid_, nt = F.G * NTHREADS;
    for (int idx0 = gt; idx0 < T * 16; idx0 += 4 * nt) {
        float x1[4], x2[4], c[4], sn[4];
#pragma unroll
        for (int j = 0; j < 4; ++j) { const int idx = idx0 + j * nt; if (idx < T * 16) { const int t = idx >> 4, i = idx & 15;
            x1[j] = __builtin_amdgcn_cvt_f32_fp8((int)T8[(size_t)t * T0W + 640 + i], 0); x2[j] = __builtin_amdgcn_cvt_f32_fp8((int)T8[(size_t)t * T0W + 656 + i], 0); c[j] = rope[t * 32 + i]; sn[j] = rope[t * 32 + 16 + i]; } }
#pragma unroll
        for (int j = 0; j < 4; ++j) { const int idx = idx0 + j * nt; if (idx < T * 16) { const int t = idx >> 4, i = idx & 15;
            *(unsigned*)(KR + (size_t)t * 32 + 2 * i) = pk2(x1[j] * c[j] - x2[j] * sn[j], x2[j] * c[j] + x1[j] * sn[j]); } } }
}
__device__ __forceinline__ void attn_simple(Frame& F) {
    const int tid_ = fresh_tid(F.wave), lane_ = tid_ & 63; (void)lane_;
    const bf16_t* Q = (const bf16_t*)(F.ws + WS_Q); const bf16_t* KN = (const bf16_t*)(F.ws + WS_KN); const bf16_t* KR = (const bf16_t*)(F.ws + WS_KR);
    const bf16_t* V = (const bf16_t*)(F.ws + WS_V); bf16_t* O = (bf16_t*)(F.ws + WS_O);
    const float scale = 0.10206207261596577f;
    for (int item = ((int)blockIdx.x * NWAVES + F.wave); item < NB * NH * (S / 64); item += (F.G * NWAVES)) {
        const int bh = item / (S / 64), qb = item % (S / 64), b = bh >> 3, h = bh & 7, i = qb * 64 + lane_; const size_t t = (size_t)b * S + i;
        u32x4 qp[12]; float o[64]; float m = -1e30f, lsum = 0.f;
#pragma unroll
        for (int c = 0; c < 12; ++c) qp[c] = *(const u32x4*)(Q + t * 768 + h * 96 + c * 8);
#pragma unroll
        for (int d = 0; d < 64; ++d) o[d] = 0.f;
        const int jend = qb * 64 + 63;
        for (int j = 0; j <= jend; ++j) { const size_t tk = (size_t)b * S + j;
            float s = 0.f;
#pragma unroll
            for (int c = 0; c < 8; ++c) { const u32x4 w = *(const u32x4*)(KN + tk * 512 + h * 64 + c * 8);
#pragma unroll
                for (int e = 0; e < 4; ++e) s += lo16(qp[c][e]) * lo16(w[e]) + hi16(qp[c][e]) * hi16(w[e]); }
#pragma unroll
            for (int c = 0; c < 4; ++c) { const u32x4 w = *(const u32x4*)(KR + tk * 32 + c * 8);
#pragma unroll
                for (int e = 0; e < 4; ++e) s += lo16(qp[8 + c][e]) * lo16(w[e]) + hi16(qp[8 + c][e]) * hi16(w[e]); }
            s *= scale;
            const bool ok = j <= i;
            const float mn = ok ? fmaxf(m, s) : m; const float a = __expf(m - mn); const float p = ok ? __expf(s - mn) : 0.f;
            lsum = lsum * a + p; m = mn;
#pragma unroll
            for (int c = 0; c < 8; ++c) { const u32x4 w = *(const u32x4*)(V + tk * 512 + h * 64 + c * 8);
#pragma unroll
                for (int e = 0; e < 4; ++e) { o[c * 8 + 2 * e] = o[c * 8 + 2 * e] * a + p * lo16(w[e]); o[c * 8 + 2 * e + 1] = o[c * 8 + 2 * e + 1] * a + p * hi16(w[e]); } }
        }
        const float il = 1.f / lsum;
#pragma unroll
        for (int c = 0; c < 8; ++c) { u32x4 w;
#pragma unroll
            for (int e = 0; e < 4; ++e) w[e] = pk2(o[c * 8 + 2 * e] * il, o[c * 8 + 2 * e + 1] * il);
            *(u32x4*)(O + t * 512 + h * 64 + c * 8) = w; }
    }
}

namespace att {
constexpr int NW = 8, QBLK = 32, KVBLK = 64, QB = NW * QBLK;
constexpr int SHM_V = 16384, SHM_K = 16384;
constexpr int NVS = 3, NKS = 2;
constexpr int ATT_LDS = NVS * SHM_V + NKS * SHM_K + NW * 64 * 4;
constexpr int QS = 768, KNS = 512, KRS = 32, VS = 512, OS = 512;
constexpr float SCALE = 0.10206207261596577f, THR = 8.f;
constexpr unsigned WBIG = 1u << 30;
typedef short s16x4 __attribute__((ext_vector_type(4)));
typedef float f32x16 __attribute__((ext_vector_type(16)));
#define AT_KSWZ(row, colB) ((row) * 256 + ((colB) ^ (((row) & 7) << 4)))
#define AT_SBAR() __builtin_amdgcn_sched_barrier(0)
__device__ __forceinline__ int v_st(int k, int c) { const int kk = (k & ~0xC) | ((k & 4) << 1) | ((k & 8) >> 1); return ((kk >> 3) * 4 + (c >> 5)) * 512 + ((kk & 7) * 32 + (c & 31)) * 2; }
__device__ __forceinline__ int v_rd_base(int lane) { return ((lane & 3) << 3) | (((lane >> 2) & 3) << 6) | (((lane >> 4) & 1) << 5) | (((lane >> 5) & 1) << 8); }
constexpr int v_rd_off(int d0, int ks, int half) { return d0 * 512 + ks * 4096 + half * 2048; }
__device__ __forceinline__ int crow(int r, int hi) { return (r & 3) + 8 * (r >> 2) + 4 * hi; }
__device__ __forceinline__ unsigned cvtpk(float lo, float hi) { unsigned r; asm volatile("v_cvt_pk_bf16_f32 %0, %1, %2" : "=v"(r) : "v"(lo), "v"(hi)); return r; }
__device__ __forceinline__ void mask_tile(f32x16& p0, f32x16& p1, int dq, unsigned W) {
    const float NEG = -__builtin_inff();
#pragma unroll
    for (int r = 0; r < 16; ++r) { const int c = (r & 3) + 8 * (r >> 2);
        if (dq < c) p0[r] = NEG;
        if (dq < c + 32) p1[r] = NEG; }
}
constexpr float THR2 = 8.f;
template <bool FIRST>
__device__ __forceinline__ void partialSM(f32x16& p0, f32x16& p1, float& mref, f32x16& negm, float& alpha) {
    float pmax = p0[0];
#pragma unroll
    for (int r = 1; r < 16; ++r) pmax = fmaxf(pmax, p0[r]);
#pragma unroll
    for (int r = 0; r < 16; ++r) pmax = fmaxf(pmax, p1[r]);
    { auto rr = __builtin_amdgcn_permlane32_swap(__float_as_uint(pmax), __float_as_uint(pmax), false, false);
      pmax = fmaxf(__uint_as_float(rr[0]), __uint_as_float(rr[1])); }
    alpha = 1.f;
    if (FIRST || __builtin_expect(__any(pmax > THR2), 0)) {
        const float dl = FIRST ? pmax : fmaxf(pmax, 0.f);
        mref += dl;
#pragma unroll
        for (int r = 0; r < 16; ++r) { p0[r] -= dl; p1[r] -= dl; }
#pragma unroll
        for (int r = 0; r < 16; ++r) negm[r] = -mref;
        asm volatile("" : "+v"(negm));
        if (!FIRST) alpha = __builtin_amdgcn_exp2f(-dl);
    }
#pragma unroll
    for (int r = 0; r < 16; ++r) p0[r] = __builtin_amdgcn_exp2f(p0[r]);
}
__device__ __forceinline__ void finishSM(f32x16& p0, f32x16& p1, float alpha, float& l_reg, bf16x8& pa0, bf16x8& pa1, bf16x8& pa2, bf16x8& pa3) {
#pragma unroll
    for (int r = 0; r < 16; ++r) p1[r] = __builtin_amdgcn_exp2f(p1[r]);
    float ps = 0;
#pragma unroll
    for (int r = 0; r < 16; ++r) ps += p0[r];
#pragma unroll
    for (int r = 0; r < 16; ++r) ps += p1[r];
    { auto rr = __builtin_amdgcn_permlane32_swap(__float_as_uint(ps), __float_as_uint(ps), false, false);
      ps = __uint_as_float(rr[0]) + __uint_as_float(rr[1]); }
    l_reg = l_reg * alpha + ps;
#define AT_PK4(P, B_, OUT) do { unsigned a0 = cvtpk(P[B_+0], P[B_+1]), a1 = cvtpk(P[B_+2], P[B_+3]);                          \
        unsigned b0 = cvtpk(P[B_+4], P[B_+5]), b1 = cvtpk(P[B_+6], P[B_+7]);                                             \
        auto r0 = __builtin_amdgcn_permlane32_swap(a0, b0, false, false); auto r1 = __builtin_amdgcn_permlane32_swap(a1, b1, false, false); \
        u32x4 w = {r0[0], r1[0], r0[1], r1[1]}; OUT = *reinterpret_cast<bf16x8*>(&w); } while (0)
    AT_PK4(p0, 0, pa0); AT_PK4(p0, 8, pa1); AT_PK4(p1, 0, pa2); AT_PK4(p1, 8, pa3);
#undef AT_PK4
}
template <int KB>
__device__ __forceinline__ void qkt(f32x16& p0, f32x16& p1, const char* K_lds, int r32, int hi, const bf16x8* qr, const f32x16& negm) {
    p0 = negm; p1 = negm;
    const char* kb[4];
#pragma unroll
    for (int dd = 0; dd < 4; ++dd) kb[dd] = K_lds + KB * SHM_K + AT_KSWZ(r32, (dd * 16 + hi * 8) * 2);
#pragma unroll
    for (int d0 = 0; d0 < 6; ++d0) { const char* a = kb[d0 & 3] + (d0 >> 2) * 128;
        bf16x8 b0 = *reinterpret_cast<const bf16x8*>(a);
        bf16x8 b1 = *reinterpret_cast<const bf16x8*>(a + 32 * 256);
        p0 = __builtin_amdgcn_mfma_f32_32x32x16_bf16(b0, qr[d0], p0, 0, 0, 0);
        p1 = __builtin_amdgcn_mfma_f32_32x32x16_bf16(b1, qr[d0], p1, 0, 0, 0); }
}
template <int VB>
__device__ __forceinline__ void pv_tile(f32x16* o, int vb0, bf16x8 pa0, bf16x8 pa1, bf16x8 pa2, bf16x8 pa3) {
#define AT_TRRD(dst, off) asm volatile("ds_read_b64_tr_b16 %0, %1 offset:%2" : "=&v"(dst) : "v"(vb0), "i"(off) : "memory")
#define AT_PV_D0(d0) do { s16x4 l0, l1, l2, l3, h0, h1, h2, h3; constexpr int b_ = VB * SHM_V + v_rd_off(d0, 0, 0); \
        AT_TRRD(l0, b_); AT_TRRD(h0, b_ + 2048); AT_TRRD(l1, b_ + 4096); AT_TRRD(h1, b_ + 6144); AT_TRRD(l2, b_ + 8192); AT_TRRD(h2, b_ + 10240); AT_TRRD(l3, b_ + 12288); AT_TRRD(h3, b_ + 14336); \
        asm volatile("s_waitcnt lgkmcnt(0)" ::: "memory"); AT_SBAR();   \
        o[d0] = __builtin_amdgcn_mfma_f32_32x32x16_bf16(pa0, (bf16x8){l0[0], l0[1], l0[2], l0[3], h0[0], h0[1], h0[2], h0[3]}, o[d0], 0, 0, 0);   \
        o[d0] = __builtin_amdgcn_mfma_f32_32x32x16_bf16(pa1, (bf16x8){l1[0], l1[1], l1[2], l1[3], h1[0], h1[1], h1[2], h1[3]}, o[d0], 0, 0, 0);   \
        o[d0] = __builtin_amdgcn_mfma_f32_32x32x16_bf16(pa2, (bf16x8){l2[0], l2[1], l2[2], l2[3], h2[0], h2[1], h2[2], h2[3]}, o[d0], 0, 0, 0);   \
        o[d0] = __builtin_amdgcn_mfma_f32_32x32x16_bf16(pa3, (bf16x8){l3[0], l3[1], l3[2], l3[3], h3[0], h3[1], h3[2], h3[3]}, o[d0], 0, 0, 0); } while (0)
    AT_PV_D0(0); AT_PV_D0(1);
#undef AT_PV_D0
#undef AT_TRRD
}
struct BlockRef { const bf16_t* Q; const bf16_t* KN; const bf16_t* KR; const bf16_t* V; bf16_t* O; int P0; };
struct Seam { bf16x8 qr[6]; int v_prev, v_cur, v_next; };
#define AT_VMW() asm volatile("s_waitcnt vmcnt(0)" ::: "memory")
#define AT_VMWN(n) asm volatile("s_waitcnt vmcnt(%0)" :: "i"(n) : "memory")
__device__ __forceinline__ void glds16(const void* gsrc, unsigned lds_dst) { unsigned keep;
    asm volatile("s_mov_b32 %0, m0\n\ts_mov_b32 m0, %2\n\ts_nop 0\n\tglobal_load_lds_dwordx4 %1, off\n\ts_mov_b32 m0, %0" : "=&s"(keep) : "v"(gsrc), "s"(lds_dst) : "memory"); }
#define AT_LANE_CONSTS() \
    const int krow_ = 4 * wid + (lane >> 4), kc_ = (lane & 15) ^ (krow_ & 7); const bool isKR = (kc_ >= 8 && kc_ < 12); \
    const unsigned kstrB = isKR ? (unsigned)(KRS * 2) : (unsigned)(KNS * 2), koffB = (unsigned)krow_ * kstrB + (isKR ? (unsigned)(kc_ - 8) * 16u : (kc_ < 8 ? (unsigned)kc_ * 16u : 0u)); \
    const int vkk_ = wid * 8 + ((lane & 31) >> 2), vk_ = (vkk_ & ~0xC) | ((vkk_ & 4) << 1) | ((vkk_ & 8) >> 1); \
    const unsigned voffB = (unsigned)vk_ * (unsigned)(VS * 2) + (unsigned)(((lane >> 5) * 32 + (lane & 3) * 8) * 2); \
    const unsigned lds0 = (unsigned)(uintptr_t)lds
#define AT_DMA_TILE(ref, k0, kslot, vslot) do { \
        const unsigned kd_ = isKR ? (unsigned)((const char*)(ref).KR - (const char*)(ref).KN) : 0u; \
        const char* ks_ = (const char*)(ref).KN + (kd_ + koffB + (unsigned)(k0) * kstrB); \
        glds16(ks_, (unsigned)__builtin_amdgcn_readfirstlane((int)(lds0 + NVS * SHM_V + (kslot) + wid * 1024))); \
        glds16(ks_ + 32u * kstrB, (unsigned)__builtin_amdgcn_readfirstlane((int)(lds0 + NVS * SHM_V + (kslot) + (wid + 8) * 1024))); \
        glds16((const char*)(ref).V + (voffB + (unsigned)(k0) * (unsigned)(VS * 2)), (unsigned)__builtin_amdgcn_readfirstlane((int)(lds0 + (vslot) + wid * 2048))); } while (0)
#define AT_WAIT_SYNC() do { asm volatile("s_waitcnt vmcnt(0)" ::: "memory"); __syncthreads(); } while (0)
__device__ __forceinline__ void prime(const BlockRef& cur, char* lds, Seam& S, int tid) {
    const int wid = __builtin_amdgcn_readfirstlane(tid >> 6), lane = tid & 63, r32 = lane & 31, hi = lane >> 5;
    AT_LANE_CONSTS();
#pragma unroll
    for (int d0 = 0; d0 < 6; ++d0) S.qr[d0] = *(const bf16x8*)((const char*)cur.Q + (unsigned)(((wid * QBLK + r32) * QS + hi * 8) * 2) + d0 * 32);
    AT_DMA_TILE(cur, 0, 0, 0);
    S.v_prev = SHM_V; S.v_cur = 2 * SHM_V; S.v_next = 0;
}
typedef short v4i16_t __attribute__((ext_vector_type(4)));
__device__ __forceinline__ s16x4 vtr(const LAS char* p) { return __builtin_bit_cast(s16x4, __builtin_amdgcn_ds_read_tr16_b64_v4i16((LAS v4i16_t*)p)); }
#define AT_MFMA(a, b, c) __builtin_amdgcn_mfma_f32_32x32x16_bf16(a, b, c, 0, 0, 0)
#define AT_PIN(x) asm volatile("" : "+v"(x))
__device__ __forceinline__ void block(const BlockRef& cur, const BlockRef& nxt, char* lds, Seam& S, int tid) {
    const int wid = __builtin_amdgcn_readfirstlane(tid >> 6), lane = tid & 63, r32 = lane & 31, hi = lane >> 5;
    const int NT = (cur.P0 + QB - 1) / KVBLK + 1;
    const int qlo = cur.P0 + wid * QBLK, qm = qlo + r32 - 4 * hi;
    float* ws = (float*)(lds + NVS * SHM_V + NKS * SHM_K) + wid * 64; float* li_l = ws, * al_l = ws + 32;
    float mref = 0.f, l_reg = 0; f32x16 o[2] = {}; f32x16 negm = {}; AT_PIN(negm);
    AT_LANE_CONSTS();
    const LAS char* lds3 = (const LAS char*)lds;
    const LAS char* kp[4];
#pragma unroll
    for (int dd = 0; dd < 4; ++dd) kp[dd] = lds3 + NVS * SHM_V + AT_KSWZ(r32, (dd * 16 + hi * 8) * 2);
    const LAS char* vp = lds3 + v_rd_base(lane);
#define AT_KBASE(t) ((t) * KVBLK)
#define AT_MASKT(P0_, P1_, t) do { const int kb_ = AT_KBASE(t); if (kb_ + KVBLK - 1 > qlo) mask_tile(P0_, P1_, qm - kb_, WBIG); } while (0)
#define AT_KF(i, KB) (*(const LAS bf16x8*)(kp[((i) >> 1) & 3] + (KB) * SHM_K + ((i) >> 3) * 128 + ((i) & 1) * 8192))
#define AT_VRD(i, VO) do { vlo[i] = vtr(vp + (VO) + v_rd_off((i) >> 2, (i) & 3, 0)); vhi[i] = vtr(vp + (VO) + v_rd_off((i) >> 2, (i) & 3, 1)); } while (0)
#define AT_VFR(i) (bf16x8){vlo[i][0], vlo[i][1], vlo[i][2], vlo[i][3], vhi[i][0], vhi[i][1], vhi[i][2], vhi[i][3]}
#define AT_PAF(k) __builtin_bit_cast(bf16x8, pw##k)
#define AT_SWAPS(PW) do { auto r0_ = __builtin_amdgcn_permlane32_swap(a0, b0, false, false); auto r1_ = __builtin_amdgcn_permlane32_swap(a1, b1, false, false); PW = (u32x4){r0_[0], r1_[0], r0_[1], r1_[1]}; AT_PIN(PW); } while (0)
#define AT_EX4(X, B) do { X[B] = __builtin_amdgcn_exp2f(X[B]); X[B + 1] = __builtin_amdgcn_exp2f(X[B + 1]); X[B + 2] = __builtin_amdgcn_exp2f(X[B + 2]); X[B + 3] = __builtin_amdgcn_exp2f(X[B + 3]); AT_PIN(X); AT_SBAR(); } while (0)
#define AT_ROWMAX(C0, C1, rm) do { float a_ = fmaxf(fmaxf(C0[0], C0[1]), C1[0]), b_ = fmaxf(fmaxf(C0[2], C0[3]), C1[1]); a_ = fmaxf(fmaxf(a_, C1[2]), C1[3]); \
        _Pragma("unroll") for (int r = 4; r < 16; r += 4) { a_ = fmaxf(fmaxf(a_, C0[r]), C0[r + 1]); b_ = fmaxf(fmaxf(b_, C0[r + 2]), C0[r + 3]); a_ = fmaxf(fmaxf(a_, C1[r]), C1[r + 1]); b_ = fmaxf(fmaxf(b_, C1[r + 2]), C1[r + 3]); } \
        rm = fmaxf(a_, b_); { auto rr_ = __builtin_amdgcn_permlane32_swap(__float_as_uint(rm), __float_as_uint(rm), false, false); rm = fmaxf(__uint_as_float(rr_[0]), __uint_as_float(rr_[1])); } } while (0)
#define AT_PHASE_A(C0, C1, P0, P1, KB, VB) do { \
        kf[0] = AT_KF(0, KB); kf[1] = AT_KF(1, KB); kf[2] = AT_KF(2, KB); kf[3] = AT_KF(3, KB); AT_SBAR(); \
        sacc = P0[0] + P0[1]; \
        C0 = AT_MFMA(kf[0], S.qr[0], negm); kf[4] = AT_KF(4, KB); sacc += P0[2]; sacc += P0[3]; a0 = cvt_pk(P0[0], P0[1]); a1 = cvt_pk(P0[2], P0[3]); AT_PIN(a0); AT_PIN(a1); AT_PIN(sacc); AT_SBAR(); \
        C1 = AT_MFMA(kf[1], S.qr[0], negm); kf[5] = AT_KF(5, KB); sacc += P0[4]; sacc += P0[5]; sacc += P0[6]; b0 = cvt_pk(P0[4], P0[5]); b1 = cvt_pk(P0[6], P0[7]); AT_PIN(b0); AT_PIN(b1); AT_PIN(sacc); AT_SBAR(); \
        C0 = AT_MFMA(kf[2], S.qr[1], C0); kf[6] = AT_KF(6, KB); sacc += P0[7]; sacc += P0[8]; sacc += P0[9]; AT_SWAPS(pw0); AT_PIN(sacc); AT_SBAR(); \
        C1 = AT_MFMA(kf[3], S.qr[1], C1); kf[7] = AT_KF(7, KB); sacc += P0[10]; sacc += P0[11]; sacc += P0[12]; a0 = cvt_pk(P0[8], P0[9]); a1 = cvt_pk(P0[10], P0[11]); AT_PIN(a0); AT_PIN(a1); AT_PIN(sacc); AT_SBAR(); \
        C0 = AT_MFMA(kf[4], S.qr[2], C0); kf[8] = AT_KF(8, KB); sacc += P0[13]; sacc += P0[14]; sacc += P0[15]; b0 = cvt_pk(P0[12], P0[13]); b1 = cvt_pk(P0[14], P0[15]); AT_PIN(b0); AT_PIN(b1); AT_PIN(sacc); AT_SBAR(); \
        C1 = AT_MFMA(kf[5], S.qr[2], C1); kf[9] = AT_KF(9, KB); sacc += P1[0]; sacc += P1[1]; sacc += P1[2]; AT_SWAPS(pw1); AT_PIN(sacc); AT_SBAR(); \
        C0 = AT_MFMA(kf[6], S.qr[3], C0); kf[10] = AT_KF(10, KB); sacc += P1[3]; sacc += P1[4]; sacc += P1[5]; a0 = cvt_pk(P1[0], P1[1]); a1 = cvt_pk(P1[2], P1[3]); AT_PIN(a0); AT_PIN(a1); AT_PIN(sacc); AT_SBAR(); \
        C1 = AT_MFMA(kf[7], S.qr[3], C1); kf[11] = AT_KF(11, KB); sacc += P1[6]; sacc += P1[7]; sacc += P1[8]; b0 = cvt_pk(P1[4], P1[5]); b1 = cvt_pk(P1[6], P1[7]); AT_PIN(b0); AT_PIN(b1); AT_PIN(sacc); AT_SBAR(); \
        C0 = AT_MFMA(kf[8], S.qr[4], C0);  sacc += P1[9]; sacc += P1[10]; sacc += P1[11]; AT_SWAPS(pw2); AT_PIN(sacc); AT_SBAR(); \
        C1 = AT_MFMA(kf[9], S.qr[4], C1);  sacc += P1[12]; sacc += P1[13]; sacc += P1[14]; a0 = cvt_pk(P1[8], P1[9]); a1 = cvt_pk(P1[10], P1[11]); AT_PIN(a0); AT_PIN(a1); AT_PIN(sacc); AT_SBAR(); \
        C0 = AT_MFMA(kf[10], S.qr[5], C0); sacc += P1[15]; b0 = cvt_pk(P1[12], P1[13]); b1 = cvt_pk(P1[14], P1[15]); AT_PIN(b0); AT_PIN(b1); AT_PIN(sacc); AT_SBAR(); \
        C1 = AT_MFMA(kf[11], S.qr[5], C1); AT_SWAPS(pw3); AT_SBAR(); \
        l_reg += sacc; } while (0)
#define AT_DECIDE(C0, C1) do { float rm_; AT_ROWMAX(C0, C1, rm_); resc = false; \
        if (__builtin_expect(__any(rm_ > THR2), 0)) { const float dl_ = fmaxf(rm_, 0.f); mref += dl_; \
            _Pragma("unroll") for (int r = 0; r < 16; ++r) { C0[r] -= dl_; C1[r] -= dl_; } \
            _Pragma("unroll") for (int r = 0; r < 16; ++r) negm[r] = -mref; AT_PIN(negm); \
            fsc = __builtin_amdgcn_exp2f(-dl_); l_reg *= fsc; resc = true; } AT_SBAR(); } while (0)
#define AT_PHASE_B(C0, C1, VB) do { AT_VRD(0, VB); AT_VRD(4, VB); AT_SBAR(); \
        o[0] = AT_MFMA(AT_PAF(0), AT_VFR(0), o[0]); AT_VRD(1, VB); AT_EX4(C0, 0); \
        o[1] = AT_MFMA(AT_PAF(0), AT_VFR(4), o[1]); AT_VRD(5, VB); AT_EX4(C0, 4); \
        o[0] = AT_MFMA(AT_PAF(1), AT_VFR(1), o[0]); AT_VRD(2, VB); AT_EX4(C0, 8); \
        o[1] = AT_MFMA(AT_PAF(1), AT_VFR(5), o[1]); AT_VRD(6, VB); AT_EX4(C0, 12); \
        o[0] = AT_MFMA(AT_PAF(2), AT_VFR(2), o[0]); AT_VRD(3, VB); AT_EX4(C1, 0); \
        o[1] = AT_MFMA(AT_PAF(2), AT_VFR(6), o[1]); AT_VRD(7, VB); AT_EX4(C1, 4); \
        o[0] = AT_MFMA(AT_PAF(3), AT_VFR(3), o[0]); AT_EX4(C1, 8); \
        o[1] = AT_MFMA(AT_PAF(3), AT_VFR(7), o[1]); AT_EX4(C1, 12); } while (0)
#define AT_RESC() do { if (resc) { if (hi == 0) al_l[r32] = fsc; asm volatile("s_waitcnt lgkmcnt(0)" ::: "memory");              \
                     for (int d_ = 0; d_ < 2; ++d_) for (int r = 0; r < 16; ++r) o[d_][r] *= al_l[crow(r, hi)]; } } while (0)
    f32x16 pA0, pA1, pB0, pB1; bf16x8 kf[12]; s16x4 vlo[8], vhi[8]; u32x4 pw0, pw1, pw2, pw3; unsigned a0, a1, b0, b1; float sacc, fsc = 1.f; bool resc = false;
    int v_prev = S.v_prev, v_cur = S.v_cur, v_next = S.v_next;
#define AT_ROT() do { v_prev = v_cur; v_cur = v_next; v_next = (v_next == (NVS - 1) * SHM_V) ? 0 : v_next + SHM_V; } while (0)
    AT_WAIT_SYNC(); AT_ROT();
    AT_DMA_TILE(cur, AT_KBASE(1), SHM_K, v_next);
#pragma unroll
    for (int i = 0; i < 12; ++i) kf[i] = AT_KF(i, 0);
    pA0 = AT_MFMA(kf[0], S.qr[0], negm); pA1 = AT_MFMA(kf[1], S.qr[0], negm);
#pragma unroll
    for (int i = 2; i < 12; i += 2) { pA0 = AT_MFMA(kf[i], S.qr[i >> 1], pA0); pA1 = AT_MFMA(kf[i + 1], S.qr[i >> 1], pA1); }
    AT_MASKT(pA0, pA1, 0);
    { float rm_; AT_ROWMAX(pA0, pA1, rm_); mref = rm_;
#pragma unroll
      for (int r = 0; r < 16; ++r) { pA0[r] -= rm_; pA1[r] -= rm_; }
#pragma unroll
      for (int r = 0; r < 16; ++r) negm[r] = -mref;
      AT_PIN(negm);
#pragma unroll
      for (int r = 0; r < 16; ++r) { pA0[r] = __builtin_amdgcn_exp2f(pA0[r]); pA1[r] = __builtin_amdgcn_exp2f(pA1[r]); } }
    AT_WAIT_SYNC(); AT_ROT();
#define AT_STEP(C0, C1, P0, P1, t, KB) do { AT_SBAR();                                                                         \
        AT_DMA_TILE(cur, AT_KBASE((t) + 1), (1 - (KB)) * SHM_K, v_next); AT_SBAR();                                            \
        AT_PHASE_A(C0, C1, P0, P1, KB, 0);                                                                                    \
        AT_MASKT(C0, C1, (t)); AT_DECIDE(C0, C1);                                                                             \
        AT_PHASE_B(C0, C1, v_prev);                                                                                           \
        AT_RESC(); AT_WAIT_SYNC(); AT_ROT(); } while (0)
    for (int t = 1; t + 1 < NT; t += 2) {
        AT_STEP(pB0, pB1, pA0, pA1, t, 1);
        AT_STEP(pA0, pA1, pB0, pB1, t + 1, 0);
    }
    AT_SBAR();
    BlockRef nx = nxt;
    asm volatile("" : "+s"(nx.Q), "+s"(nx.KN), "+s"(nx.KR), "+s"(nx.V));
    AT_DMA_TILE(nx, 0, 0, v_next); AT_SBAR();
    AT_PHASE_A(pB0, pB1, pA0, pA1, 1, 0);
#pragma unroll
    for (int d0 = 0; d0 < 6; ++d0) S.qr[d0] = *(const bf16x8*)((const char*)nx.Q + (unsigned)(((wid * QBLK + r32) * QS + hi * 8) * 2) + d0 * 32);
    AT_SBAR();
    AT_MASKT(pB0, pB1, NT - 1); AT_DECIDE(pB0, pB1);
    AT_PHASE_B(pB0, pB1, v_prev);
    AT_RESC();
    { sacc = pB0[0] + pB0[1];
#pragma unroll
      for (int r = 2; r < 16; ++r) sacc += pB0[r];
#pragma unroll
      for (int r = 0; r < 16; ++r) sacc += pB1[r];
      l_reg += sacc;
#pragma unroll
      for (int i = 0; i < 8; ++i) AT_VRD(i, v_cur);
      a0 = cvt_pk(pB0[0], pB0[1]); a1 = cvt_pk(pB0[2], pB0[3]); b0 = cvt_pk(pB0[4], pB0[5]); b1 = cvt_pk(pB0[6], pB0[7]); AT_SWAPS(pw0);
      a0 = cvt_pk(pB0[8], pB0[9]); a1 = cvt_pk(pB0[10], pB0[11]); b0 = cvt_pk(pB0[12], pB0[13]); b1 = cvt_pk(pB0[14], pB0[15]); AT_SWAPS(pw1);
      a0 = cvt_pk(pB1[0], pB1[1]); a1 = cvt_pk(pB1[2], pB1[3]); b0 = cvt_pk(pB1[4], pB1[5]); b1 = cvt_pk(pB1[6], pB1[7]); AT_SWAPS(pw2);
      a0 = cvt_pk(pB1[8], pB1[9]); a1 = cvt_pk(pB1[10], pB1[11]); b0 = cvt_pk(pB1[12], pB1[13]); b1 = cvt_pk(pB1[14], pB1[15]); AT_SWAPS(pw3);
      o[0] = AT_MFMA(AT_PAF(0), AT_VFR(0), o[0]); o[1] = AT_MFMA(AT_PAF(0), AT_VFR(4), o[1]); o[0] = AT_MFMA(AT_PAF(1), AT_VFR(1), o[0]); o[1] = AT_MFMA(AT_PAF(1), AT_VFR(5), o[1]);
      o[0] = AT_MFMA(AT_PAF(2), AT_VFR(2), o[0]); o[1] = AT_MFMA(AT_PAF(2), AT_VFR(6), o[1]); o[0] = AT_MFMA(AT_PAF(3), AT_VFR(3), o[0]); o[1] = AT_MFMA(AT_PAF(3), AT_VFR(7), o[1]); }
    S.v_prev = v_prev; S.v_cur = v_cur; S.v_next = v_next;
    { auto rr = __builtin_amdgcn_permlane32_swap(__float_as_uint(l_reg), __float_as_uint(l_reg), false, false); l_reg = __uint_as_float(rr[0]) + __uint_as_float(rr[1]); }
    if (hi == 0) li_l[r32] = l_reg; asm volatile("s_waitcnt lgkmcnt(0)" ::: "memory");
    float rli[16];
#pragma unroll
    for (int r = 0; r < 16; ++r) rli[r] = __builtin_amdgcn_rcpf(li_l[crow(r, hi)]);
    bf16_t* Oc = cur.O; asm volatile("" : "+s"(Oc));
    bf16_t* Ow = Oc + (size_t)(wid * QBLK) * OS;
#pragma unroll
    for (int r = 0; r < 16; ++r) { const int orow = crow(r, hi);
#pragma unroll
        for (int d0 = 0; d0 < 2; ++d0) { const float v = o[d0][r] * rli[r]; const float vn = __shfl_xor(v, 1);
            if ((r32 & 1) == 0) *(unsigned*)((char*)Ow + (unsigned)((orow * OS + d0 * 32 + r32) * 2)) = cvtpk(v, vn); } }
#undef AT_RESC
#undef AT_ROT
#undef AT_KBASE
#undef AT_MASKT
#undef AT_STEP
#undef AT_PHASE_A
#undef AT_PHASE_B
#undef AT_DECIDE
#undef AT_ROWMAX
#undef AT_EX4
#undef AT_SWAPS
#undef AT_PAF
#undef AT_VFR
#undef AT_VRD
#undef AT_KF
}
__device__ __forceinline__ BlockRef make_ref(int L, int pass, const bf16_t* Q, const bf16_t* KN, const bf16_t* KR, const bf16_t* V, bf16_t* O) {
    const int bh = L >> 3, x = L & 7, b = bh >> 3, h = bh & 7, qb = pass ? 15 - x : x;
    BlockRef r; const size_t row0 = (size_t)b * S;
    r.Q = Q + (row0 + (size_t)qb * QB) * QS + h * 96; r.O = O + (row0 + (size_t)qb * QB) * OS + h * 64;
    r.KN = KN + row0 * KNS + h * 64; r.KR = KR + row0 * KRS; r.V = V + row0 * VS + h * 64; r.P0 = qb * QB;
    return r;
}
__device__ __forceinline__ void phase(char* lds, int tid, int vcu, int G, const bf16_t* Q, const bf16_t* KN, const bf16_t* KR, const bf16_t* V, bf16_t* O) {
    const int total = NB * NH * 8;
    int L = vcu; if (L >= total) return;
    if (__builtin_amdgcn_readfirstlane(tid >> 6) >= 4) __builtin_amdgcn_s_setprio(1);
    int pass = 0;
    BlockRef cur = make_ref(L, 0, Q, KN, KR, V, O);
    Seam S;
    prime(cur, lds, S, tid);
    for (;;) {
        const bool more_pass = pass == 0, more_item = L + G < total, last = !more_pass && !more_item;
        int passn = pass + 1, Ln = L;
        if (!more_pass) { passn = 0; Ln = more_item ? L + G : L; }
        const BlockRef nxt = last ? cur : make_ref(Ln, passn, Q, KN, KR, V, O);
        block(cur, nxt, lds, S, tid);
        if (last) break;
        cur = nxt; pass = passn; L = Ln;
    }
    __builtin_amdgcn_s_setprio(0);
}
#undef AT_VMW
#undef AT_VMWN
#undef AT_LANE_CONSTS
#undef AT_DMA_TILE
#undef AT_WAIT_SYNC
#undef AT_KSWZ
#undef AT_SBAR
}

__device__ __forceinline__ void moe_tables(Frame& F, int l) {
    const int tid_ = fresh_tid(F.wave);
    LAS int* base = (LAS int*)(F.lds + TAB_OFF); LAS int* cntl = (LAS int*)(F.lds + TAB_OFF + 192);
    LAS unsigned char* tile_e = (LAS unsigned char*)(F.lds + TAB_OFF + 320); LAS unsigned short* tile_r = (LAS unsigned short*)(F.lds + TAB_OFF + 896);
    __syncthreads();
    if (F.wave == 0) {
        const int lane = tid_ & 63;
        const int c = lane < NE ? (int)__hip_atomic_load(((unsigned*)F.ws) + CW_CNT + (l * NE + lane) * 64, __ATOMIC_RELAXED, __HIP_MEMORY_SCOPE_AGENT) : 0;
        const int nt = (c + 255) >> 8; int incl = nt;
#pragma unroll
        for (int o = 1; o < 32; o <<= 1) { const int v = __shfl_up(incl, o); if (lane >= o) incl += v; }
        const int excl = incl - nt;
        if (lane < NE) { base[lane] = excl * 256; cntl[lane] = c; for (int k = 0; k < nt; ++k) { tile_e[excl + k] = (unsigned char)lane; tile_r[excl + k] = (unsigned short)k; } }
        if (lane == NE - 1) { base[NE] = incl * 256; base[NE + 1] = incl; } }
    __syncthreads();
}
__device__ __forceinline__ void route_pass(Frame& F, int l, const bf16_t* X, const bool dry) {
    const int tid_ = fresh_tid(F.wave), lane_ = tid_ & 63, c16 = lane_ & 15, q = lane_ >> 4;
    LAS float* LG = (LAS float*)(F.lds + F.wave * 4096);
    const bf16_t* WH = (const bf16_t*)(F.ws + WS_WRT); const bf16_t* WL = WH + 48 * 1024;
    const float* bg = F.in[18] + l * 4; const float* be = F.in[20] + l * NE; const float* gain = F.in[16] + l * D;
    unsigned* rec = (unsigned*)(F.ws + WS_REC); unsigned* list = (unsigned*)(F.ws + WS_LIST); float* rl = (float*)(F.ws + WS_RL);
    const int gw_ = (int)blockIdx.x * NWAVES + F.wave, ngw_ = F.G * NWAVES, ntile_ = T / 16, nit_ = (ntile_ + 2 * ngw_ - 1) / (2 * ngw_);
    LAS unsigned* LC = (LAS unsigned*)(F.lds + TAB_OFF); LAS unsigned* GB = LC + 32;
    struct RouteRes { int e0, e1, row; unsigned l0, l1; float w0, w1, rstd; };
    for (int it_ = 0; it_ < nit_; ++it_) {
        const int tile0 = it_ * 2 * ngw_ + gw_, tile1 = tile0 + ngw_; const bool has0 = tile0 < ntile_, has1 = tile1 < ntile_;
        if (tid_ < 32) LC[tid_] = 0u;
        __syncthreads();
        RouteRes RA{}, RB{};
        if (has0) {
        const int rowA = tile0 * 16 + c16, rowB = (has1 ? tile1 : tile0) * 16 + c16;
        const bf16_t* xa = X + (size_t)rowA * D + 8 * q; const bf16_t* xb = X + (size_t)rowB * D + 8 * q; const float* gr = gain + 8 * q;
        const bf16_t* wh = WH + (size_t)c16 * 1024 + 8 * q; const bf16_t* wl = WL + (size_t)c16 * 1024 + 8 * q;
        f32x4 accA[3], accB[3]; accA[0] = (f32x4){0.f, 0.f, 0.f, 0.f}; accA[1] = accA[0]; accA[2] = accA[0]; accB[0] = accA[0]; accB[1] = accA[0]; accB[2] = accA[0]; float ssA = 0.f, ssB = 0.f;
#pragma unroll 4
        for (int ks = 0; ks < 32; ++ks) {
            const u32x4 xwa = *(const u32x4*)(xa + 32 * ks), xwb = *(const u32x4*)(xb + 32 * ks);
            const f32x4 g0 = *(const f32x4*)(gr + 32 * ks), g1 = *(const f32x4*)(gr + 32 * ks + 4);
            bf16x8 Bh[3], Bl[3];
#pragma unroll
            for (int nt = 0; nt < 3; ++nt) { Bh[nt] = *(const bf16x8*)(wh + (size_t)nt * 16 * 1024 + 32 * ks); Bl[nt] = *(const bf16x8*)(wl + (size_t)nt * 16 * 1024 + 32 * ks); }
#pragma unroll
            for (int h = 0; h < 2; ++h) { const u32x4 xw = h ? xwb : xwa;
                const f32x4 x0 = (f32x4){lo16(xw.x), hi16(xw.x), lo16(xw.y), hi16(xw.y)}, x1 = (f32x4){lo16(xw.z), hi16(xw.z), lo16(xw.w), hi16(xw.w)};
                if (h) ssB += dot8(x0, x1); else ssA += dot8(x0, x1);
                const f32x4 h0 = x0 * g0, h1 = x1 * g1;
                const u32x4 ph = pack8(h0, h1);
                const f32x4 r0 = h0 - (f32x4){lo16(ph.x), hi16(ph.x), lo16(ph.y), hi16(ph.y)}, r1 = h1 - (f32x4){lo16(ph.z), hi16(ph.z), lo16(ph.w), hi16(ph.w)};
                const u32x4 pl = pack8(r0, r1);
                const bf16x8 Ah = __builtin_bit_cast(bf16x8, ph), Al = __builtin_bit_cast(bf16x8, pl);
#pragma unroll
                for (int nt = 0; nt < 3; ++nt) { f32x4 a_ = h ? accB[nt] : accA[nt];
                    a_ = __builtin_amdgcn_mfma_f32_16x16x32_bf16(Ah, Bh[nt], a_, 0, 0, 0);
                    a_ = __builtin_amdgcn_mfma_f32_16x16x32_bf16(Ah, Bl[nt], a_, 0, 0, 0);
                    a_ = __builtin_amdgcn_mfma_f32_16x16x32_bf16(Al, Bh[nt], a_, 0, 0, 0);
                    if (h) accB[nt] = a_; else accA[nt] = a_; } } }
        auto finish = [&](const f32x4 (&acc)[3], float ss, const int row, RouteRes& RR) {
        ss += __shfl_xor(ss, 16); ss += __shfl_xor(ss, 32);
        const float rstd = rsqrtf(ss * (1.f / D) + EPS);
#pragma unroll
        for (int nt = 0; nt < 3; ++nt)
#pragma unroll
            for (int r = 0; r < 4; ++r) LG[(4 * q + r) * 48 + 16 * nt + c16] = acc[nt][r];
        LDS_WAIT(); asm volatile("" ::: "memory");
        if (lane_ < 16 && !dry) {
            const LAS float* lr = LG + lane_ * 48;
            float lg[4], le[32];
#pragma unroll
            for (int n = 0; n < 4; ++n) lg[n] = lr[n] * rstd + bg[n];
#pragma unroll
            for (int n = 0; n < 32; ++n) le[n] = lr[4 + n] * rstd + be[n];
            int gi = 0; float gm = lg[0];
#pragma unroll
            for (int n = 1; n < 4; ++n) if (lg[n] > gm) { gm = lg[n]; gi = n; }
            float gs = 0.f;
#pragma unroll
            for (int n = 0; n < 4; ++n) gs += __expf(lg[n] - gm);
            const float gp = 1.f / gs;
            float es[8];
#pragma unroll
            for (int j = 0; j < 8; ++j) es[j] = gi == 0 ? le[j] : (gi == 1 ? le[8 + j] : (gi == 2 ? le[16 + j] : le[24 + j]));
            int i0 = 0; float m0 = es[0];
#pragma unroll
            for (int j = 1; j < 8; ++j) if (es[j] > m0) { m0 = es[j]; i0 = j; }
            int i1 = -1; float m1 = -3.0e38f;
#pragma unroll
            for (int j = 0; j < 8; ++j) if (j != i0 && es[j] > m1) { m1 = es[j]; i1 = j; }
            const float p1 = __expf(m1 - m0);
            const float w0 = gp / (1.f + p1), w1 = gp * p1 / (1.f + p1);
            const int e0 = gi * 8 + i0, e1 = gi * 8 + i1;
            RR.e0 = e0; RR.e1 = e1; RR.row = row; RR.w0 = w0; RR.w1 = w1; RR.rstd = rstd;
            RR.l0 = __hip_atomic_fetch_add(LC + e0, 1u, __ATOMIC_RELAXED, __HIP_MEMORY_SCOPE_WORKGROUP);
            RR.l1 = __hip_atomic_fetch_add(LC + e1, 1u, __ATOMIC_RELAXED, __HIP_MEMORY_SCOPE_WORKGROUP);
        }
        LDS_WAIT(); asm volatile("" ::: "memory");
        };
        finish(accA, ssA, rowA, RA);
        if (has1) finish(accB, ssB, rowB, RB);
        }
        __syncthreads();
        if (F.wave == 0 && lane_ < NE && !dry) { const unsigned c = LC[lane_];
            GB[lane_] = c ? __hip_atomic_fetch_add(((unsigned*)F.ws) + CW_CNT + (l * NE + lane_) * 64, c, __ATOMIC_RELAXED, __HIP_MEMORY_SCOPE_AGENT) : 0u; }
        __syncthreads();
        auto commit = [&](const RouteRes& RR) {
            const unsigned pos0 = GB[RR.e0] + RR.l0, pos1 = GB[RR.e1] + RR.l1;
            u32x4 r0 = {(unsigned)RR.e0, pos0, (unsigned)RR.e1, pos1}, r1 = {__float_as_uint(RR.w0), __float_as_uint(RR.w1), __float_as_uint(RR.rstd), 0u};
            *(u32x4*)(rec + (size_t)RR.row * 8) = r0; *(u32x4*)(rec + (size_t)RR.row * 8 + 4) = r1;
            list[(size_t)RR.e0 * T + pos0] = (unsigned)RR.row; rl[(size_t)RR.e0 * T + pos0] = RR.rstd; list[(size_t)RR.e1 * T + pos1] = (unsigned)RR.row; rl[(size_t)RR.e1 * T + pos1] = RR.rstd; };
        if (has0 && lane_ < 16 && !dry) { commit(RA); if (has1) commit(RB); }
        __syncthreads();
    }
}
__device__ __forceinline__ void prep_small(Frame& F, int l) {
    const int tid_ = fresh_tid(F.wave); const int gt = blockIdx.x * NTHREADS + tid_, nt = F.G * NTHREADS;
    const float* wsrc = F.in[9] + (size_t)l * 4 * 128 * 128; bf16_t* WSG = (bf16_t*)(F.ws + WS_WSG);
    for (int idx = gt; idx < 4 * 128 * 128; idx += nt) { const int t = (idx >> 7) & 127, sidx = idx & 127; WSG[idx] = (bf16_t)f2bf(sidx <= t ? wsrc[idx] : 0.f); }
    const float* wg = F.in[17] + (size_t)l * D * 4; const float* we = F.in[19] + (size_t)l * D * NE; bf16_t* WH = (bf16_t*)(F.ws + WS_WRT); bf16_t* WL = WH + 48 * 1024;
    for (int idx = gt; idx < 48 * 1024; idx += nt) { const int n = idx >> 10, k = idx & 1023;
        const float v = n < 4 ? wg[k * 4 + n] : (n < 36 ? we[k * NE + (n - 4)] : 0.f);
        const unsigned h = f2bf(v); WH[idx] = (bf16_t)h; WL[idx] = (bf16_t)f2bf(v - bf2f(h)); }
}
__device__ __forceinline__ void combine_pass(Frame& F, const bf16_t* Xin, float* RS, float* OUT, const float* gain, bf16_t* H, unsigned char* H8, bool final_out) {
    const int tid_ = fresh_tid(F.wave), lane_ = tid_ & 63; (void)lane_;
    const LAS int* base = (const LAS int*)(F.lds + TAB_OFF); const unsigned* rec = (const unsigned*)(F.ws + WS_REC); const unsigned char* YB = F.ws + WS_YB;
    constexpr int RB = 4;
    f32x4 g[4];
#pragma unroll
    for (int j = 0; j < 4; ++j) g[j] = ((const f32x4*)gain)[lane_ + 64 * j];
    for (int m0 = ((int)blockIdx.x * NWAVES + F.wave); m0 < T; m0 += RB * (F.G * NWAVES)) {
        u32x4 r0[RB], r1[RB]; u32x2 xv[RB][4]; unsigned ya[RB][4], yb[RB][4];
#pragma unroll
        for (int r = 0; r < RB; ++r) { const int m = m0 + r * (F.G * NWAVES); if (m < T) { r0[r] = *(const u32x4*)(rec + (size_t)m * 8); r1[r] = *(const u32x4*)(rec + (size_t)m * 8 + 4); } }
#pragma unroll
        for (int r = 0; r < RB; ++r) { const int m = m0 + r * (F.G * NWAVES); if (m < T) {
            const size_t s0 = (size_t)base[r0[r].x] + r0[r].y, s1 = (size_t)base[r0[r].z] + r0[r].w;
            const u32x2* xr = (const u32x2*)(Xin + (size_t)m * D) + lane_;
            const unsigned* y0 = (const unsigned*)(YB + s0 * D) + lane_; const unsigned* y1 = (const unsigned*)(YB + s1 * D) + lane_;
#pragma unroll
            for (int j = 0; j < 4; ++j) { xv[r][j] = xr[64 * j]; ya[r][j] = y0[64 * j]; yb[r][j] = y1[64 * j]; } } }
#pragma unroll
        for (int r = 0; r < RB; ++r) { const int m = m0 + r * (F.G * NWAVES); if (m < T) {
            const float w0 = __uint_as_float(r1[r].x), w1 = __uint_as_float(r1[r].y); float ss = 0.f; f32x4 v[4];
#pragma unroll
            for (int j = 0; j < 4; ++j) { const u32x2 x_ = xv[r][j];
                const f32x2 a0 = __builtin_amdgcn_cvt_pk_f32_fp8((int)ya[r][j], false), a1 = __builtin_amdgcn_cvt_pk_f32_fp8((int)ya[r][j], true), b0 = __builtin_amdgcn_cvt_pk_f32_fp8((int)yb[r][j], false), b1 = __builtin_amdgcn_cvt_pk_f32_fp8((int)yb[r][j], true);
                v[j].x = lo16(x_.x) + w0 * a0[0] + w1 * b0[0]; v[j].y = hi16(x_.x) + w0 * a0[1] + w1 * b0[1]; v[j].z = lo16(x_.y) + w0 * a1[0] + w1 * b1[0]; v[j].w = hi16(x_.y) + w0 * a1[1] + w1 * b1[1];
                ss += (v[j].x * v[j].x + v[j].y * v[j].y) + (v[j].z * v[j].z + v[j].w * v[j].w); }
            const float ms = wave_sum(ss) * (1.f / D) + EPS, rstd = rsqrtf(ms);
            if (final_out) { f32x4* o = (f32x4*)(OUT + (size_t)m * D) + lane_;
#pragma unroll
                for (int j = 0; j < 4; ++j) o[64 * j] = (f32x4){v[j].x * rstd * g[j].x, v[j].y * rstd * g[j].y, v[j].z * rstd * g[j].z, v[j].w * rstd * g[j].w};
            } else {
                u32x2* o = (u32x2*)(H + (size_t)m * D) + lane_; if (lane_ == 0) RS[m] = ms * rstd;
#pragma unroll
                for (int j = 0; j < 4; ++j) { u32x2 w;
                    w.x = cvt_pk(v[j].x * rstd * g[j].x, v[j].y * rstd * g[j].y); w.y = cvt_pk(v[j].z * rstd * g[j].z, v[j].w * rstd * g[j].w); o[64 * j] = w; }
                unsigned* o8 = (unsigned*)(H8 + (size_t)m * D) + lane_;
#pragma unroll
                for (int j = 0; j < 4; ++j) o8[64 * j] = pk4f8(v[j].x * rstd * g[j].x, v[j].y * rstd * g[j].y, v[j].z * rstd * g[j].z, v[j].w * rstd * g[j].w);
            } } }
    }
}
template <int KK, int NperE, bool FP8 = false, class Fn>
__device__ __forceinline__ void gemm_moe(Frame& F, const bf16_t* A, const bf16_t* Bt, const Fn& f) {
    const LAS int* base = (const LAS int*)(F.lds + TAB_OFF);
    pg8::Gemm g{A, Bt}; pg8::MoeOrder So{(const LAS unsigned char*)(F.lds + TAB_OFF + 320), base[NE + 1], NperE / 256, F.G, (int)blockIdx.x};
    pg8::Epi8<Fn> E{f};
    pg8::gemm_phase<pg8::Epi8<Fn>, pg8::MoeOrder, KK, KK, KK, true, false, FP8>(F.lds, F.wave, g, So, E);
}

constexpr int PH_PER_LAYER = 9, N_PHASES = 1 + DEPTH * PH_PER_LAYER;
struct Args { const float* in[24]; float* out; unsigned char* ws; int ph_lo, ph_hi; };
#ifndef PHSEL
#define PHSEL -1
#endif
#ifndef REPEAT_MASK
#define REPEAT_MASK 0
#endif
#define REP(k) for (int rep_ = 0; rep_ < 1 + ((REPEAT_MASK >> (k)) & 1); ++rep_)
#define PHOK(j) (PHSEL < 0 || PHSEL == (j))
#define IN(k) (lo <= (k) && (k) < hi)
#define SEAM(k) do { if (IN(k) && IN((k) + 1)) xcd_barrier(bar, fresh_tid(F.wave) == 0); } while (0)
template <int l>
__device__ __forceinline__ void layer_body(Frame& F, const XcdBarrier& bar, const int lo, const int hi) {
    unsigned char* ws = F.ws; unsigned char* wt = ws + WS_WT;
    bf16_t* H = (bf16_t*)(ws + WS_H);
    constexpr int pb = 1 + l * PH_PER_LAYER;
    bf16_t* XS = (bf16_t*)F.out;
    bf16_t* xnew = (l + 1 < DEPTH) ? XS : (bf16_t*)(ws + WS_X1);
    if (PHOK(1) && IN(pb + 0)) {
        { EpiP1<true> E{(bf16_t*)(ws + WS_T0), (bf16_t*)(ws + WS_SGU), (bf16_t*)(ws + WS_GV), (bf16_t*)(ws + WS_CB), (bf16_t*)(ws + WS_Z), (float*)(ws + WS_ST0), (float*)(ws + WS_STV)};
          REP(0) gemm_dense<D / 2, D / 2, N_F8A, D / 2, true>(F, (const bf16_t*)(ws + WS_H8), (const bf16_t*)(wt + WT_WT8), E); }
        { EpiP1<false> E{(bf16_t*)(ws + WS_T0), (bf16_t*)(ws + WS_SGU), (bf16_t*)(ws + WS_GV), (bf16_t*)(ws + WS_CB), (bf16_t*)(ws + WS_Z), (float*)(ws + WS_ST0), (float*)(ws + WS_STV)};
          REP(0) gemm_dense<D, D, N_P1 - N_F8A, D>(F, H, (const bf16_t*)(wt + WT_WIN) + (size_t)N_F8A * D, E); } }
    SEAM(pb + 0);
    if (PHOK(2) && IN(pb + 1)) {
        const bool pass_first = (((int)blockIdx.x >> 3) & 1) != 0;
        if (pass_first) { sgmix_pass(F, l, (bf16_t*)(ws + WS_SGU)); conv_pass(F, l, (bf16_t*)(ws + WS_CB)); krope_pass(F); asm volatile("s_waitcnt vmcnt(0)" ::: "memory"); __syncthreads(); }
        { pg8::Epi8L<FnQ8, 2> E{{(bf16_t*)(ws + WS_Q), (const float*)(ws + WS_ST0), (const float*)(ws + WS_ROPE)}};
          REP(1) gemm_dense<T0W / 2, WQ8_LD / 2, 768, WQ8_LD / 2, true>(F, (const bf16_t*)(ws + WS_T0 + 256), (const bf16_t*)(wt + WT_WQ), E); }
        { pg8::Epi8A<FnKV8> E{{(bf16_t*)(ws + WS_KN), (bf16_t*)(ws + WS_V), (const float*)(ws + WS_ST0)}};
          REP(1) gemm_dense<T0W / 2, KVR / 2, 1024, KVR / 2, true>(F, (const bf16_t*)(ws + WS_T0), (const bf16_t*)(wt + WT_WKV), E); }
        if ((REPEAT_MASK >> 12) & 1) sgmix_pass(F, l, (bf16_t*)(ws + WS_GB)); if ((REPEAT_MASK >> 13) & 1) conv_pass(F, l, (bf16_t*)(ws + WS_GB));
        if (!pass_first) { sgmix_pass(F, l, (bf16_t*)(ws + WS_SGU)); conv_pass(F, l, (bf16_t*)(ws + WS_CB)); REP(11) krope_pass(F); }
    }
    SEAM(pb + 1);
    if (PHOK(3) && IN(pb + 2)) {
        const bool attn_first = (((int)blockIdx.x >> 3) & 1) != 0;
        const int vcu = (F.G % 8 == 0) ? ((int)blockIdx.x % 8) * (F.G / 8) + (int)blockIdx.x / 8 : (int)blockIdx.x;
        if (attn_first) { REP(3) att::phase((char*)F.lds_generic, fresh_tid(F.wave), vcu, F.G, (const bf16_t*)(ws + WS_Q), (const bf16_t*)(ws + WS_KN), (const bf16_t*)(ws + WS_KR), (const bf16_t*)(ws + WS_V), (bf16_t*)(ws + WS_O));
            asm volatile("s_waitcnt vmcnt(0)" ::: "memory"); __syncthreads(); }
        { pg8::Epi8<FnGates8> E{{ws}};
          REP(2) gemm_dense<D / 2, D / 2, N_GATES, D / 2, true>(F, (const bf16_t*)(ws + WS_H8), (const bf16_t*)(wt + WT_WG8), E); }
        if (!attn_first) { REP(3) att::phase((char*)F.lds_generic, fresh_tid(F.wave), vcu, F.G, (const bf16_t*)(ws + WS_Q), (const bf16_t*)(ws + WS_KN), (const bf16_t*)(ws + WS_KR), (const bf16_t*)(ws + WS_V), (bf16_t*)(ws + WS_O)); }
    }
    SEAM(pb + 2);
    if (PHOK(4) && IN(pb + 3)) {
        REP(4) {
        pg8::Gemm g{(const bf16_t*)ws, (const bf16_t*)ws};
        constexpr size_t TS = (size_t)256 * 512 * 2;
        static_assert(WS_SGU % TS == 0 && WS_CB % TS == 0 && WS_O % TS == 0 && (WS_WT + WT_WA) % TS == 0 && (WS_WT + WT_WB) % TS == 0 && (WS_WT + WT_WC) % TS == 0, "branch buffers must sit on 256 KiB boundaries");
        pg8::ChainOrder So; So.so.init(T, D, F.G, (int)blockIdx.x);
        EpiChain E{(bf16_t*)(ws + WS_MRG), ws};
        pg8::gemm_phase<EpiChain, pg8::ChainOrder, 512, 512, 512>(F.lds, F.wave, g, So, E);
        }
    }
    SEAM(pb + 3);
    if (PHOK(5) && IN(pb + 4)) {
        EpiResH E{H, (const float*)(ws + WS_RS), F.in[2] + l * D, xnew, ws + WS_XB};
        REP(5) gemm_dense<D, D, D, D>(F, (const bf16_t*)(ws + WS_MRG), (const bf16_t*)(wt + WT_WO), E); }
    SEAM(pb + 4);
    if (PHOK(6) && IN(pb + 5)) { REP(8) convert_moe_weights(F, l); if ((REPEAT_MASK >> 10) & 1) route_pass(F, l, xnew, true); route_pass(F, l, xnew, false); }
    SEAM(pb + 5);
    if (PHOK(7) && IN(pb + 6)) { moe_tables(F, l);
        const LAS int* base = (const LAS int*)(F.lds + TAB_OFF);
        pg8::Gemm g{(const bf16_t*)(ws + WS_XB), (const bf16_t*)(ws + WS_WGU)};
        pg8::MoeGatherOrder So{(const LAS unsigned char*)(F.lds + TAB_OFF + 320), (const LAS unsigned short*)(F.lds + TAB_OFF + 896), (const LAS int*)(F.lds + TAB_OFF + 192), (const unsigned*)(ws + WS_LIST), base[NE + 1], 2, F.G, (int)blockIdx.x};
        pg8::Epi8A<FnMoe1G> E{{(bf16_t*)(ws + WS_ACT), (const float*)(ws + WS_RL)}};
        REP(6) pg8::gemm_phase<pg8::Epi8A<FnMoe1G>, pg8::MoeGatherOrder, D / 2, D / 2, D / 2, true, true, true>(F.lds, F.wave, g, So, E); }
    SEAM(pb + 6);
    if (PHOK(8) && IN(pb + 7)) { moe_tables(F, l); FnMoe2_8 f{ws + WS_YB}; REP(7) gemm_moe<DE / 2, D, true>(F, (const bf16_t*)(ws + WS_ACT), (const bf16_t*)(ws + WS_WD), f);
        if (l + 1 < DEPTH) { convert_mixer_weights(F, l + 1); prep_small(F, l + 1); } }
    SEAM(pb + 7);
    if (PHOK(9) && IN(pb + 8)) { moe_tables(F, l);
        if (l + 1 < DEPTH) combine_pass(F, xnew, (float*)(ws + WS_RS), nullptr, F.in[2] + (l + 1) * D, H, ws + WS_H8, false); else combine_pass(F, xnew, nullptr, F.out, F.in[23], H, ws + WS_H8, true); }
    SEAM(pb + 8);
}
__global__ void __launch_bounds__(NTHREADS, 2) fwd(Args args) {
    extern __shared__ __attribute__((aligned(16))) unsigned char lds_raw[];
    Frame F;
    F.lds = (LAS unsigned char*)lds_raw; F.lds_generic = lds_raw; F.ws = args.ws;
    F.wave = __builtin_amdgcn_readfirstlane((int)threadIdx.x >> 6); F.G = gridDim.x;
    F.in = args.in;
    F.out = args.out;
    volatile LAS unsigned* MISC = (volatile LAS unsigned*)(F.lds + MISC_OFF);
    if (threadIdx.x < 32) MISC[threadIdx.x] = 0u;
    __syncthreads();
    XcdBarrier bar; bar.bar = ((unsigned*)F.ws) + CW_BAR; bar.x = 0; bar.st = nullptr;
    const int lo = args.ph_lo, hi = args.ph_hi;
    if (hi - lo > 1) bar = xcd_barrier_post(((unsigned*)F.ws) + CW_BAR, MISC + 8);
    if (PHOK(0) && IN(0)) REP(9) { convert_mixer_weights(F, 0); prep_small(F, 0); rope_table(F); norm_rows_bf16(F, F.in[0], F.in[2], (bf16_t*)(F.ws + WS_H), F.ws + WS_H8, (float*)(F.ws + WS_RS)); }
    SEAM(0);
    layer_body<0>(F, bar, lo, hi);
    layer_body<1>(F, bar, lo, hi);
}
#undef IN
#undef SEAM

extern "C" void kernel_launch(void* const* d_in, const int* in_sizes, int n_in, void* d_out, int out_size, void* d_ws, size_t ws_size, hipStream_t stream) {
    static int grid = 0;
    if (grid == 0) {
        if (n_in != 24 || out_size != T * D || ws_size < WS_END) { fprintf(stderr, "kernel_launch: unexpected shapes (n_in %d, out %d, ws %zu)\n", n_in, out_size, ws_size); grid = -1; return; }
        int dev = 0, cus = 0;
        if (hipGetDevice(&dev) != hipSuccess || hipDeviceGetAttribute(&cus, hipDeviceAttributeMultiprocessorCount, dev) != hipSuccess) { grid = -1; return; }
        if (hipFuncSetAttribute((const void*)fwd, hipFuncAttributeMaxDynamicSharedMemorySize, LDS_BYTES) != hipSuccess) { fprintf(stderr, "kernel_launch: hipFuncSetAttribute failed\n"); grid = -1; return; }
        int per_cu = 0;
        if (hipOccupancyMaxActiveBlocksPerMultiprocessor(&per_cu, (const void*)fwd, NTHREADS, LDS_BYTES) != hipSuccess || per_cu < 1) fprintf(stderr, "kernel_launch: occupancy query says %d\n", per_cu);
        (void)hipGetLastError();
        grid = cus;
    }
    if (grid < 0) return;
    (void)hipMemsetAsync((char*)d_ws + WS_CTL, 0, CTL_ZERO_BYTES, stream);
    Args a{};
    for (int i = 0; i < 24; ++i) a.in[i] = (const float*)d_in[i];
    a.out = (float*)d_out; a.ws = (unsigned char*)d_ws;
#if MK_ONE_LAUNCH
    a.ph_lo = 0; a.ph_hi = N_PHASES;
    hipLaunchKernelGGL(fwd, dim3(grid), dim3(NTHREADS), LDS_BYTES, stream, a);
#else
    for (int p = 0; p < N_PHASES; ++p) { a.ph_lo = p; a.ph_hi = p + 1; hipLaunchKernelGGL(fwd, dim3(grid), dim3(NTHREADS), LDS_BYTES, stream, a); }
#endif
}
```

```cpp
#include <hip/hip_runtime.h>
#include <cstdio>
#include <cstdint>

#ifndef MK_ONE_LAUNCH
#define MK_ONE_LAUNCH 1
#endif
#ifndef FAST_ATTN
#define FAST_ATTN 1
#endif

#define GAS __attribute__((address_space(1)))
#define LAS __attribute__((address_space(3)))
typedef unsigned short bf16_t;
typedef short bf16x8 __attribute__((ext_vector_type(8)));
typedef float f32x4 __attribute__((ext_vector_type(4)));
typedef float f32x2 __attribute__((ext_vector_type(2)));
typedef unsigned u32x4 __attribute__((ext_vector_type(4)));
typedef unsigned u32x2 __attribute__((ext_vector_type(2)));

constexpr int D = 1024, NB = 16, S = 4096, T = NB * S, DEPTH = 2;
constexpr int NH = 8, NOPE = 64, ROPE = 32, QKH = 96, VH = 64, QR = 384, KVR = 256;
constexpr int SGW = 512, CW = 512, DIN = 6304, NE = 32, DE = 256;
constexpr float EPS = 1e-6f;
constexpr int C_CQ = 0, C_CKV = 384, C_KR = 640, C_SGU = 672, C_SGV = 1184, C_CB = 1696, C_CC = 2208, C_CH = 2720, C_GA = 3232, C_GB = 4256, C_GC = 5280;
constexpr int N_P1 = 3328, N_GATES = 3072, N_WIN = N_P1 + N_GATES;
constexpr int T0W = 768;
constexpr int N_F8A = 1280;
constexpr int WQ8_LD = 512;

constexpr size_t MiB = 1u << 20;
constexpr size_t WS_CTL = 0, CTL_ZERO_BYTES = 1 * MiB;
constexpr size_t WS_WSG = 1 * MiB;
constexpr size_t WS_WRT = 1 * MiB + 128 * 1024;
constexpr size_t WS_ROPE = 2 * MiB;
constexpr size_t WS_WT = 10 * MiB;
constexpr size_t WT_WIN = 0, WT_WQ = 13 * MiB, WT_WKV = 14 * MiB, WT_WA = 15 * MiB, WT_WB = 16 * MiB, WT_WC = 17 * MiB, WT_WO = 18 * MiB;
constexpr size_t WS_REC = 30 * MiB;
constexpr size_t WS_H = 32 * MiB;
constexpr size_t WS_T0 = 160 * MiB;
constexpr size_t WS_GV = 256 * MiB;
constexpr size_t WS_Z = 320 * MiB;
constexpr size_t WS_SGU = 384 * MiB;
constexpr size_t WS_CB = 448 * MiB;
constexpr size_t WS_KN = 512 * MiB;
constexpr size_t WS_V = 576 * MiB;
constexpr size_t WS_GB = 640 * MiB;
constexpr size_t WS_GC = 768 * MiB;
constexpr size_t WS_Q = 896 * MiB;
constexpr size_t WS_KR = 992 * MiB;
constexpr size_t WS_ST0 = 996 * MiB;
constexpr size_t WS_STV = 1000 * MiB;
constexpr size_t WS_RS = 1002 * MiB;
constexpr size_t WS_END = 1003 * MiB;
constexpr size_t WS_GA = WS_T0, WS_O = WS_Z, WS_MRG = WS_KN;
constexpr size_t WS_H8 = 704 * MiB;
constexpr size_t WT_WT8 = 10 * MiB + 512 * 1024;
constexpr size_t WT_WG8 = 7 * MiB;
constexpr float W8_SCALE = 32.f;
constexpr size_t WS_WGU = 32 * MiB, WS_WD = 64 * MiB, WS_ACT = 80 * MiB;
constexpr size_t WS_XB = 160 * MiB, WS_YB = 432 * MiB;
constexpr size_t WS_X1 = 832 * MiB;
constexpr size_t WS_LIST = 288 * MiB, WS_RL = 296 * MiB;
constexpr int MAX_TILES = 544;
constexpr int CW_TMO = 0, CW_BAR = 4096, CW_CNT = 8192;

#define LDS_WAIT() asm volatile("s_waitcnt lgkmcnt(0)" ::: "memory")
#define VM_WAIT() asm volatile("s_waitcnt vmcnt(0)" ::: "memory")
__device__ __forceinline__ float bf2f(unsigned v) { return __uint_as_float(v << 16); }
__device__ __forceinline__ unsigned f2bf(float f) { unsigned u = __float_as_uint(f); return (u + 0x7fffu + ((u >> 16) & 1u)) >> 16; }
__device__ __forceinline__ unsigned pk2(float lo, float hi) { return f2bf(lo) | (f2bf(hi) << 16); }
__device__ __forceinline__ float lo16(unsigned w) { return __uint_as_float(w << 16); }
__device__ __forceinline__ float hi16(unsigned w) { return __uint_as_float(w & 0xffff0000u); }
__device__ __forceinline__ float wave_sum(float v) {
#pragma unroll
    for (int o = 1; o < 64; o <<= 1) v += __shfl_xor(v, o);
    return v;
}
__device__ __forceinline__ float sigmoidf_(float x) { return 1.f / (1.f + __expf(-x)); }
__device__ __forceinline__ float gelu_tanh(float x) { const float u = 0.7978845608028654f * (x + 0.044715f * x * x * x); return x / (1.f + __expf(-2.f * u)); }
__device__ __forceinline__ float siluf_(float x) { return x / (1.f + __expf(-x)); }
typedef __bf16 bf16x2_t __attribute__((ext_vector_type(2)));
__device__ __forceinline__ unsigned cvt_pk(float lo, float hi) { const f32x2 v = {lo, hi}; const bf16x2_t b = __builtin_convertvector(v, bf16x2_t); return __builtin_bit_cast(unsigned, b); }
__device__ __forceinline__ unsigned pk4f8(float a, float b, float c, float d) { int w = 0; w = __builtin_amdgcn_cvt_pk_fp8_f32(a, b, w, false); w = __builtin_amdgcn_cvt_pk_fp8_f32(c, d, w, true); return (unsigned)w; }
__device__ __forceinline__ u32x4 pack8(const f32x4 a, const f32x4 b) { u32x4 w; w.x = cvt_pk(a[0], a[1]); w.y = cvt_pk(a[2], a[3]); w.z = cvt_pk(b[0], b[1]); w.w = cvt_pk(b[2], b[3]); return w; }
__device__ __forceinline__ float fsigmoid(float x) { return __builtin_amdgcn_rcpf(1.f + __builtin_amdgcn_exp2f(-1.4426950408889634f * x)); }
__device__ __forceinline__ float fgelu(float x) { const float t = x * x; return x * __builtin_amdgcn_rcpf(1.f + __builtin_amdgcn_exp2f(x * (-2.302208198f + -0.102943240f * t))); }
__device__ __forceinline__ f32x4 fgelu4(const f32x4 v) { return (f32x4){fgelu(v[0]), fgelu(v[1]), fgelu(v[2]), fgelu(v[3])}; }
__device__ __forceinline__ float dot8(const f32x4 a, const f32x4 b) { return ((a[0] * a[0] + a[1] * a[1]) + (a[2] * a[2] + a[3] * a[3])) + ((b[0] * b[0] + b[1] * b[1]) + (b[2] * b[2] + b[3] * b[3])); }

#define XB_TMO      128
#define XB_XCNT(j)  (256  + 64 * (j))
#define XB_XSUB(j)  (1280 + 64 * (j))
#define XB_XGEN(j)  (2304 + 64 * (j))
#define XB_TOP      3328
#define XB_TOPGEN   3392
#define XCD_BAR_WORDS 3456
#define XB_SPIN_CAP (1u << 18)
__device__ __forceinline__ unsigned xb_ld(unsigned* p)              { return __hip_atomic_load(p, __ATOMIC_RELAXED, __HIP_MEMORY_SCOPE_AGENT); }
__device__ __forceinline__ unsigned xb_add(unsigned* p, unsigned v) { return __hip_atomic_fetch_add(p, v, __ATOMIC_RELAXED, __HIP_MEMORY_SCOPE_AGENT); }
__device__ __forceinline__ unsigned xb_xcc_id() { return (unsigned)__builtin_amdgcn_s_getreg((3 << 11) | 20) & 0xFu; }
#define XB_SPIN(cond, bar) do { unsigned _sp = 0; while (cond) { __builtin_amdgcn_s_sleep(1); \
    if ((++_sp & 255u) == 0u) { if (xb_ld(&(bar)[XB_TMO])) break; if (_sp > XB_SPIN_CAP) { atomicAdd(&(bar)[XB_TMO], 1u); break; } } } } while (0)
struct XcdBarrier { unsigned* bar; unsigned x; volatile LAS unsigned* st; };
__device__ __forceinline__ XcdBarrier xcd_barrier_post(unsigned* bar, volatile LAS unsigned* st) {
    XcdBarrier b; b.bar = bar; b.x = xb_xcc_id(); b.st = st;
    if (threadIdx.x == 0) (void)xb_add(&bar[XB_XCNT(b.x)], 1u);
    return b;
}
__device__ __forceinline__ void xcd_barrier_complete(unsigned* bar, unsigned x, unsigned& nloc, unsigned& nx) {
    const unsigned G = gridDim.x * gridDim.y * gridDim.z;
    unsigned sum, cnt, mine, sp = 0u;
    for (;;) {
        sum = 0u; cnt = 0u; mine = 0u;
#pragma unroll
        for (unsigned j = 0; j < 16; ++j) { const unsigned c = xb_ld(&bar[XB_XCNT(j)]); sum += c; cnt += (c > 0u) ? 1u : 0u; mine = (j == x) ? c : mine; }
        if (sum == G) break;
        __builtin_amdgcn_s_sleep(1);
        if ((++sp & 255u) == 0u) { if (xb_ld(&bar[XB_TMO])) break; if (sp > XB_SPIN_CAP) { atomicAdd(&bar[XB_TMO], 1u); break; } }
    }
    nloc = mine > 0u ? mine : 1u; nx = cnt > 0u ? cnt : 1u;
}
__device__ __forceinline__ void xcd_barrier(const XcdBarrier& b, const bool is_t0) {
    asm volatile("s_waitcnt vmcnt(0)" ::: "memory");
    __syncthreads();
    if (is_t0) {
        unsigned* bar = b.bar;
        __builtin_amdgcn_s_waitcnt(0);
        unsigned nloc = b.st[0], nx = b.st[1];
        if (nloc == 0u) { xcd_barrier_complete(bar, b.x, nloc, nx); b.st[0] = nloc; b.st[1] = nx; }
        const unsigned old = xb_add(&bar[XB_XSUB(b.x)], 1u);
        const unsigned gen = old / nloc;
        if (old + 1u == (gen + 1u) * nloc) {
            __builtin_amdgcn_fence(__ATOMIC_RELEASE, "agent");
            asm volatile("s_waitcnt vmcnt(0)" ::: "memory");
            const unsigned og = xb_add(&bar[XB_TOP], 1u);
            const unsigned tg = og / nx;
            if (og + 1u == (tg + 1u) * nx) xb_add(&bar[XB_TOPGEN], 1u);
            else XB_SPIN(xb_ld(&bar[XB_TOPGEN]) == tg, bar);
            __builtin_amdgcn_fence(__ATOMIC_ACQUIRE, "agent");
            xb_add(&bar[XB_XGEN(b.x)], 1u);
            asm volatile("s_waitcnt vmcnt(0)" ::: "memory");
        } else {
            XB_SPIN(xb_ld(&bar[XB_XGEN(b.x)]) == gen, bar);
            __builtin_amdgcn_fence(__ATOMIC_ACQUIRE, "agent");
            asm volatile("s_waitcnt vmcnt(0)" ::: "memory");
        }
    }
    __syncthreads();
}

constexpr int RING_BYTES = 131072;
constexpr int TAB_OFF = RING_BYTES;
constexpr int TAB_BYTES = 2048;
constexpr int MISC_OFF = TAB_OFF + TAB_BYTES;
constexpr int LDS_BYTES = 147456;
constexpr int NWAVES = 8, NTHREADS = 512;

__device__ __forceinline__ int fresh_tid(int wave) { int lane; asm volatile("v_mbcnt_lo_u32_b32 %0, -1, 0\n\tv_mbcnt_hi_u32_b32 %0, -1, %0" : "=v"(lane)); return wave * 64 + lane; }
struct Frame {
    LAS unsigned char* lds;
    unsigned char* lds_generic;
    unsigned char* ws;
    int wave, G;
    const float* const* in;
    float* out;
};

struct MapIdent { __device__ __forceinline__ int operator()(int n) const { return n; } };
struct MapWin {
    __device__ __forceinline__ int operator()(int n) const {
        if (n < 256) return C_CKV + n;
        if (n < 640) return C_CQ + (n - 256);
        if (n < 672) return C_KR + (n - 640);
        if (n < 768) return -1;
        if (n < 1280) return C_SGV + (n - 768);
        if (n < 1792) return C_SGU + (n - 1280);
        if (n < 2304) return C_CB + (n - 1792);
        if (n < 3328) { const int j = (n - 2304) >> 1; return (n & 1) ? C_CH + j : C_CC + j; }
        if (n < 4352) return C_GA + (n - 3328);
        if (n < 5376) return C_GB + (n - 4352);
        return C_GC + (n - 5376);
    }
};
struct MapGates { __device__ __forceinline__ int operator()(int n) const { return C_GA + n; } };
struct MapWq {
    __device__ __forceinline__ int operator()(int n) const { const int h = n / 96, d = n - h * 96; if (d < 64) return n; const int j = d - 64, i = j >> 1; return h * 96 + 64 + ((j & 1) ? 16 + i : i); }
};
struct MapWkv {
    __device__ __forceinline__ int operator()(int n) const { const int part = n >> 9, r = n & 511, h = r >> 6, j = r & 63; return h * 128 + part * 64 + j; }
};
struct MapWgu {
    __device__ __forceinline__ int operator()(int n) const { const int j = n >> 1; return (n & 1) ? 256 + j : j; }
};
template <class Map, bool FP8 = false>
__device__ __forceinline__ void transpose_mat(const float* W, int K, int Nsrc, bf16_t* WT, int ndest, const Map map, const float* kscale,
                                              LAS float* scr, int gw, int ngw, int lane, int nmat, size_t src_stride, size_t dst_stride, int ldk = 0  ) {
    const int nblk = ndest / 32, kblk = K / 64, per = nblk * kblk;
    for (int it = gw; it < per * nmat; it += ngw) {
        const int mat = it / per, r = it - mat * per, kb = r / nblk, nb = r - kb * nblk, k0 = kb * 64, n0 = nb * 32;
        const float* Wm = W + (size_t)mat * src_stride; bf16_t* WTm = WT + (size_t)mat * dst_stride;
        const int sc = map(n0 + (lane & 31)); const float msk = sc >= 0 ? 1.f : 0.f;
        const float* src = Wm + (size_t)(k0 + (lane >> 5)) * Nsrc + (sc >= 0 ? sc : 0);
        float v[32];
#pragma unroll
        for (int i = 0; i < 32; ++i) v[i] = src[(size_t)(2 * i) * Nsrc];
        const int c = lane & 7;
        f32x4 ka = {1.f, 1.f, 1.f, 1.f}, kb4 = ka;
        if (kscale) { ka = *(const f32x4*)(kscale + k0 + 8 * c); kb4 = *(const f32x4*)(kscale + k0 + 8 * c + 4); }
        if constexpr (FP8) { ka *= W8_SCALE; kb4 *= W8_SCALE; }
#pragma unroll
        for (int i = 0; i < 32; ++i) scr[(2 * i + (lane >> 5)) * 33 + (lane & 31)] = v[i] * msk;
        LDS_WAIT(); asm volatile("" ::: "memory");
#pragma unroll
        for (int j = 0; j < 4; ++j) { const int n = (lane >> 3) + 8 * j; const LAS float* s = scr + (8 * c) * 33 + n;
            if constexpr (FP8) { u32x2 o; o.x = pk4f8(s[0 * 33] * ka[0], s[1 * 33] * ka[1], s[2 * 33] * ka[2], s[3 * 33] * ka[3]); o.y = pk4f8(s[4 * 33] * kb4[0], s[5 * 33] * kb4[1], s[6 * 33] * kb4[2], s[7 * 33] * kb4[3]);
                *(u32x2*)((unsigned char*)WT + (size_t)mat * dst_stride + (size_t)(n0 + n) * (ldk ? ldk : K) + k0 + 8 * c) = o; }
            else { u32x4 o; o.x = pk2(s[0 * 33] * ka[0], s[1 * 33] * ka[1]); o.y = pk2(s[2 * 33] * ka[2], s[3 * 33] * ka[3]); o.z = pk2(s[4 * 33] * kb4[0], s[5 * 33] * kb4[1]); o.w = pk2(s[6 * 33] * kb4[2], s[7 * 33] * kb4[3]);
            *(u32x4*)(WTm + (size_t)(n0 + n) * K + k0 + 8 * c) = o; } }
        LDS_WAIT(); asm volatile("" ::: "memory");
    }
}
__device__ __forceinline__ void convert_mixer_weights(Frame& F, int l) {
    const int tid_ = fresh_tid(F.wave), lane_ = tid_ & 63; (void)lane_;
    LAS float* scr = (LAS float*)(F.lds + F.wave * 16384);
    unsigned char* wt = F.ws + WS_WT;
    transpose_mat(F.in[3] + (size_t)l * D * DIN, D, DIN, (bf16_t*)(wt + WT_WIN), N_P1, MapWin(), nullptr, scr, ((int)blockIdx.x * NWAVES + F.wave), (F.G * NWAVES), lane_, 1, 0, 0);
    transpose_mat<MapGates, true>(F.in[3] + (size_t)l * D * DIN, D, DIN, (bf16_t*)(wt + WT_WG8), N_GATES, MapGates(), nullptr, scr, ((int)blockIdx.x * NWAVES + F.wave), (F.G * NWAVES), lane_, 1, 0, 0);
    transpose_mat<MapWin, true>(F.in[3] + (size_t)l * D * DIN, D, DIN, (bf16_t*)(wt + WT_WT8), N_F8A, MapWin(), nullptr, scr, ((int)blockIdx.x * NWAVES + F.wave), (F.G * NWAVES), lane_, 1, 0, 0);
    transpose_mat<MapWq, true>(F.in[5] + (size_t)l * QR * 768, QR, 768, (bf16_t*)(wt + WT_WQ), 768, MapWq(), F.in[4] + l * QR, scr, ((int)blockIdx.x * NWAVES + F.wave), (F.G * NWAVES), lane_, 1, 0, 0, WQ8_LD);
    for (int idx = (int)blockIdx.x * NTHREADS + tid_; idx < 768 * 32; idx += F.G * NTHREADS) *(unsigned*)(wt + WT_WQ + (size_t)(idx >> 5) * WQ8_LD + QR + (idx & 31) * 4) = 0u;
    transpose_mat<MapWkv, true>(F.in[7] + (size_t)l * KVR * 1024, KVR, 1024, (bf16_t*)(wt + WT_WKV), 1024, MapWkv(), F.in[6] + l * KVR, scr, ((int)blockIdx.x * NWAVES + F.wave), (F.G * NWAVES), lane_, 1, 0, 0);
    transpose_mat(F.in[12] + (size_t)l * 512 * D, 512, D, (bf16_t*)(wt + WT_WA), D, MapIdent(), nullptr, scr, ((int)blockIdx.x * NWAVES + F.wave), (F.G * NWAVES), lane_, 1, 0, 0);
    transpose_mat(F.in[13] + (size_t)l * 512 * D, 512, D, (bf16_t*)(wt + WT_WB), D, MapIdent(), nullptr, scr, ((int)blockIdx.x * NWAVES + F.wave), (F.G * NWAVES), lane_, 1, 0, 0);
    transpose_mat(F.in[14] + (size_t)l * 512 * D, 512, D, (bf16_t*)(wt + WT_WC), D, MapIdent(), nullptr, scr, ((int)blockIdx.x * NWAVES + F.wave), (F.G * NWAVES), lane_, 1, 0, 0);
    transpose_mat(F.in[15] + (size_t)l * D * D, D, D, (bf16_t*)(wt + WT_WO), D, MapIdent(), nullptr, scr, ((int)blockIdx.x * NWAVES + F.wave), (F.G * NWAVES), lane_, 1, 0, 0);
}
__device__ __forceinline__ void convert_moe_weights(Frame& F, int l) {
    const int tid_ = fresh_tid(F.wave), lane_ = tid_ & 63; (void)lane_;
    LAS float* scr = (LAS float*)(F.lds + F.wave * 16384);
    transpose_mat<MapWgu, true>(F.in[21] + (size_t)l * NE * D * 512, D, 512, (bf16_t*)(F.ws + WS_WGU), 512, MapWgu(), F.in[16] + l * D  , scr, ((int)blockIdx.x * NWAVES + F.wave), (F.G * NWAVES), lane_, NE, (size_t)D * 512, (size_t)512 * D  );
    transpose_mat<MapIdent, true>(F.in[22] + (size_t)l * NE * DE * D, DE, D, (bf16_t*)(F.ws + WS_WD), D, MapIdent(), nullptr, scr, ((int)blockIdx.x * NWAVES + F.wave), (F.G * NWAVES), lane_, NE, (size_t)DE * D, (size_t)D * DE  );
}

__device__ __forceinline__ void norm_rows_bf16(Frame& F, const float* X, const float* gain, bf16_t* H, unsigned char* H8, float* RS) {
    const int tid_ = fresh_tid(F.wave), lane_ = tid_ & 63; (void)lane_;
    constexpr int RB = 4;
    f32x4 g[4];
#pragma unroll
    for (int j = 0; j < 4; ++j) g[j] = ((const f32x4*)gain)[lane_ + 64 * j];
    for (int m0 = ((int)blockIdx.x * NWAVES + F.wave); m0 < T; m0 += RB * (F.G * NWAVES)) {
        f32x4 v[RB][4];
#pragma unroll
        for (int r = 0; r < RB; ++r) { const int m = m0 + r * (F.G * NWAVES); if (m < T) { const f32x4* xr = (const f32x4*)(X + (size_t)m * D) + lane_;
#pragma unroll
            for (int j = 0; j < 4; ++j) v[r][j] = xr[64 * j]; } }
#pragma unroll
        for (int r = 0; r < RB; ++r) { const int m = m0 + r * (F.G * NWAVES); if (m < T) { float s = 0.f;
#pragma unroll
            for (int j = 0; j < 4; ++j) s += (v[r][j].x * v[r][j].x + v[r][j].y * v[r][j].y) + (v[r][j].z * v[r][j].z + v[r][j].w * v[r][j].w);
            const float ms = wave_sum(s) * (1.f / D) + EPS, rstd = rsqrtf(ms);
            if (lane_ == 0) RS[m] = ms * rstd;
            u32x2* o = (u32x2*)(H + (size_t)m * D) + lane_;
#pragma unroll
            for (int j = 0; j < 4; ++j) { u32x2 w; w.x = cvt_pk(v[r][j].x * rstd * g[j].x, v[r][j].y * rstd * g[j].y); w.y = cvt_pk(v[r][j].z * rstd * g[j].z, v[r][j].w * rstd * g[j].w); o[64 * j] = w; }
            unsigned* o8 = (unsigned*)(H8 + (size_t)m * D) + lane_;
#pragma unroll
            for (int j = 0; j < 4; ++j) o8[64 * j] = pk4f8(v[r][j].x * rstd * g[j].x, v[r][j].y * rstd * g[j].y, v[r][j].z * rstd * g[j].z, v[r][j].w * rstd * g[j].w); } }
    }
}
__device__ __forceinline__ void rope_table(Frame& F) {
    const int tid_ = fresh_tid(F.wave), lane_ = tid_ & 63; (void)lane_;
    const int* pos = (const int*)F.in[1]; float* R = (float*)(F.ws + WS_ROPE);
    const int gt = blockIdx.x * NTHREADS + tid_, nt = F.G * NTHREADS;
    const int i = gt & 15; const double c = exp2(-0.83048202372184059 * (double)i) * 0.15915494309189535;
    for (int idx = gt; idx < T * 16; idx += nt) { const int t = idx >> 4;
        double rd = (double)pos[t] * c; rd -= floor(rd); const float r = (float)rd;
        R[t * 32 + i] = __builtin_amdgcn_cosf(r); R[t * 32 + 16 + i] = __builtin_amdgcn_sinf(r); }
}
namespace pg8 {
constexpr int BM = 256, BK = 64, HALF = 128, HTB = HALF * BK * 2, STAGE_BYTES = 8 * HTB, NXCD = 8, WGM = 8;
__host__ __device__ __forceinline__ int lds_byte(int r, int c) { const int st = (r >> 4) * 2 + (c >> 5), rr = r & 15, cc = c & 31, ob = rr * 64 + cc * 2; return st * 1024 + (ob ^ (((ob >> 9) & 1) << 5)); }
__host__ __device__ __forceinline__ void stage_rc(int b, int& R, int& C) { const int st = b / 1024, sb = b % 1024, swz = sb ^ (((sb >> 9) & 1) << 5); R = (st >> 1) * 16 + swz / 64; C = (st & 1) * 32 + (swz % 64) / 2; }
__host__ __device__ __forceinline__ int perm32(int rho) { const int n = rho >> 4, i = rho & 15; return 8 * (i >> 2) + 4 * n + (i & 3); }
struct Unit { int pm, pn, aux, rm, rn; };
struct Gemm { const bf16_t* A; const bf16_t* Bt; };
struct StaticOrder {
    int nM, nN, nwg, G, c;
    __host__ __device__ void init(int M, int N, int G_, int c_) { nM = M / BM; nN = N / BM; nwg = nM * nN; G = G_; c = c_; }
    __host__ __device__ bool next(int i, Unit& u) const {
        const long L = (long)i * G + c; if (L >= nwg) return false;
        int wgid = (int)L; { const int q = nwg / NXCD, r = nwg % NXCD, xcd = wgid % NXCD, off = wgid / NXCD; wgid = (xcd < r ? xcd * (q + 1) : r * (q + 1) + (xcd - r) * q) + off; }
        const int nig = WGM * nN, gid = wgid / nig, fm = gid * WGM, gsz = (nM - fm) < WGM ? (nM - fm) : WGM;
        u.pm = fm + ((wgid % nig) % gsz); u.pn = (wgid % nig) / gsz; return true;
    }
};
struct MoeOrder {
    const LAS unsigned char* tile_e; int ntiles, ntn, G, c;
    __device__ bool next(int i, Unit& u) const {
        const int L = i * G + c; if (L >= ntiles * ntn) return false;
        const int tile = L / ntn, pn = L - tile * ntn; u.pm = tile; u.pn = __builtin_amdgcn_readfirstlane((int)tile_e[tile]) * ntn + pn; return true;
    }
};
struct MoeGatherOrder {
    const LAS unsigned char* tile_e; const LAS unsigned short* tile_r; const LAS int* cnt; const unsigned* list; int ntiles, ntn, G, c;
    __device__ bool next(int i, Unit& u) const {
        const int L = i * G + c; if (L >= ntiles * ntn) return false;
        const int tile = L / ntn, pn = L - tile * ntn, e = __builtin_amdgcn_readfirstlane((int)tile_e[tile]), rt = __builtin_amdgcn_readfirstlane((int)tile_r[tile]);
        u.pm = tile; u.pn = e * ntn + pn; u.aux = e; u.rm = rt; u.rn = __builtin_amdgcn_readfirstlane(cnt[e]); return true;
    }
    __device__ __forceinline__ unsigned rowoff(const Unit& u, int r) const { const int idx = u.rm * 256 + r; const unsigned tok = idx < u.rn ? list[(size_t)u.aux * T + idx] : 0u; return tok * (unsigned)D; }
};
struct ChainOrder {
    StaticOrder so;
    __device__ bool next(int i, Unit& u) const {
        const int it = i / 3, br = i - it * 3; Unit t;
        if (!so.next(it, t)) return false;
        u.rm = t.pm; u.rn = t.pn; u.aux = br;
        constexpr size_t TS = (size_t)256 * 512 * 2;
        constexpr int A0 = (int)(WS_SGU / TS), A1 = (int)(WS_CB / TS), A2 = (int)(WS_O / TS), B0 = (int)((WS_WT + WT_WB) / TS), B1 = (int)((WS_WT + WT_WC) / TS), B2 = (int)((WS_WT + WT_WA) / TS);
        int ao = A0 + br * (A1 - A0), bo = B0 + br * (B1 - B0); if (br == 2) { ao = A2; bo = B2; }
        u.pm = t.pm + ao; u.pn = t.pn + bo; return true;
    }
};
template <class Fn> struct Epi8 {
    static constexpr bool PERM = true, CHAIN = false;
    Fn f;
    __device__ __forceinline__ void operator()(const f32x4 (&acc)[2][2][4][2], const Unit& u, int wr, int wc, int fr, int fq) const {
#pragma unroll
        for (int ai = 0; ai < 2; ++ai)
#pragma unroll
            for (int m = 0; m < 4; ++m) { const int row = u.pm * BM + ai * HALF + wr * 64 + m * 16 + fr;
#pragma unroll
                for (int bj = 0; bj < 2; ++bj) f(u, row, u.pn * BM + bj * HALF + wc * 32 + 8 * fq, acc[ai][bj][m][0], acc[ai][bj][m][1]);
                asm volatile("" ::: "memory"); }
    }
};
template <class Fn, int MB> struct Epi8L {
    static constexpr bool PERM = true, CHAIN = false;
    Fn f;
    __device__ __forceinline__ void operator()(const f32x4 (&acc)[2][2][4][2], const Unit& u, int wr, int wc, int fr, int fq) const {
#pragma unroll
        for (int ai = 0; ai < 2; ++ai)
#pragma unroll
            for (int mb = 0; mb < 4; mb += MB) {
                typename Fn::Pre pre[MB][2];
#pragma unroll
                for (int m = 0; m < MB; ++m)
#pragma unroll
                    for (int bj = 0; bj < 2; ++bj) pre[m][bj] = f.pre(u, u.pm * BM + ai * HALF + wr * 64 + (mb + m) * 16 + fr, u.pn * BM + bj * HALF + wc * 32 + 8 * fq);
                asm volatile("" ::: "memory");
#pragma unroll
                for (int m = 0; m < MB; ++m)
#pragma unroll
                    for (int bj = 0; bj < 2; ++bj) f.post(u, u.pm * BM + ai * HALF + wr * 64 + (mb + m) * 16 + fr, u.pn * BM + bj * HALF + wc * 32 + 8 * fq, acc[ai][bj][mb + m][0], acc[ai][bj][mb + m][1], pre[m][bj]);
                asm volatile("" ::: "memory"); }
    }
};
template <class Fn> struct Epi8A {
    static constexpr bool PERM = true, CHAIN = false;
    Fn f;
    __device__ __forceinline__ void operator()(const f32x4 (&acc)[2][2][4][2], const Unit& u, int wr, int wc, int fr, int fq) const {
        typename Fn::Pre pre[2][4][2];
#pragma unroll
        for (int ai = 0; ai < 2; ++ai)
#pragma unroll
            for (int m = 0; m < 4; ++m)
#pragma unroll
                for (int bj = 0; bj < 2; ++bj) pre[ai][m][bj] = f.pre(u, u.pm * BM + ai * HALF + wr * 64 + m * 16 + fr, u.pn * BM + bj * HALF + wc * 32 + 8 * fq);
        asm volatile("" ::: "memory");
#pragma unroll
        for (int ai = 0; ai < 2; ++ai)
#pragma unroll
            for (int m = 0; m < 4; ++m) {
#pragma unroll
                for (int bj = 0; bj < 2; ++bj) f.post(u, u.pm * BM + ai * HALF + wr * 64 + m * 16 + fr, u.pn * BM + bj * HALF + wc * 32 + 8 * fq, acc[ai][bj][m][0], acc[ai][bj][m][1], pre[ai][m][bj]);
                asm volatile("" ::: "memory"); }
    }
};
typedef int i32x4_t __attribute__((ext_vector_type(4)));
typedef int i32x8_t __attribute__((ext_vector_type(8)));
__device__ __forceinline__ i32x8_t cat8(const bf16x8 a, const bf16x8 b) { const i32x4_t x = __builtin_bit_cast(i32x4_t, a), y = __builtin_bit_cast(i32x4_t, b); return __builtin_shufflevector(x, y, 0, 1, 2, 3, 4, 5, 6, 7); }
template <class Epi, class Sched, int LDA, int LDB, int KK, bool ALIGN_EPI = true, bool GATHER = false, bool FP8 = false>
__device__ __forceinline__ void gemm_phase(LAS unsigned char* lds, const int wave, const Gemm g, const Sched& S, const Epi& E) {
    const int tid = fresh_tid(wave), wid = __builtin_amdgcn_readfirstlane(tid >> 6), lane = tid & 63, wr = wid >> 2, wc = wid & 3, fr = lane & 15, fq = lane >> 4;
    constexpr int nt = KK / BK; static_assert(KK % 128 == 0, "K must be a multiple of 128");
    unsigned voffA, voffB;
    { int R, C; stage_rc(tid * 16, R, C); const int Rb = Epi::PERM ? ((R & ~31) + perm32(R & 31)) : R;
      voffA = (unsigned)(R * LDA + C) * 2u; voffB = (unsigned)(Rb * LDB + C) * 2u; }
    constexpr size_t pieceA = (size_t)64 * LDA * 2, pieceB = (size_t)64 * LDB * 2;
    unsigned gc00 = 0, gc01 = 0, gc10 = 0, gc11 = 0, gn00 = 0, gn01 = 0, gn10 = 0, gn11 = 0;
    constexpr size_t kstep = (size_t)(BK * 2);
    constexpr size_t hstepA = (size_t)HALF * LDA * 2, hstepB = (size_t)HALF * LDB * 2;
    constexpr size_t tstepA = 2 * hstepA, tstepB = 2 * hstepB;
    const unsigned ldsw = (unsigned)wid * 1024u;
    const int aoff = lds_byte(wr * 64 + fr, fq * 8), boff = lds_byte(wc * 32 + fr, fq * 8);
#define PG8_SA(b, h) (((b) * 2 + (h)) * HTB)
#define PG8_SB(b, h) ((4 + (b) * 2 + (h)) * HTB)
#define PG8_STAGE(bufoff, gbase, voff) do { \
        __builtin_amdgcn_global_load_lds((const unsigned*)((const char*)(gbase) + voff), (LAS unsigned*)(lds + (bufoff) + ldsw), 16, 0, 0); \
        __builtin_amdgcn_global_load_lds((const unsigned*)((const char*)(gbase) + PG8_PIECE_##voff + voff), (LAS unsigned*)(lds + (bufoff) + ldsw + 8192), 16, 0, 0); } while (0)
#define PG8_GLD(gptr, ldsoff) __builtin_amdgcn_global_load_lds((const unsigned*)(gptr), (LAS unsigned*)(lds + (ldsoff)), 16, 0, 0)
#define PG8_STAGE_A(bufoff, ptr, h, nx) do { if constexpr (GATHER) { \
        const unsigned o0_ = (nx) ? ((h) ? gn10 : gn00) : ((h) ? gc10 : gc00), o1_ = (nx) ? ((h) ? gn11 : gn01) : ((h) ? gc11 : gc01); \
        PG8_GLD((const char*)(ptr) + o0_, (bufoff) + ldsw); PG8_GLD((const char*)(ptr) + o1_, (bufoff) + ldsw + 8192); \
    } else { PG8_STAGE(bufoff, (const char*)(ptr) + (h) * hstepA, voffA); } } while (0)
#define PG8_ROWOFFS(u, o00, o01, o10, o11) do { int gR_, gC_; stage_rc(fresh_tid(wave) * 16, gR_, gC_);     \
        o00 = S.rowoff(u, gR_) + gC_ * 2; o01 = S.rowoff(u, gR_ + 64) + gC_ * 2; o10 = S.rowoff(u, 128 + gR_) + gC_ * 2; o11 = S.rowoff(u, 192 + gR_) + gC_ * 2; } while (0)
#define PG8_PIECE_voffA pieceA
#define PG8_PIECE_voffB pieceB
#define PG8_LDA(dst, b, h) do { _Pragma("unroll") for (int m = 0; m < 4; ++m) _Pragma("unroll") for (int k = 0; k < 2; ++k) dst[m][k] = *(const LAS bf16x8*)(lds + PG8_SA(b, h) + aoff + m * 2048 + k * 1024); } while (0)
#define PG8_LDB(dst, b, h) do { _Pragma("unroll") for (int n = 0; n < 2; ++n) _Pragma("unroll") for (int k = 0; k < 2; ++k) dst[n][k] = *(const LAS bf16x8*)(lds + PG8_SB(b, h) + boff + n * 2048 + k * 1024); } while (0)
#define PG8_MMA(ai, bj, At, Bt) do { __builtin_amdgcn_s_setprio(1); _Pragma("unroll") for (int m = 0; m < 4; ++m) _Pragma("unroll") for (int n = 0; n < 2; ++n) { \
        if constexpr (FP8) asm volatile("v_mfma_f32_16x16x128_f8f6f4 %0, %1, %2, %0" : "+v"(acc[ai][bj][m][n]) : "v"(cat8(Bt[n][0], Bt[n][1])), "v"(cat8(At[m][0], At[m][1])));   \
        else { _Pragma("unroll") for (int k = 0; k < 2; ++k) acc[ai][bj][m][n] = __builtin_amdgcn_mfma_f32_16x16x32_bf16(Bt[n][k], At[m][k], acc[ai][bj][m][n], 0, 0, 0); } } __builtin_amdgcn_s_setprio(0); } while (0)
#define PG8_WAIT_V(n) asm volatile("s_waitcnt vmcnt(" #n ")" ::: "memory")
#define PG8_WAIT_L(n) asm volatile("s_waitcnt lgkmcnt(" #n ")" ::: "memory")
#define PG8_BAR __builtin_amdgcn_s_barrier()
#define PG8_SCHED __builtin_amdgcn_sched_barrier(0)
    Unit cur, nxt; int ui = 0;
    if (!S.next(0, cur)) return;
    f32x4 acc[2][2][4][2];
#pragma unroll
    for (int a = 0; a < 2; ++a)
#pragma unroll
        for (int b = 0; b < 2; ++b)
#pragma unroll
            for (int m = 0; m < 4; ++m)
#pragma unroll
                for (int n = 0; n < 2; ++n) acc[a][b][m][n] = (f32x4){0.f, 0.f, 0.f, 0.f};
    bf16x8 At[4][2], B0[2][2], B1[2][2];
    const char* cA = (const char*)g.A + (GATHER ? (size_t)0 : (size_t)cur.pm * tstepA); const char* cB = (const char*)g.Bt + (size_t)cur.pn * tstepB;
    if constexpr (GATHER) PG8_ROWOFFS(cur, gc00, gc01, gc10, gc11);
    PG8_STAGE(PG8_SB(0, 0), cB, voffB); PG8_STAGE(PG8_SB(0, 1), cB + hstepB, voffB); PG8_STAGE_A(PG8_SA(0, 0), cA, 0, false); PG8_STAGE_A(PG8_SA(0, 1), cA, 1, false);
    if (wr == 1) PG8_BAR;
    PG8_WAIT_V(2); PG8_BAR;
    PG8_STAGE(PG8_SB(1, 0), cB + kstep, voffB); PG8_STAGE_A(PG8_SA(1, 0), cA + kstep, 0, false); PG8_STAGE(PG8_SB(1, 1), cB + hstepB + kstep, voffB);
    PG8_WAIT_V(6); PG8_BAR;
    for (;;) {
        const bool has_next = S.next(ui + 1, nxt);
        const char* nA = (has_next && !GATHER) ? (const char*)g.A + (size_t)nxt.pm * tstepA : cA;
        if constexpr (GATHER) { if (has_next) PG8_ROWOFFS(nxt, gn00, gn01, gn10, gn11); else { gn00 = gc00; gn01 = gc01; gn10 = gc10; gn11 = gc11; } } const char* nB = has_next ? (const char*)g.Bt + (size_t)nxt.pn * tstepB : cB;
#pragma nounroll
        for (int t = 0; t < nt; t += 2) {
            const bool last = (t == nt - 2);
            const char* a1 = cA + (size_t)(t + 1) * kstep;
            const char* a2 = last ? nA : cA + (size_t)(t + 2) * kstep; const char* b2 = last ? nB : cB + (size_t)(t + 2) * kstep;
            const char* a3 = a2 + kstep; const char* b3 = b2 + kstep;
            PG8_LDB(B0, 0, 0); PG8_LDB(B1, 0, 1); PG8_SCHED; PG8_LDA(At, 0, 0); PG8_STAGE_A(PG8_SA(1, 1), a1, 1, false);
            PG8_WAIT_V(8); PG8_WAIT_L(0); PG8_BAR; PG8_MMA(0, 0, At, B0); PG8_MMA(0, 1, At, B1); PG8_BAR; PG8_SCHED;
            PG8_LDA(At, 0, 1); PG8_STAGE(PG8_SB(0, 0), b2, voffB); PG8_STAGE(PG8_SB(0, 1), b2 + hstepB, voffB); PG8_STAGE_A(PG8_SA(0, 0), a2, 0, last);
            PG8_WAIT_V(8); PG8_WAIT_L(0); PG8_BAR; PG8_MMA(1, 0, At, B0); PG8_MMA(1, 1, At, B1); PG8_BAR; PG8_SCHED;
            PG8_LDB(B0, 1, 0); PG8_LDB(B1, 1, 1); PG8_SCHED; PG8_LDA(At, 1, 0); PG8_STAGE_A(PG8_SA(0, 1), a2, 1, last);
            PG8_WAIT_V(8); PG8_WAIT_L(0); PG8_BAR; PG8_MMA(0, 0, At, B0); PG8_MMA(0, 1, At, B1); PG8_BAR; PG8_SCHED;
            PG8_LDA(At, 1, 1); PG8_STAGE(PG8_SB(1, 0), b3, voffB); PG8_STAGE(PG8_SB(1, 1), b3 + hstepB, voffB); PG8_STAGE_A(PG8_SA(1, 0), a3, 0, last);
            PG8_WAIT_V(8); PG8_WAIT_L(0); PG8_BAR; PG8_MMA(1, 0, At, B0); PG8_MMA(1, 1, At, B1); PG8_BAR; PG8_SCHED;
        }
        if constexpr (FP8) asm volatile("s_nop 15\n\ts_nop 15" ::: "memory");
        if constexpr (ALIGN_EPI) { if (wr == 0) PG8_BAR; }
        { const int l2 = fresh_tid(wave) & 63; E(acc, cur, wr, wc, l2 & 15, l2 >> 4); }
        if (!has_next) break;
        if (!Epi::CHAIN || cur.aux == 2) {
#pragma unroll
        for (int a = 0; a < 2; ++a)
#pragma unroll
            for (int b = 0; b < 2; ++b)
#pragma unroll
                for (int m = 0; m < 4; ++m)
#pragma unroll
                    for (int n = 0; n < 2; ++n) acc[a][b][m][n] = (f32x4){0.f, 0.f, 0.f, 0.f}; }
        cur = nxt; cA = nA; cB = nB; ++ui;
        if constexpr (GATHER) { gc00 = gn00; gc01 = gn01; gc10 = gn10; gc11 = gn11; }
        if constexpr (ALIGN_EPI) { if (wr == 1) PG8_BAR; }
    }
    PG8_WAIT_V(0);
    if constexpr (!ALIGN_EPI) { if (wr == 0) PG8_BAR; }
    PG8_BAR;
#undef PG8_SA
#undef PG8_SB
#undef PG8_STAGE
#undef PG8_GLD
#undef PG8_STAGE_A
#undef PG8_ROWOFFS
#undef PG8_PIECE_voffA
#undef PG8_PIECE_voffB
#undef PG8_LDA
#undef PG8_LDB
#undef PG8_MMA
#undef PG8_WAIT_V
#undef PG8_WAIT_L
#undef PG8_BAR
#undef PG8_SCHED
}
}

template <int LDA, int LDB, int N, int KK, bool FP8 = false, class Epi>
__device__ __forceinline__ void gemm_dense(Frame& F, const bf16_t* A, const bf16_t* Bt, const Epi& E) {
    pg8::Gemm g{A, Bt}; pg8::StaticOrder So; So.init(T, N, F.G, (int)blockIdx.x);
    pg8::gemm_phase<Epi, pg8::StaticOrder, LDA, LDB, KK, true, false, FP8>(F.lds, F.wave, g, So, E);
}

template <bool F8> struct EpiP1 {
    static constexpr bool PERM = true, CHAIN = false;
    bf16_t *T0, *SGU, *GV, *CB, *Z; float *ST0, *STV;
    __device__ __forceinline__ void operator()(const f32x4 (&acc)[2][2][4][2], const pg8::Unit& u, int wr, int wc, int fr, int fq) const {
        const int pn = F8 ? (u.pn < 3 ? u.pn : u.pn + 2) : (u.pn < 2 ? u.pn + 3 : u.pn + 5);
#pragma unroll
        for (int ai = 0; ai < 2; ++ai)
#pragma unroll
            for (int m = 0; m < 4; ++m) { const int row = u.pm * 256 + ai * 128 + wr * 64 + m * 16 + fr;
                float ss0 = 0.f, ss1 = 0.f;
#pragma unroll
                for (int bj = 0; bj < 2; ++bj) { const int c = bj * 128 + wc * 32 + 8 * fq; f32x4 v0 = acc[ai][bj][m][0], v1 = acc[ai][bj][m][1]; float ss = 0.f;
                    if (F8) { v0 *= (1.f / W8_SCALE); v1 *= (1.f / W8_SCALE); }
                    if (pn < 3) { u32x2 w8; w8.x = pk4f8(v0[0], v0[1], v0[2], v0[3]); w8.y = pk4f8(v1[0], v1[1], v1[2], v1[3]); *(u32x2*)((unsigned char*)T0 + (size_t)row * T0W + pn * 256 + c) = w8; ss = dot8(v0, v1); }
                    else if (pn < 5) { v0 = fgelu4(v0); v1 = fgelu4(v1); *(u32x4*)(SGU + (size_t)row * SGW + (pn - 3) * 256 + c) = pack8(v0, v1); }
                    else if (pn < 7) { v0 = fgelu4(v0); v1 = fgelu4(v1); *(u32x4*)(GV + (size_t)row * SGW + (pn - 5) * 256 + c) = pack8(v0, v1); ss = dot8(v0, v1); }
                    else if (pn < 9) { *(u32x4*)(CB + (size_t)row * CW + (pn - 7) * 256 + c) = pack8(v0, v1); }
                    else { u32x2 w; w.x = cvt_pk(v0[0] * v0[1], v0[2] * v0[3]); w.y = cvt_pk(v1[0] * v1[1], v1[2] * v1[3]); *(u32x2*)(Z + (size_t)row * CW + (pn - 9) * 128 + (c >> 1)) = w; }
                    if (bj == 0) ss0 = ss; else ss1 = ss; }
                if (pn < 3 || (pn >= 5 && pn < 7)) {
                    float sv = (pn == 2) ? ss0 : ss0 + ss1;
                    sv += __shfl_xor(sv, 16); sv += __shfl_xor(sv, 32);
                    if (fq == 0) { if (pn < 3) ST0[(size_t)row * 12 + pn * 4 + wc] = sv; else STV[(size_t)row * 8 + (pn - 5) * 4 + wc] = sv; } }
                asm volatile("" ::: "memory"); }
    }
};
struct FnGates8 {
    unsigned char* ws;
    __device__ __forceinline__ void operator()(const pg8::Unit& u, int row, int col, f32x4 v0, f32x4 v1) const {
        const int w = u.pn >> 2; size_t off = WS_GB + (size_t)(w - 1) * (WS_GC - WS_GB); if (w == 0) off = WS_GA;
        constexpr float KS = -1.4426950408889634f / W8_SCALE;
        u32x2 pk = {0u, 0u};
#pragma unroll
        for (int j = 0; j < 4; ++j) {
            pk.x = __builtin_amdgcn_cvt_pk_u8_f32(__builtin_amdgcn_rcpf(1.f + __builtin_amdgcn_exp2f(KS * v0[j])) * 255.f + 0.5f, j, pk.x);
            pk.y = __builtin_amdgcn_cvt_pk_u8_f32(__builtin_amdgcn_rcpf(1.f + __builtin_amdgcn_exp2f(KS * v1[j])) * 255.f + 0.5f, j, pk.y); }
        const unsigned char* gb = ws + off; const unsigned vo = (unsigned)row * (unsigned)D + (unsigned)(col & 1023);
        *(u32x2*)(gb + vo) = pk;
    }
};
constexpr float QSCALE = 0.10206207261596577f * 1.4426950408889634f;
struct FnQ8 {
    bf16_t* Q; const float* ST0; const float* rope;
    struct Pre { f32x4 a, b, c, s; };
    __device__ __forceinline__ Pre pre(const pg8::Unit& u, int row, int col) const {
        Pre p; p.a = *(const f32x4*)(ST0 + (size_t)row * 12 + 4); p.b = *(const f32x4*)(ST0 + (size_t)row * 12 + 8);
        const int d = col % 96, i = d >= 64 ? (d - 64) >> 1 : 0;
        p.c = *(const f32x4*)(rope + (size_t)row * 32 + i); p.s = *(const f32x4*)(rope + (size_t)row * 32 + 16 + i);
        if (d < 64) { p.c = (f32x4){1.f, 1.f, 1.f, 1.f}; p.s = (f32x4){0.f, 0.f, 0.f, 0.f}; }
        return p; }
    __device__ __forceinline__ void post(const pg8::Unit& u, int row, int col, f32x4 v0, f32x4 v1, const Pre& p) const {
        const float r = rsqrtf((((p.a[0] + p.a[1]) + (p.a[2] + p.a[3])) + ((p.b[0] + p.b[1]) + (p.b[2] + p.b[3]))) * (1.f / QR) + EPS);
        const f32x4 t0 = v0 * (r * (QSCALE / W8_SCALE)), t1 = v1 * (r * (QSCALE / W8_SCALE)), c = p.c, s = p.s;
        v0[0] = t0[0] * c[0] - t0[1] * s[0]; v0[1] = t0[1] * c[0] + t0[0] * s[0]; v0[2] = t0[2] * c[1] - t0[3] * s[1]; v0[3] = t0[3] * c[1] + t0[2] * s[1];
        v1[0] = t1[0] * c[2] - t1[1] * s[2]; v1[1] = t1[1] * c[2] + t1[0] * s[2]; v1[2] = t1[2] * c[3] - t1[3] * s[3]; v1[3] = t1[3] * c[3] + t1[2] * s[3];
        *(u32x4*)(Q + (size_t)row * 768 + col) = pack8(v0, v1);
    }
};
struct FnKV8 {
    bf16_t *KN, *V; const float* ST0;
    struct Pre { f32x4 a; };
    __device__ __forceinline__ Pre pre(const pg8::Unit& u, int row, int col) const { Pre p; p.a = *(const f32x4*)(ST0 + (size_t)row * 12); return p; }
    __device__ __forceinline__ void post(const pg8::Unit& u, int row, int col, f32x4 v0, f32x4 v1, const Pre& p) const {
        const float r = rsqrtf(((p.a[0] + p.a[1]) + (p.a[2] + p.a[3])) * (1.f / KVR) + EPS) * (1.f / W8_SCALE);
        bf16_t* O = u.pn < 2 ? KN : V;
        *(u32x4*)(O + (size_t)row * 512 + (col & 511)) = pack8(v0 * r, v1 * r);
    }
};
template <bool FIRST> struct FnMerge8 {
    bf16_t* MRG; const bf16_t* G;
    struct Pre { u32x4 g, m; };
    __device__ __forceinline__ Pre pre(const pg8::Unit& u, int row, int col) const {
        const size_t o = (size_t)row * D + col; Pre p; p.g = *(const u32x4*)(G + o);
        if (!FIRST) p.m = *(const u32x4*)(MRG + o); else p.m = (u32x4){0u, 0u, 0u, 0u};
        return p; }
    __device__ __forceinline__ void post(const pg8::Unit& u, int row, int col, f32x4 v0, f32x4 v1, const Pre& p) const {
        const size_t o = (size_t)row * D + col; const u32x4 g = p.g, m = p.m;
        v0 = (f32x4){lo16(g.x) * v0[0], hi16(g.x) * v0[1], lo16(g.y) * v0[2], hi16(g.y) * v0[3]};
        v1 = (f32x4){lo16(g.z) * v1[0], hi16(g.z) * v1[1], lo16(g.w) * v1[2], hi16(g.w) * v1[3]};
        if (!FIRST) { v0 += (f32x4){lo16(m.x), hi16(m.x), lo16(m.y), hi16(m.y)}; v1 += (f32x4){lo16(m.z), hi16(m.z), lo16(m.w), hi16(m.w)}; }
        *(u32x4*)(MRG + o) = pack8(v0, v1);
    }
};
template <bool BASE_F32> struct FnResB {
    const void* base; bf16_t* out; unsigned char* out8;
    struct Pre { f32x4 b0, b1; };
    __device__ __forceinline__ Pre pre(const pg8::Unit& u, int row, int col) const { const size_t o = (size_t)row * D + col; Pre p;
        if (BASE_F32) { p.b0 = *(const f32x4*)((const float*)base + o); p.b1 = *(const f32x4*)((const float*)base + o + 4); }
        else { const u32x4 w = *(const u32x4*)((const bf16_t*)base + o); p.b0 = (f32x4){lo16(w.x), hi16(w.x), lo16(w.y), hi16(w.y)}; p.b1 = (f32x4){lo16(w.z), hi16(w.z), lo16(w.w), hi16(w.w)}; }
        return p; }
    __device__ __forceinline__ void post(const pg8::Unit& u, int row, int col, f32x4 v0, f32x4 v1, const Pre& p) const { v0 += p.b0; v1 += p.b1; *(u32x4*)(out + (size_t)row * D + col) = pack8(v0, v1);
        u32x2 w; w.x = pk4f8(v0[0], v0[1], v0[2], v0[3]); w.y = pk4f8(v1[0], v1[1], v1[2], v1[3]); *(u32x2*)(out8 + (size_t)row * D + col) = w; }
};
struct EpiResH {
    static constexpr bool PERM = true, CHAIN = false;
    const bf16_t* Hn; const float* rs; const float* gain; bf16_t* out; unsigned char* out8;
    __device__ __forceinline__ void operator()(const f32x4 (&acc)[2][2][4][2], const pg8::Unit& u, int wr, int wc, int fr, int fq) const {
        f32x4 ig[2][2]; u32x4 h[2][4][2]; float r[2][4];
#pragma unroll
        for (int bj = 0; bj < 2; ++bj) { const int col = u.pn * 256 + bj * 128 + wc * 32 + 8 * fq; ig[bj][0] = *(const f32x4*)(gain + col); ig[bj][1] = *(const f32x4*)(gain + col + 4); }
#pragma unroll
        for (int ai = 0; ai < 2; ++ai)
#pragma unroll
            for (int m = 0; m < 4; ++m) { const int row = u.pm * 256 + ai * 128 + wr * 64 + m * 16 + fr; r[ai][m] = rs[row];
#pragma unroll
                for (int bj = 0; bj < 2; ++bj) h[ai][m][bj] = *(const u32x4*)(Hn + (size_t)row * D + u.pn * 256 + bj * 128 + wc * 32 + 8 * fq); }
        asm volatile("" ::: "memory");
#pragma unroll
        for (int bj = 0; bj < 2; ++bj)
#pragma unroll
            for (int k = 0; k < 2; ++k) ig[bj][k] = (f32x4){__builtin_amdgcn_rcpf(ig[bj][k][0]), __builtin_amdgcn_rcpf(ig[bj][k][1]), __builtin_amdgcn_rcpf(ig[bj][k][2]), __builtin_amdgcn_rcpf(ig[bj][k][3])};
#pragma unroll
        for (int ai = 0; ai < 2; ++ai)
#pragma unroll
            for (int m = 0; m < 4; ++m) { const int row = u.pm * 256 + ai * 128 + wr * 64 + m * 16 + fr;
#pragma unroll
                for (int bj = 0; bj < 2; ++bj) { const size_t o = (size_t)row * D + u.pn * 256 + bj * 128 + wc * 32 + 8 * fq; const u32x4 w = h[ai][m][bj];
                    const f32x4 v0 = (f32x4){lo16(w.x), hi16(w.x), lo16(w.y), hi16(w.y)} * (ig[bj][0] * r[ai][m]) + acc[ai][bj][m][0];
                    const f32x4 v1 = (f32x4){lo16(w.z), hi16(w.z), lo16(w.w), hi16(w.w)} * (ig[bj][1] * r[ai][m]) + acc[ai][bj][m][1];
                    *(u32x4*)(out + o) = pack8(v0, v1);
                    u32x2 w8; w8.x = pk4f8(v0[0], v0[1], v0[2], v0[3]); w8.y = pk4f8(v1[0], v1[1], v1[2], v1[3]); *(u32x2*)(out8 + o) = w8; }
                asm volatile("" ::: "memory"); }
    }
};
struct FnRes8 {
    const float* base; float* out;
    struct Pre { f32x4 b0, b1; };
    __device__ __forceinline__ Pre pre(const pg8::Unit& u, int row, int col) const { const size_t o = (size_t)row * D + col; Pre p; p.b0 = *(const f32x4*)(base + o); p.b1 = *(const f32x4*)(base + o + 4); return p; }
    __device__ __forceinline__ void post(const pg8::Unit& u, int row, int col, f32x4 v0, f32x4 v1, const Pre& p) const {
        const size_t o = (size_t)row * D + col; *(f32x4*)(out + o) = p.b0 + v0; *(f32x4*)(out + o + 4) = p.b1 + v1;
    }
};
struct EpiChain {
    static constexpr bool PERM = true, CHAIN = true;
    bf16_t* MRG; const unsigned char* ws;
    static __device__ __forceinline__ f32x4 ub4(unsigned w) {
        return (f32x4){fmaxf((float)(w & 255u), 1.f), fmaxf((float)((w >> 8) & 255u), 1.f), fmaxf((float)((w >> 16) & 255u), 1.f), fmaxf((float)(w >> 24), 1.f)}; }
    __device__ __forceinline__ void operator()(f32x4 (&acc)[2][2][4][2], const pg8::Unit& u, int wr, int wc, int fr, int fq) const {
        const int br = u.aux;
        const size_t on = (br == 2) ? WS_GA : WS_GB + (size_t)br * (WS_GC - WS_GB), od = (br == 0) ? WS_GC : WS_GA;
        const unsigned char* Gn = ws + on; const unsigned char* Gd = ws + od;
        u32x2 gna[2][4][2], gda[2][4][2];
#pragma unroll
        for (int ai = 0; ai < 2; ++ai)
#pragma unroll
            for (int m = 0; m < 4; ++m)
#pragma unroll
                for (int bj = 0; bj < 2; ++bj) { const size_t o = (size_t)(u.rm * 256 + ai * 128 + wr * 64 + m * 16 + fr) * D + u.rn * 256 + bj * 128 + wc * 32 + 8 * fq;
                    gna[ai][m][bj] = *(const u32x2*)(Gn + o); if (br != 2) gda[ai][m][bj] = *(const u32x2*)(Gd + o); else gda[ai][m][bj] = (u32x2){0u, 0u}; }
        asm volatile("" ::: "memory");
#pragma unroll
        for (int ai = 0; ai < 2; ++ai) {
            const u32x2 (&gn)[4][2] = gna[ai]; const u32x2 (&gd)[4][2] = gda[ai];
#pragma unroll
            for (int m = 0; m < 4; ++m)
#pragma unroll
                for (int bj = 0; bj < 2; ++bj) { const size_t o = (size_t)(u.rm * 256 + ai * 128 + wr * 64 + m * 16 + fr) * D + u.rn * 256 + bj * 128 + wc * 32 + 8 * fq;
                    f32x4 f0 = ub4(gn[m][bj].x), f1 = ub4(gn[m][bj].y);
                    if (br != 2) { const f32x4 d0 = ub4(gd[m][bj].x), d1 = ub4(gd[m][bj].y);
                        f0 *= (f32x4){__builtin_amdgcn_rcpf(d0[0]), __builtin_amdgcn_rcpf(d0[1]), __builtin_amdgcn_rcpf(d0[2]), __builtin_amdgcn_rcpf(d0[3])};
                        f1 *= (f32x4){__builtin_amdgcn_rcpf(d1[0]), __builtin_amdgcn_rcpf(d1[1]), __builtin_amdgcn_rcpf(d1[2]), __builtin_amdgcn_rcpf(d1[3])};
                        acc[ai][bj][m][0] *= f0; acc[ai][bj][m][1] *= f1;
                    } else { *(u32x4*)(MRG + o) = pack8(acc[ai][bj][m][0] * (f0 * (1.f / 255.f)), acc[ai][bj][m][1] * (f1 * (1.f / 255.f))); } }
            asm volatile("" ::: "memory"); }
    }
};
struct FnMoe1G {
    bf16_t* ACT; const float* rl;
    struct Pre { float rs; };
    __device__ __forceinline__ Pre pre(const pg8::Unit& u, int row, int col) const { Pre p; p.rs = rl[(size_t)u.aux * T + u.rm * 256 + (row - u.pm * 256)] * (1.f / W8_SCALE); return p; }
    __device__ __forceinline__ void post(const pg8::Unit& u, int row, int col, f32x4 v0, f32x4 v1, const Pre& p) const {
        v0 *= p.rs; v1 *= p.rs;
        *(unsigned*)((unsigned char*)ACT + (size_t)row * DE + ((col & 511) >> 1)) = pk4f8(v0[0] * fsigmoid(v0[0]) * v0[1], v0[2] * fsigmoid(v0[2]) * v0[3], v1[0] * fsigmoid(v1[0]) * v1[1], v1[2] * fsigmoid(v1[2]) * v1[3]);
    }
};
struct FnMoe1_8 {
    bf16_t* ACT;
    __device__ __forceinline__ void operator()(const pg8::Unit& u, int row, int col, f32x4 v0, f32x4 v1) const {
        u32x2 w; w.x = cvt_pk(v0[0] * fsigmoid(v0[0]) * v0[1], v0[2] * fsigmoid(v0[2]) * v0[3]); w.y = cvt_pk(v1[0] * fsigmoid(v1[0]) * v1[1], v1[2] * fsigmoid(v1[2]) * v1[3]);
        *(u32x2*)(ACT + (size_t)row * DE + ((col & 511) >> 1)) = w;
    }
};
struct FnMoe2_8 {
    unsigned char* YB;
    __device__ __forceinline__ void operator()(const pg8::Unit& u, int row, int col, f32x4 v0, f32x4 v1) const {
        v0 *= (1.f / W8_SCALE); v1 *= (1.f / W8_SCALE);
        u32x2 w; w.x = pk4f8(v0[0], v0[1], v0[2], v0[3]); w.y = pk4f8(v1[0], v1[1], v1[2], v1[3]);
        *(u32x2*)(YB + (size_t)row * D + (col & 1023)) = w; }
};

__device__ __forceinline__ void sgmix_pass(Frame& F, int l, bf16_t* OUT) {
    typedef float f32x16 __attribute__((ext_vector_type(16)));
    const int tid_ = fresh_tid(F.wave), lane_ = tid_ & 63, r32 = lane_ & 31, hi = lane_ >> 5, wid = F.wave;
    LAS unsigned char* VT = F.lds; LAS float* RV = (LAS float*)(F.lds + TAB_OFF);
    bf16_t* SGU = (bf16_t*)(F.ws + WS_SGU); const bf16_t* GV = (const bf16_t*)(F.ws + WS_GV); const float* stv = (const float*)(F.ws + WS_STV);
    const float* sgn = F.in[8] + l * SGW; const bf16_t* WSG = (const bf16_t*)(F.ws + WS_WSG); const float* bs = F.in[10] + l * 4 * 128;
    for (int chunk = blockIdx.x; chunk < T / 128; chunk += gridDim.x) {
        const int t0 = chunk * 128;
        __syncthreads();
        if (tid_ < 128) { const f32x4 a = *(const f32x4*)(stv + (size_t)(t0 + tid_) * 8), b = *(const f32x4*)(stv + (size_t)(t0 + tid_) * 8 + 4);
            RV[tid_] = rsqrtf((((a[0] + a[1]) + (a[2] + a[3])) + ((b[0] + b[1]) + (b[2] + b[3]))) * (1.f / SGW) + EPS); }
        __syncthreads();
        u32x4 av[8], bv[8];
#pragma unroll
        for (int k = 0; k < 8; ++k) { const int c0 = (wid + 8 * k) * 8, s2 = 2 * lane_;
            av[k] = *(const u32x4*)(GV + (size_t)(t0 + s2) * SGW + c0); bv[k] = *(const u32x4*)(GV + (size_t)(t0 + s2 + 1) * SGW + c0); }
#pragma unroll
        for (int k = 0; k < 8; ++k) { const int cc = wid + 8 * k, c0 = cc * 8, s2 = 2 * lane_, g = c0 >> 7, d0 = c0 & 127;
            const u32x4 a = av[k], b = bv[k];
            const float ra = RV[s2], rb = RV[s2 + 1]; const f32x4 g0 = *(const f32x4*)(sgn + c0), g1 = *(const f32x4*)(sgn + c0 + 4);
            const float ga[8] = {g0[0], g0[1], g0[2], g0[3], g1[0], g1[1], g1[2], g1[3]};
#pragma unroll
            for (int j = 0; j < 8; ++j) { const unsigned wa = a[j >> 1], wb = b[j >> 1];
                const float va = ((j & 1) ? hi16(wa) : lo16(wa)) * ra * ga[j], vb = ((j & 1) ? hi16(wb) : lo16(wb)) * rb * ga[j];
                const int d = d0 + j;
                *(LAS unsigned*)(VT + g * 32768 + d * 256 + ((((s2 >> 3) ^ (d & 15)) << 4) + (s2 & 7) * 2)) = cvt_pk(va, vb); } }
        __syncthreads();
        const int g = wid >> 1;
#pragma unroll 1
        for (int pass = 0; pass < 2; ++pass) { const int tt = (wid & 1) ? 1 + pass : (pass ? 3 : 0);
            f32x16 acc[4] = {};
            const bf16_t* wrow = WSG + ((size_t)(g * 128 + 32 * tt + r32)) * 128 + 8 * hi;
            const LAS unsigned char* vb = VT + g * 32768;
            bf16x8 Af[8];
#pragma unroll
            for (int ks = 0; ks < 8; ++ks) Af[ks] = *(const bf16x8*)(wrow + 16 * ks);
            const int nks = 2 * (tt + 1);
#pragma unroll
            for (int ks = 0; ks < 8; ++ks) if (ks < nks) {
#pragma unroll
                for (int dt = 0; dt < 4; ++dt) { const int d = 32 * dt + r32;
                    const bf16x8 B = *(const LAS bf16x8*)(vb + d * 256 + (((2 * ks + hi) ^ (d & 15)) << 4));
                    acc[dt] = __builtin_amdgcn_mfma_f32_32x32x16_bf16(Af[ks], B, acc[dt], 0, 0, 0); } }
#pragma unroll
            for (int r = 0; r < 16; ++r) { const int t = 32 * tt + (r & 3) + 8 * (r >> 2) + 4 * hi; const float bias = bs[g * 128 + t];
#pragma unroll
                for (int dt = 0; dt < 4; ++dt) { const size_t o_ = (size_t)(t0 + t) * SGW + g * 128 + 32 * dt + r32;
                    OUT[o_] = (bf16_t)f2bf(bf2f(SGU[o_]) * (acc[dt][r] + bias)); } }
        }
    }
    __syncthreads();
}
__device__ __forceinline__ void conv_pass(Frame& F, int l, bf16_t* OUT) {
    const int tid_ = fresh_tid(F.wave);
    bf16_t* CB = (bf16_t*)(F.ws + WS_CB); const bf16_t* Z = (const bf16_t*)(F.ws + WS_Z); const float* cw = F.in[11] + (size_t)l * 3 * CW;
    const int gt = blockIdx.x * NTHREADS + tid_, nt = F.G * NTHREADS;
    for (int idx = gt; idx < (T / 4) * 64; idx += nt) { const int t0 = (idx >> 6) * 4, c8 = (idx & 63) * 8, s0 = t0 & (S - 1);
        u32x4 z[6], b[4];
        z[0] = (u32x4){0, 0, 0, 0}; z[1] = z[0];
        if (s0 >= 2) { z[0] = *(const u32x4*)(Z + (size_t)(t0 - 2) * CW + c8); z[1] = *(const u32x4*)(Z + (size_t)(t0 - 1) * CW + c8); }
#pragma unroll
        for (int i = 0; i < 4; ++i) { z[2 + i] = *(const u32x4*)(Z + (size_t)(t0 + i) * CW + c8); b[i] = *(const u32x4*)(CB + (size_t)(t0 + i) * CW + c8); }
        const f32x4 w00 = *(const f32x4*)(cw + c8), w01 = *(const f32x4*)(cw + c8 + 4), w10 = *(const f32x4*)(cw + CW + c8), w11 = *(const f32x4*)(cw + CW + c8 + 4), w20 = *(const f32x4*)(cw + 2 * CW + c8), w21 = *(const f32x4*)(cw + 2 * CW + c8 + 4);
        const float w0[8] = {w00[0], w00[1], w00[2], w00[3], w01[0], w01[1], w01[2], w01[3]}, w1[8] = {w10[0], w10[1], w10[2], w10[3], w11[0], w11[1], w11[2], w11[3]}, w2[8] = {w20[0], w20[1], w20[2], w20[3], w21[0], w21[1], w21[2], w21[3]};
#pragma unroll
        for (int i = 0; i < 4; ++i) { u32x4 o;
#pragma unroll
            for (int j = 0; j < 4; ++j) {
                const float y0 = w0[2 * j] * lo16(z[i][j]) + w1[2 * j] * lo16(z[i + 1][j]) + w2[2 * j] * lo16(z[i + 2][j]);
                const float y1 = w0[2 * j + 1] * hi16(z[i][j]) + w1[2 * j + 1] * hi16(z[i + 1][j]) + w2[2 * j + 1] * hi16(z[i + 2][j]);
                o[j] = cvt_pk(lo16(b[i][j]) * y0, hi16(b[i][j]) * y1); }
            *(u32x4*)(OUT + (size_t)(t0 + i) * CW + c8) = o; } }
}
__device__ __forceinline__ void krope_pass(Frame& F) {
    const int tid_ = fresh_tid(F.wave), lane_ = tid_ & 63; (void)lane_;
    const unsigned char* T8 = F.ws + WS_T0; bf16_t* KR = (bf16_t*)(F.ws + WS_KR); const float* rope = (const float*)(F.ws + WS_ROPE);
    const int gt = blockIdx.x * NTHREADS + tid_, nt = F.G * NTHREADS;
    for (int idx0 = gt; idx0 < T * 16; idx0 += 4 * nt) {
        float x1[4], x2[4], c[4], sn[4];
#pragma unroll
        for (int j = 0; j < 4; ++j) { const int idx = idx0 + j * nt; if (idx < T * 16) { const int t = idx >> 4, i = idx & 15;
            x1[j] = __builtin_amdgcn_cvt_f32_fp8((int)T8[(size_t)t * T0W + 640 + i], 0); x2[j] = __builtin_amdgcn_cvt_f32_fp8((int)T8[(size_t)t * T0W + 656 + i], 0); c[j] = rope[t * 32 + i]; sn[j] = rope[t * 32 + 16 + i]; } }
#pragma unroll
        for (int j = 0; j < 4; ++j) { const int idx = idx0 + j * nt; if (idx < T * 16) { const int t = idx >> 4, i = idx & 15;
            *(unsigned*)(KR + (size_t)t * 32 + 2 * i) = pk2(x1[j] * c[j] - x2[j] * sn[j], x2[j] * c[j] + x1[j] * sn[j]); } } }
}
__device__ __forceinline__ void attn_simple(Frame& F) {
    const int tid_ = fresh_tid(F.wave), lane_ = tid_ & 63; (void)lane_;
    const bf16_t* Q = (const bf16_t*)(F.ws + WS_Q); const bf16_t* KN = (const bf16_t*)(F.ws + WS_KN); const bf16_t* KR = (const bf16_t*)(F.ws + WS_KR);
    const bf16_t* V = (const bf16_t*)(F.ws + WS_V); bf16_t* O = (bf16_t*)(F.ws + WS_O);
    const float scale = 0.10206207261596577f;
    for (int item = ((int)blockIdx.x * NWAVES + F.wave); item < NB * NH * (S / 64); item += (F.G * NWAVES)) {
        const int bh = item / (S / 64), qb = item % (S / 64), b = bh >> 3, h = bh & 7, i = qb * 64 + lane_; const size_t t = (size_t)b * S + i;
        u32x4 qp[12]; float o[64]; float m = -1e30f, lsum = 0.f;
#pragma unroll
        for (int c = 0; c < 12; ++c) qp[c] = *(const u32x4*)(Q + t * 768 + h * 96 + c * 8);
#pragma unroll
        for (int d = 0; d < 64; ++d) o[d] = 0.f;
        const int jend = qb * 64 + 63;
        for (int j = 0; j <= jend; ++j) { const size_t tk = (size_t)b * S + j;
            float s = 0.f;
#pragma unroll
            for (int c = 0; c < 8; ++c) { const u32x4 w = *(const u32x4*)(KN + tk * 512 + h * 64 + c * 8);
#pragma unroll
                for (int e = 0; e < 4; ++e) s += lo16(qp[c][e]) * lo16(w[e]) + hi16(qp[c][e]) * hi16(w[e]); }
#pragma unroll
            for (int c = 0; c < 4; ++c) { const u32x4 w = *(const u32x4*)(KR + tk * 32 + c * 8);
#pragma unroll
                for (int e = 0; e < 4; ++e) s += lo16(qp[8 + c][e]) * lo16(w[e]) + hi16(qp[8 + c][e]) * hi16(w[e]); }
            s *= scale;
            const bool ok = j <= i;
            const float mn = ok ? fmaxf(m, s) : m; const float a = __expf(m - mn); const float p = ok ? __expf(s - mn) : 0.f;
            lsum = lsum * a + p; m = mn;
#pragma unroll
            for (int c = 0; c < 8; ++c) { const u32x4 w = *(const u32x4*)(V + tk * 512 + h * 64 + c * 8);
#pragma unroll
                for (int e = 0; e < 4; ++e) { o[c * 8 + 2 * e] = o[c * 8 + 2 * e] * a + p * lo16(w[e]); o[c * 8 + 2 * e + 1] = o[c * 8 + 2 * e + 1] * a + p * hi16(w[e]); } }
        }
        const float il = 1.f / lsum;
#pragma unroll
        for (int c = 0; c < 8; ++c) { u32x4 w;
#pragma unroll
            for (int e = 0; e < 4; ++e) w[e] = pk2(o[c * 8 + 2 * e] * il, o[c * 8 + 2 * e + 1] * il);
            *(u32x4*)(O + t * 512 + h * 64 + c * 8) = w; }
    }
}

namespace att {
constexpr int NW = 8, QBLK = 32, KVBLK = 64, QB = NW * QBLK;
constexpr int SHM_V = 16384, SHM_K = 16384;
constexpr int NVS = 3, NKS = 2;
constexpr int ATT_LDS = NVS * SHM_V + NKS * SHM_K + NW * 64 * 4;
constexpr int QS = 768, KNS = 512, KRS = 32, VS = 512, OS = 512;
constexpr float SCALE = 0.10206207261596577f, THR = 8.f;
constexpr unsigned WBIG = 1u << 30;
typedef short s16x4 __attribute__((ext_vector_type(4)));
typedef float f32x16 __attribute__((ext_vector_type(16)));
#define AT_KSWZ(row, colB) ((row) * 256 + ((colB) ^ (((row) & 7) << 4)))
#define AT_SBAR() __builtin_amdgcn_sched_barrier(0)
__device__ __forceinline__ int v_st(int k, int c) { const int kk = (k & ~0xC) | ((k & 4) << 1) | ((k & 8) >> 1); return ((kk >> 3) * 4 + (c >> 5)) * 512 + ((kk & 7) * 32 + (c & 31)) * 2; }
__device__ __forceinline__ int v_rd_base(int lane) { return ((lane & 3) << 3) | (((lane >> 2) & 3) << 6) | (((lane >> 4) & 1) << 5) | (((lane >> 5) & 1) << 8); }
constexpr int v_rd_off(int d0, int ks, int half) { return d0 * 512 + ks * 4096 + half * 2048; }
__device__ __forceinline__ int crow(int r, int hi) { return (r & 3) + 8 * (r >> 2) + 4 * hi; }
__device__ __forceinline__ unsigned cvtpk(float lo, float hi) { unsigned r; asm volatile("v_cvt_pk_bf16_f32 %0, %1, %2" : "=v"(r) : "v"(lo), "v"(hi)); return r; }
__device__ __forceinline__ void mask_tile(f32x16& p0, f32x16& p1, int dq, unsigned W) {
    const float NEG = -__builtin_inff();
#pragma unroll
    for (int r = 0; r < 16; ++r) { const int c = (r & 3) + 8 * (r >> 2);
        if (dq < c) p0[r] = NEG;
        if (dq < c + 32) p1[r] = NEG; }
}
constexpr float THR2 = 8.f;
template <bool FIRST>
__device__ __forceinline__ void partialSM(f32x16& p0, f32x16& p1, float& mref, f32x16& negm, float& alpha) {
    float pmax = p0[0];
#pragma unroll
    for (int r = 1; r < 16; ++r) pmax = fmaxf(pmax, p0[r]);
#pragma unroll
    for (int r = 0; r < 16; ++r) pmax = fmaxf(pmax, p1[r]);
    { auto rr = __builtin_amdgcn_permlane32_swap(__float_as_uint(pmax), __float_as_uint(pmax), false, false);
      pmax = fmaxf(__uint_as_float(rr[0]), __uint_as_float(rr[1])); }
    alpha = 1.f;
    if (FIRST || __builtin_expect(__any(pmax > THR2), 0)) {
        const float dl = FIRST ? pmax : fmaxf(pmax, 0.f);
        mref += dl;
#pragma unroll
        for (int r = 0; r < 16; ++r) { p0[r] -= dl; p1[r] -= dl; }
#pragma unroll
        for (int r = 0; r < 16; ++r) negm[r] = -mref;
        asm volatile("" : "+v"(negm));
        if (!FIRST) alpha = __builtin_amdgcn_exp2f(-dl);
    }
#pragma unroll
    for (int r = 0; r < 16; ++r) p0[r] = __builtin_amdgcn_exp2f(p0[r]);
}
__device__ __forceinline__ void finishSM(f32x16& p0, f32x16& p1, float alpha, float& l_reg, bf16x8& pa0, bf16x8& pa1, bf16x8& pa2, bf16x8& pa3) {
#pragma unroll
    for (int r = 0; r < 16; ++r) p1[r] = __builtin_amdgcn_exp2f(p1[r]);
    float ps = 0;
#pragma unroll
    for (int r = 0; r < 16; ++r) ps += p0[r];
#pragma unroll
    for (int r = 0; r < 16; ++r) ps += p1[r];
    { auto rr = __builtin_amdgcn_permlane32_swap(__float_as_uint(ps), __float_as_uint(ps), false, false);
      ps = __uint_as_float(rr[0]) + __uint_as_float(rr[1]); }
    l_reg = l_reg * alpha + ps;
#define AT_PK4(P, B_, OUT) do { unsigned a0 = cvtpk(P[B_+0], P[B_+1]), a1 = cvtpk(P[B_+2], P[B_+3]);                          \
        unsigned b0 = cvtpk(P[B_+4], P[B_+5]), b1 = cvtpk(P[B_+6], P[B_+7]);                                             \
        auto r0 = __builtin_amdgcn_permlane32_swap(a0, b0, false, false); auto r1 = __builtin_amdgcn_permlane32_swap(a1, b1, false, false); \
        u32x4 w = {r0[0], r1[0], r0[1], r1[1]}; OUT = *reinterpret_cast<bf16x8*>(&w); } while (0)
    AT_PK4(p0, 0, pa0); AT_PK4(p0, 8, pa1); AT_PK4(p1, 0, pa2); AT_PK4(p1, 8, pa3);
#undef AT_PK4
}
template <int KB>
__device__ __forceinline__ void qkt(f32x16& p0, f32x16& p1, const char* K_lds, int r32, int hi, const bf16x8* qr, const f32x16& negm) {
    p0 = negm; p1 = negm;
    const char* kb[4];
#pragma unroll
    for (int dd = 0; dd < 4; ++dd) kb[dd] = K_lds + KB * SHM_K + AT_KSWZ(r32, (dd * 16 + hi * 8) * 2);
#pragma unroll
    for (int d0 = 0; d0 < 6; ++d0) { const char* a = kb[d0 & 3] + (d0 >> 2) * 128;
        bf16x8 b0 = *reinterpret_cast<const bf16x8*>(a);
        bf16x8 b1 = *reinterpret_cast<const bf16x8*>(a + 32 * 256);
        p0 = __builtin_amdgcn_mfma_f32_32x32x16_bf16(b0, qr[d0], p0, 0, 0, 0);
        p1 = __builtin_amdgcn_mfma_f32_32x32x16_bf16(b1, qr[d0], p1, 0, 0, 0); }
}
template <int VB>
__device__ __forceinline__ void pv_tile(f32x16* o, int vb0, bf16x8 pa0, bf16x8 pa1, bf16x8 pa2, bf16x8 pa3) {
#define AT_TRRD(dst, off) asm volatile("ds_read_b64_tr_b16 %0, %1 offset:%2" : "=&v"(dst) : "v"(vb0), "i"(off) : "memory")
#define AT_PV_D0(d0) do { s16x4 l0, l1, l2, l3, h0, h1, h2, h3; constexpr int b_ = VB * SHM_V + v_rd_off(d0, 0, 0); \
        AT_TRRD(l0, b_); AT_TRRD(h0, b_ + 2048); AT_TRRD(l1, b_ + 4096); AT_TRRD(h1, b_ + 6144); AT_TRRD(l2, b_ + 8192); AT_TRRD(h2, b_ + 10240); AT_TRRD(l3, b_ + 12288); AT_TRRD(h3, b_ + 14336); \
        asm volatile("s_waitcnt lgkmcnt(0)" ::: "memory"); AT_SBAR();   \
        o[d0] = __builtin_amdgcn_mfma_f32_32x32x16_bf16(pa0, (bf16x8){l0[0], l0[1], l0[2], l0[3], h0[0], h0[1], h0[2], h0[3]}, o[d0], 0, 0, 0);   \
        o[d0] = __builtin_amdgcn_mfma_f32_32x32x16_bf16(pa1, (bf16x8){l1[0], l1[1], l1[2], l1[3], h1[0], h1[1], h1[2], h1[3]}, o[d0], 0, 0, 0);   \
        o[d0] = __builtin_amdgcn_mfma_f32_32x32x16_bf16(pa2, (bf16x8){l2[0], l2[1], l2[2], l2[3], h2[0], h2[1], h2[2], h2[3]}, o[d0], 0, 0, 0);   \
        o[d0] = __builtin_amdgcn_mfma_f32_32x32x16_bf16(pa3, (bf16x8){l3[0], l3[1], l3[2], l3[3], h3[0], h3[1], h3[2], h3[3]}, o[d0], 0, 0, 0); } while (0)
    AT_PV_D0(0); AT_PV_D0(1);
#undef AT_PV_D0
#undef AT_TRRD
}
struct BlockRef { const bf16_t* Q; const bf16_t* KN; const bf16_t* KR; const bf16_t* V; bf16_t* O; int P0; };
struct Seam { bf16x8 qr[6]; int v_prev, v_cur, v_next; };
#define AT_VMW() asm volatile("s_waitcnt vmcnt(0)" ::: "memory")
#define AT_VMWN(n) asm volatile("s_waitcnt vmcnt(%0)" :: "i"(n) : "memory")
__device__ __forceinline__ void glds16(const void* gsrc, unsigned lds_dst) { unsigned keep;
    asm volatile("s_mov_b32 %0, m0\n\ts_mov_b32 m0, %2\n\ts_nop 0\n\tglobal_load_lds_dwordx4 %1, off\n\ts_mov_b32 m0, %0" : "=&s"(keep) : "v"(gsrc), "s"(lds_dst) : "memory"); }
#define AT_LANE_CONSTS() \
    const int krow_ = 4 * wid + (lane >> 4), kc_ = (lane & 15) ^ (krow_ & 7); const bool isKR = (kc_ >= 8 && kc_ < 12); \
    const unsigned kstrB = isKR ? (unsigned)(KRS * 2) : (unsigned)(KNS * 2), koffB = (unsigned)krow_ * kstrB + (isKR ? (unsigned)(kc_ - 8) * 16u : (kc_ < 8 ? (unsigned)kc_ * 16u : 0u)); \
    const int vkk_ = wid * 8 + ((lane & 31) >> 2), vk_ = (vkk_ & ~0xC) | ((vkk_ & 4) << 1) | ((vkk_ & 8) >> 1); \
    const unsigned voffB = (unsigned)vk_ * (unsigned)(VS * 2) + (unsigned)(((lane >> 5) * 32 + (lane & 3) * 8) * 2); \
    const unsigned lds0 = (unsigned)(uintptr_t)lds
#define AT_DMA_TILE(ref, k0, kslot, vslot) do { \
        const unsigned kd_ = isKR ? (unsigned)((const char*)(ref).KR - (const char*)(ref).KN) : 0u; \
        const char* ks_ = (const char*)(ref).KN + (kd_ + koffB + (unsigned)(k0) * kstrB); \
        glds16(ks_, (unsigned)__builtin_amdgcn_readfirstlane((int)(lds0 + NVS * SHM_V + (kslot) + wid * 1024))); \
        glds16(ks_ + 32u * kstrB, (unsigned)__builtin_amdgcn_readfirstlane((int)(lds0 + NVS * SHM_V + (kslot) + (wid + 8) * 1024))); \
        glds16((const char*)(ref).V + (voffB + (unsigned)(k0) * (unsigned)(VS * 2)), (unsigned)__builtin_amdgcn_readfirstlane((int)(lds0 + (vslot) + wid * 2048))); } while (0)
#define AT_WAIT_SYNC() do { asm volatile("s_waitcnt vmcnt(0)" ::: "memory"); __syncthreads(); } while (0)
__device__ __forceinline__ void prime(const BlockRef& cur, char* lds, Seam& S, int tid) {
    const int wid = __builtin_amdgcn_readfirstlane(tid >> 6), lane = tid & 63, r32 = lane & 31, hi = lane >> 5;
    AT_LANE_CONSTS();
#pragma unroll
    for (int d0 = 0; d0 < 6; ++d0) S.qr[d0] = *(const bf16x8*)((const char*)cur.Q + (unsigned)(((wid * QBLK + r32) * QS + hi * 8) * 2) + d0 * 32);
    AT_DMA_TILE(cur, 0, 0, 0);
    S.v_prev = SHM_V; S.v_cur = 2 * SHM_V; S.v_next = 0;
}
typedef short v4i16_t __attribute__((ext_vector_type(4)));
__device__ __forceinline__ s16x4 vtr(const LAS char* p) { return __builtin_bit_cast(s16x4, __builtin_amdgcn_ds_read_tr16_b64_v4i16((LAS v4i16_t*)p)); }
#define AT_MFMA(a, b, c) __builtin_amdgcn_mfma_f32_32x32x16_bf16(a, b, c, 0, 0, 0)
#define AT_PIN(x) asm volatile("" : "+v"(x))
__device__ __forceinline__ void block(const BlockRef& cur, const BlockRef& nxt, char* lds, Seam& S, int tid) {
    const int wid = __builtin_amdgcn_readfirstlane(tid >> 6), lane = tid & 63, r32 = lane & 31, hi = lane >> 5;
    const int NT = (cur.P0 + QB - 1) / KVBLK + 1;
    const int qlo = cur.P0 + wid * QBLK, qm = qlo + r32 - 4 * hi;
    float* ws = (float*)(lds + NVS * SHM_V + NKS * SHM_K) + wid * 64; float* li_l = ws, * al_l = ws + 32;
    float mref = 0.f, l_reg = 0; f32x16 o[2] = {}; f32x16 negm = {}; AT_PIN(negm);
    AT_LANE_CONSTS();
    const LAS char* lds3 = (const LAS char*)lds;
    const LAS char* kp[4];
#pragma unroll
    for (int dd = 0; dd < 4; ++dd) kp[dd] = lds3 + NVS * SHM_V + AT_KSWZ(r32, (dd * 16 + hi * 8) * 2);
    const LAS char* vp = lds3 + v_rd_base(lane);
#define AT_KBASE(t) ((t) * KVBLK)
#define AT_MASKT(P0_, P1_, t) do { const int kb_ = AT_KBASE(t); if (kb_ + KVBLK - 1 > qlo) mask_tile(P0_, P1_, qm - kb_, WBIG); } while (0)
#define AT_KF(i, KB) (*(const LAS bf16x8*)(kp[((i) >> 1) & 3] + (KB) * SHM_K + ((i) >> 3) * 128 + ((i) & 1) * 8192))
#define AT_VRD(i, VO) do { vlo[i] = vtr(vp + (VO) + v_rd_off((i) >> 2, (i) & 3, 0)); vhi[i] = vtr(vp + (VO) + v_rd_off((i) >> 2, (i) & 3, 1)); } while (0)
#define AT_VFR(i) (bf16x8){vlo[i][0], vlo[i][1], vlo[i][2], vlo[i][3], vhi[i][0], vhi[i][1], vhi[i][2], vhi[i][3]}
#define AT_PAF(k) __builtin_bit_cast(bf16x8, pw##k)
#define AT_SWAPS(PW) do { auto r0_ = __builtin_amdgcn_permlane32_swap(a0, b0, false, false); auto r1_ = __builtin_amdgcn_permlane32_swap(a1, b1, false, false); PW = (u32x4){r0_[0], r1_[0], r0_[1], r1_[1]}; AT_PIN(PW); } while (0)
#define AT_EX4(X, B) do { X[B] = __builtin_amdgcn_exp2f(X[B]); X[B + 1] = __builtin_amdgcn_exp2f(X[B + 1]); X[B + 2] = __builtin_amdgcn_exp2f(X[B + 2]); X[B + 3] = __builtin_amdgcn_exp2f(X[B + 3]); AT_PIN(X); AT_SBAR(); } while (0)
#define AT_ROWMAX(C0, C1, rm) do { float a_ = fmaxf(fmaxf(C0[0], C0[1]), C1[0]), b_ = fmaxf(fmaxf(C0[2], C0[3]), C1[1]); a_ = fmaxf(fmaxf(a_, C1[2]), C1[3]); \
        _Pragma("unroll") for (int r = 4; r < 16; r += 4) { a_ = fmaxf(fmaxf(a_, C0[r]), C0[r + 1]); b_ = fmaxf(fmaxf(b_, C0[r + 2]), C0[r + 3]); a_ = fmaxf(fmaxf(a_, C1[r]), C1[r + 1]); b_ = fmaxf(fmaxf(b_, C1[r + 2]), C1[r + 3]); } \
        rm = fmaxf(a_, b_); { auto rr_ = __builtin_amdgcn_permlane32_swap(__float_as_uint(rm), __float_as_uint(rm), false, false); rm = fmaxf(__uint_as_float(rr_[0]), __uint_as_float(rr_[1])); } } while (0)
#define AT_PHASE_A(C0, C1, P0, P1, KB, VB) do { \
        kf[0] = AT_KF(0, KB); kf[1] = AT_KF(1, KB); kf[2] = AT_KF(2, KB); kf[3] = AT_KF(3, KB); AT_SBAR(); \
        sacc = P0[0] + P0[1]; \
        C0 = AT_MFMA(kf[0], S.qr[0], negm); kf[4] = AT_KF(4, KB); sacc += P0[2]; sacc += P0[3]; a0 = cvt_pk(P0[0], P0[1]); a1 = cvt_pk(P0[2], P0[3]); AT_PIN(a0); AT_PIN(a1); AT_PIN(sacc); AT_SBAR(); \
        C1 = AT_MFMA(kf[1], S.qr[0], negm); kf[5] = AT_KF(5, KB); sacc += P0[4]; sacc += P0[5]; sacc += P0[6]; b0 = cvt_pk(P0[4], P0[5]); b1 = cvt_pk(P0[6], P0[7]); AT_PIN(b0); AT_PIN(b1); AT_PIN(sacc); AT_SBAR(); \
        C0 = AT_MFMA(kf[2], S.qr[1], C0); kf[6] = AT_KF(6, KB); sacc += P0[7]; sacc += P0[8]; sacc += P0[9]; AT_SWAPS(pw0); AT_PIN(sacc); AT_SBAR(); \
        C1 = AT_MFMA(kf[3], S.qr[1], C1); kf[7] = AT_KF(7, KB); sacc += P0[10]; sacc += P0[11]; sacc += P0[12]; a0 = cvt_pk(P0[8], P0[9]); a1 = cvt_pk(P0[10], P0[11]); AT_PIN(a0); AT_PIN(a1); AT_PIN(sacc); AT_SBAR(); \
        C0 = AT_MFMA(kf[4], S.qr[2], C0); kf[8] = AT_KF(8, KB); sacc += P0[13]; sacc += P0[14]; sacc += P0[15]; b0 = cvt_pk(P0[12], P0[13]); b1 = cvt_pk(P0[14], P0[15]); AT_PIN(b0); AT_PIN(b1); AT_PIN(sacc); AT_SBAR(); \
        C1 = AT_MFMA(kf[5], S.qr[2], C1); kf[9] = AT_KF(9, KB); sacc += P1[0]; sacc += P1[1]; sacc += P1[2]; AT_SWAPS(pw1); AT_PIN(sacc); AT_SBAR(); \
        C0 = AT_MFMA(kf[6], S.qr[3], C0); kf[10] = AT_KF(10, KB); sacc += P1[3]; sacc += P1[4]; sacc += P1[5]; a0 = cvt_pk(P1[0], P1[1]); a1 = cvt_pk(P1[2], P1[3]); AT_PIN(a0); AT_PIN(a1); AT_PIN(sacc); AT_SBAR(); \
        C1 = AT_MFMA(kf[7], S.qr[3], C1); kf[11] = AT_KF(11, KB); sacc += P1[6]; sacc += P1[7]; sacc += P1[8]; b0 = cvt_pk(P1[4], P1[5]); b1 = cvt_pk(P1[6], P1[7]); AT_PIN(b0); AT_PIN(b1); AT_PIN(sacc); AT_SBAR(); \
        C0 = AT_MFMA(kf[8], S.qr[4], C0);  sacc += P1[9]; sacc += P1[10]; sacc += P1[11]; AT_SWAPS(pw2); AT_PIN(sacc); AT_SBAR(); \
        C1 = AT_MFMA(kf[9], S.qr[4], C1);  sacc += P1[12]; sacc += P1[13]; sacc += P1[14]; a0 = cvt_pk(P1[8], P1[9]); a1 = cvt_pk(P1[10], P1[11]); AT_PIN(a0); AT_PIN(a1); AT_PIN(sacc); AT_SBAR(); \
        C0 = AT_MFMA(kf[10], S.qr[5], C0); sacc += P1[15]; b0 = cvt_pk(P1[12], P1[13]); b1 = cvt_pk(P1[14], P1[15]); AT_PIN(b0); AT_PIN(b1); AT_PIN(sacc); AT_SBAR(); \
        C1 = AT_MFMA(kf[11], S.qr[5], C1); AT_SWAPS(pw3); AT_SBAR(); \
        l_reg += sacc; } while (0)
#define AT_DECIDE(C0, C1) do { float rm_; AT_ROWMAX(C0, C1, rm_); resc = false; \
        if (__builtin_expect(__any(rm_ > THR2), 0)) { const float dl_ = fmaxf(rm_, 0.f); mref += dl_; \
            _Pragma("unroll") for (int r = 0; r < 16; ++r) { C0[r] -= dl_; C1[r] -= dl_; } \
            _Pragma("unroll") for (int r = 0; r < 16; ++r) negm[r] = -mref; AT_PIN(negm); \
            fsc = __builtin_amdgcn_exp2f(-dl_); l_reg *= fsc; resc = true; } AT_SBAR(); } while (0)
#define AT_PHASE_B(C0, C1, VB) do { AT_VRD(0, VB); AT_VRD(4, VB); AT_SBAR(); \
        o[0] = AT_MFMA(AT_PAF(0), AT_VFR(0), o[0]); AT_VRD(1, VB); AT_EX4(C0, 0); \
        o[1] = AT_MFMA(AT_PAF(0), AT_VFR(4), o[1]); AT_VRD(5, VB); AT_EX4(C0, 4); \
        o[0] = AT_MFMA(AT_PAF(1), AT_VFR(1), o[0]); AT_VRD(2, VB); AT_EX4(C0, 8); \
        o[1] = AT_MFMA(AT_PAF(1), AT_VFR(5), o[1]); AT_VRD(6, VB); AT_EX4(C0, 12); \
        o[0] = AT_MFMA(AT_PAF(2), AT_VFR(2), o[0]); AT_VRD(3, VB); AT_EX4(C1, 0); \
        o[1] = AT_MFMA(AT_PAF(2), AT_VFR(6), o[1]); AT_VRD(7, VB); AT_EX4(C1, 4); \
        o[0] = AT_MFMA(AT_PAF(3), AT_VFR(3), o[0]); AT_EX4(C1, 8); \
        o[1] = AT_MFMA(AT_PAF(3), AT_VFR(7), o[1]); AT_EX4(C1, 12); } while (0)
#define AT_RESC() do { if (resc) { if (hi == 0) al_l[r32] = fsc; asm volatile("s_waitcnt lgkmcnt(0)" ::: "memory");              \
                     for (int d_ = 0; d_ < 2; ++d_) for (int r = 0; r < 16; ++r) o[d_][r] *= al_l[crow(r, hi)]; } } while (0)
    f32x16 pA0, pA1, pB0, pB1; bf16x8 kf[12]; s16x4 vlo[8], vhi[8]; u32x4 pw0, pw1, pw2, pw3; unsigned a0, a1, b0, b1; float sacc, fsc = 1.f; bool resc = false;
    int v_prev = S.v_prev, v_cur = S.v_cur, v_next = S.v_next;
#define AT_ROT() do { v_prev = v_cur; v_cur = v_next; v_next = (v_next == (NVS - 1) * SHM_V) ? 0 : v_next + SHM_V; } while (0)
    AT_WAIT_SYNC(); AT_ROT();
    AT_DMA_TILE(cur, AT_KBASE(1), SHM_K, v_next);
#pragma unroll
    for (int i = 0; i < 12; ++i) kf[i] = AT_KF(i, 0);
    pA0 = AT_MFMA(kf[0], S.qr[0], negm); pA1 = AT_MFMA(kf[1], S.qr[0], negm);
#pragma unroll
    for (int i = 2; i < 12; i += 2) { pA0 = AT_MFMA(kf[i], S.qr[i >> 1], pA0); pA1 = AT_MFMA(kf[i + 1], S.qr[i >> 1], pA1); }
    AT_MASKT(pA0, pA1, 0);
    { float rm_; AT_ROWMAX(pA0, pA1, rm_); mref = rm_;
#pragma unroll
      for (int r = 0; r < 16; ++r) { pA0[r] -= rm_; pA1[r] -= rm_; }
#pragma unroll
      for (int r = 0; r < 16; ++r) negm[r] = -mref;
      AT_PIN(negm);
#pragma unroll
      for (int r = 0; r < 16; ++r) { pA0[r] = __builtin_amdgcn_exp2f(pA0[r]); pA1[r] = __builtin_amdgcn_exp2f(pA1[r]); } }
    AT_WAIT_SYNC(); AT_ROT();
#define AT_STEP(C0, C1, P0, P1, t, KB) do { AT_SBAR();                                                                         \
        AT_DMA_TILE(cur, AT_KBASE((t) + 1), (1 - (KB)) * SHM_K, v_next); AT_SBAR();                                            \
        AT_PHASE_A(C0, C1, P0, P1, KB, 0);                                                                                    \
        AT_MASKT(C0, C1, (t)); AT_DECIDE(C0, C1);                                                                             \
        AT_PHASE_B(C0, C1, v_prev);                                                                                           \
        AT_RESC(); AT_WAIT_SYNC(); AT_ROT(); } while (0)
    for (int t = 1; t + 1 < NT; t += 2) {
        AT_STEP(pB0, pB1, pA0, pA1, t, 1);
        AT_STEP(pA0, pA1, pB0, pB1, t + 1, 0);
    }
    AT_SBAR();
    BlockRef nx = nxt;
    asm volatile("" : "+s"(nx.Q), "+s"(nx.KN), "+s"(nx.KR), "+s"(nx.V));
    AT_DMA_TILE(nx, 0, 0, v_next); AT_SBAR();
    AT_PHASE_A(pB0, pB1, pA0, pA1, 1, 0);
#pragma unroll
    for (int d0 = 0; d0 < 6; ++d0) S.qr[d0] = *(const bf16x8*)((const char*)nx.Q + (unsigned)(((wid * QBLK + r32) * QS + hi * 8) * 2) + d0 * 32);
    AT_SBAR();
    AT_MASKT(pB0, pB1, NT - 1); AT_DECIDE(pB0, pB1);
    AT_PHASE_B(pB0, pB1, v_prev);
    AT_RESC();
    { sacc = pB0[0] + pB0[1];
#pragma unroll
      for (int r = 2; r < 16; ++r) sacc += pB0[r];
#pragma unroll
      for (int r = 0; r < 16; ++r) sacc += pB1[r];
      l_reg += sacc;
#pragma unroll
      for (int i = 0; i < 8; ++i) AT_VRD(i, v_cur);
      a0 = cvt_pk(pB0[0], pB0[1]); a1 = cvt_pk(pB0[2], pB0[3]); b0 = cvt_pk(pB0[4], pB0[5]); b1 = cvt_pk(pB0[6], pB0[7]); AT_SWAPS(pw0);
      a0 = cvt_pk(pB0[8], pB0[9]); a1 = cvt_pk(pB0[10], pB0[11]); b0 = cvt_pk(pB0[12], pB0[13]); b1 = cvt_pk(pB0[14], pB0[15]); AT_SWAPS(pw1);
      a0 = cvt_pk(pB1[0], pB1[1]); a1 = cvt_pk(pB1[2], pB1[3]); b0 = cvt_pk(pB1[4], pB1[5]); b1 = cvt_pk(pB1[6], pB1[7]); AT_SWAPS(pw2);
      a0 = cvt_pk(pB1[8], pB1[9]); a1 = cvt_pk(pB1[10], pB1[11]); b0 = cvt_pk(pB1[12], pB1[13]); b1 = cvt_pk(pB1[14], pB1[15]); AT_SWAPS(pw3);
      o[0] = AT_MFMA(AT_PAF(0), AT_VFR(0), o[0]); o[1] = AT_MFMA(AT_PAF(0), AT_VFR(4), o[1]); o[0] = AT_MFMA(AT_PAF(1), AT_VFR(1), o[0]); o[1] = AT_MFMA(AT_PAF(1), AT_VFR(5), o[1]);
      o[0] = AT_MFMA(AT_PAF(2), AT_VFR(2), o[0]); o[1] = AT_MFMA(AT_PAF(2), AT_VFR(6), o[1]); o[0] = AT_MFMA(AT_PAF(3), AT_VFR(3), o[0]); o[1] = AT_MFMA(AT_PAF(3), AT_VFR(7), o[1]); }
    S.v_prev = v_prev; S.v_cur = v_cur; S.v_next = v_next;
    { auto rr = __builtin_amdgcn_permlane32_swap(__float_as_uint(l_reg), __float_as_uint(l_reg), false, false); l_reg = __uint_as_float(rr[0]) + __uint_as_float(rr[1]); }
    if (hi == 0) li_l[r32] = l_reg; asm volatile("s_waitcnt lgkmcnt(0)" ::: "memory");
    float rli[16];
#pragma unroll
    for (int r = 0; r < 16; ++r) rli[r] = __builtin_amdgcn_rcpf(li_l[crow(r, hi)]);
    bf16_t* Oc = cur.O; asm volatile("" : "+s"(Oc));
    bf16_t* Ow = Oc + (size_t)(wid * QBLK) * OS;
#pragma unroll
    for (int r = 0; r < 16; ++r) { const int orow = crow(r, hi);
#pragma unroll
        for (int d0 = 0; d0 < 2; ++d0) { const float v = o[d0][r] * rli[r]; const float vn = __shfl_xor(v, 1);
            if ((r32 & 1) == 0) *(unsigned*)((char*)Ow + (unsigned)((orow * OS + d0 * 32 + r32) * 2)) = cvtpk(v, vn); } }
#undef AT_RESC
#undef AT_ROT
#undef AT_KBASE
#undef AT_MASKT
#undef AT_STEP
#undef AT_PHASE_A
#undef AT_PHASE_B
#undef AT_DECIDE
#undef AT_ROWMAX
#undef AT_EX4
#undef AT_SWAPS
#undef AT_PAF
#undef AT_VFR
#undef AT_VRD
#undef AT_KF
}
__device__ __forceinline__ BlockRef make_ref(int L, int pass, const bf16_t* Q, const bf16_t* KN, const bf16_t* KR, const bf16_t* V, bf16_t* O) {
    const int bh = L >> 3, x = L & 7, b = bh >> 3, h = bh & 7, qb = pass ? 15 - x : x;
    BlockRef r; const size_t row0 = (size_t)b * S;
    r.Q = Q + (row0 + (size_t)qb * QB) * QS + h * 96; r.O = O + (row0 + (size_t)qb * QB) * OS + h * 64;
    r.KN = KN + row0 * KNS + h * 64; r.KR = KR + row0 * KRS; r.V = V + row0 * VS + h * 64; r.P0 = qb * QB;
    return r;
}
__device__ __forceinline__ void phase(char* lds, int tid, int vcu, int G, const bf16_t* Q, const bf16_t* KN, const bf16_t* KR, const bf16_t* V, bf16_t* O) {
    const int total = NB * NH * 8;
    int L = vcu; if (L >= total) return;
    if (__builtin_amdgcn_readfirstlane(tid >> 6) >= 4) __builtin_amdgcn_s_setprio(1);
    int pass = 0;
    BlockRef cur = make_ref(L, 0, Q, KN, KR, V, O);
    Seam S;
    prime(cur, lds, S, tid);
    for (;;) {
        const bool more_pass = pass == 0, more_item = L + G < total, last = !more_pass && !more_item;
        int passn = pass + 1, Ln = L;
        if (!more_pass) { passn = 0; Ln = more_item ? L + G : L; }
        const BlockRef nxt = last ? cur : make_ref(Ln, passn, Q, KN, KR, V, O);
        block(cur, nxt, lds, S, tid);
        if (last) break;
        cur = nxt; pass = passn; L = Ln;
    }
    __builtin_amdgcn_s_setprio(0);
}
#undef AT_VMW
#undef AT_VMWN
#undef AT_LANE_CONSTS
#undef AT_DMA_TILE
#undef AT_WAIT_SYNC
#undef AT_KSWZ
#undef AT_SBAR
}

__device__ __forceinline__ void moe_tables(Frame& F, int l) {
    const int tid_ = fresh_tid(F.wave);
    LAS int* base = (LAS int*)(F.lds + TAB_OFF); LAS int* cntl = (LAS int*)(F.lds + TAB_OFF + 192);
    LAS unsigned char* tile_e = (LAS unsigned char*)(F.lds + TAB_OFF + 320); LAS unsigned short* tile_r = (LAS unsigned short*)(F.lds + TAB_OFF + 896);
    __syncthreads();
    if (F.wave == 0) {
        const int lane = tid_ & 63;
        const int c = lane < NE ? (int)__hip_atomic_load(((unsigned*)F.ws) + CW_CNT + (l * NE + lane) * 64, __ATOMIC_RELAXED, __HIP_MEMORY_SCOPE_AGENT) : 0;
        const int nt = (c + 255) >> 8; int incl = nt;
#pragma unroll
        for (int o = 1; o < 32; o <<= 1) { const int v = __shfl_up(incl, o); if (lane >= o) incl += v; }
        const int excl = incl - nt;
        if (lane < NE) { base[lane] = excl * 256; cntl[lane] = c; for (int k = 0; k < nt; ++k) { tile_e[excl + k] = (unsigned char)lane; tile_r[excl + k] = (unsigned short)k; } }
        if (lane == NE - 1) { base[NE] = incl * 256; base[NE + 1] = incl; } }
    __syncthreads();
}
__device__ __forceinline__ void route_pass(Frame& F, int l, const bf16_t* X, const bool dry) {
    const int tid_ = fresh_tid(F.wave), lane_ = tid_ & 63, c16 = lane_ & 15, q = lane_ >> 4;
    LAS float* LG = (LAS float*)(F.lds + F.wave * 4096);
    const bf16_t* WH = (const bf16_t*)(F.ws + WS_WRT); const bf16_t* WL = WH + 48 * 1024;
    const float* bg = F.in[18] + l * 4; const float* be = F.in[20] + l * NE; const float* gain = F.in[16] + l * D;
    unsigned* rec = (unsigned*)(F.ws + WS_REC); unsigned* list = (unsigned*)(F.ws + WS_LIST); float* rl = (float*)(F.ws + WS_RL);
    const int gw_ = (int)blockIdx.x * NWAVES + F.wave, ngw_ = F.G * NWAVES, ntile_ = T / 16, nit_ = (ntile_ + 2 * ngw_ - 1) / (2 * ngw_);
    LAS unsigned* LC = (LAS unsigned*)(F.lds + TAB_OFF); LAS unsigned* GB = LC + 32;
    struct RouteRes { int e0, e1, row; unsigned l0, l1; float w0, w1, rstd; };
    for (int it_ = 0; it_ < nit_; ++it_) {
        const int tile0 = it_ * 2 * ngw_ + gw_, tile1 = tile0 + ngw_; const bool has0 = tile0 < ntile_, has1 = tile1 < ntile_;
        if (tid_ < 32) LC[tid_] = 0u;
        __syncthreads();
        RouteRes RA{}, RB{};
        if (has0) {
        const int rowA = tile0 * 16 + c16, rowB = (has1 ? tile1 : tile0) * 16 + c16;
        const bf16_t* xa = X + (size_t)rowA * D + 8 * q; const bf16_t* xb = X + (size_t)rowB * D + 8 * q; const float* gr = gain + 8 * q;
        const bf16_t* wh = WH + (size_t)c16 * 1024 + 8 * q; const bf16_t* wl = WL + (size_t)c16 * 1024 + 8 * q;
        f32x4 accA[3], accB[3]; accA[0] = (f32x4){0.f, 0.f, 0.f, 0.f}; accA[1] = accA[0]; accA[2] = accA[0]; accB[0] = accA[0]; accB[1] = accA[0]; accB[2] = accA[0]; float ssA = 0.f, ssB = 0.f;
#pragma unroll 4
        for (int ks = 0; ks < 32; ++ks) {
            const u32x4 xwa = *(const u32x4*)(xa + 32 * ks), xwb = *(const u32x4*)(xb + 32 * ks);
            const f32x4 g0 = *(const f32x4*)(gr + 32 * ks), g1 = *(const f32x4*)(gr + 32 * ks + 4);
            bf16x8 Bh[3], Bl[3];
#pragma unroll
            for (int nt = 0; nt < 3; ++nt) { Bh[nt] = *(const bf16x8*)(wh + (size_t)nt * 16 * 1024 + 32 * ks); Bl[nt] = *(const bf16x8*)(wl + (size_t)nt * 16 * 1024 + 32 * ks); }
#pragma unroll
            for (int h = 0; h < 2; ++h) { const u32x4 xw = h ? xwb : xwa;
                const f32x4 x0 = (f32x4){lo16(xw.x), hi16(xw.x), lo16(xw.y), hi16(xw.y)}, x1 = (f32x4){lo16(xw.z), hi16(xw.z), lo16(xw.w), hi16(xw.w)};
                if (h) ssB += dot8(x0, x1); else ssA += dot8(x0, x1);
                const f32x4 h0 = x0 * g0, h1 = x1 * g1;
                const u32x4 ph = pack8(h0, h1);
                const f32x4 r0 = h0 - (f32x4){lo16(ph.x), hi16(ph.x), lo16(ph.y), hi16(ph.y)}, r1 = h1 - (f32x4){lo16(ph.z), hi16(ph.z), lo16(ph.w), hi16(ph.w)};
                const u32x4 pl = pack8(r0, r1);
                const bf16x8 Ah = __builtin_bit_cast(bf16x8, ph), Al = __builtin_bit_cast(bf16x8, pl);
#pragma unroll
                for (int nt = 0; nt < 3; ++nt) { f32x4 a_ = h ? accB[nt] : accA[nt];
                    a_ = __builtin_amdgcn_mfma_f32_16x16x32_bf16(Ah, Bh[nt], a_, 0, 0, 0);
                    a_ = __builtin_amdgcn_mfma_f32_16x16x32_bf16(Ah, Bl[nt], a_, 0, 0, 0);
                    a_ = __builtin_amdgcn_mfma_f32_16x16x32_bf16(Al, Bh[nt], a_, 0, 0, 0);
                    if (h) accB[nt] = a_; else accA[nt] = a_; } } }
        auto finish = [&](const f32x4 (&acc)[3], float ss, const int row, RouteRes& RR) {
        ss += __shfl_xor(ss, 16); ss += __shfl_xor(ss, 32);
        const float rstd = rsqrtf(ss * (1.f / D) + EPS);
#pragma unroll
        for (int nt = 0; nt < 3; ++nt)
#pragma unroll
            for (int r = 0; r < 4; ++r) LG[(4 * q + r) * 48 + 16 * nt + c16] = acc[nt][r];
        LDS_WAIT(); asm volatile("" ::: "memory");
        if (lane_ < 16 && !dry) {
            const LAS float* lr = LG + lane_ * 48;
            float lg[4], le[32];
#pragma unroll
            for (int n = 0; n < 4; ++n) lg[n] = lr[n] * rstd + bg[n];
#pragma unroll
            for (int n = 0; n < 32; ++n) le[n] = lr[4 + n] * rstd + be[n];
            int gi = 0; float gm = lg[0];
#pragma unroll
            for (int n = 1; n < 4; ++n) if (lg[n] > gm) { gm = lg[n]; gi = n; }
            float gs = 0.f;
#pragma unroll
            for (int n = 0; n < 4; ++n) gs += __expf(lg[n] - gm);
            const float gp = 1.f / gs;
            float es[8];
#pragma unroll
            for (int j = 0; j < 8; ++j) es[j] = gi == 0 ? le[j] : (gi == 1 ? le[8 + j] : (gi == 2 ? le[16 + j] : le[24 + j]));
            int i0 = 0; float m0 = es[0];
#pragma unroll
            for (int j = 1; j < 8; ++j) if (es[j] > m0) { m0 = es[j]; i0 = j; }
            int i1 = -1; float m1 = -3.0e38f;
#pragma unroll
            for (int j = 0; j < 8; ++j) if (j != i0 && es[j] > m1) { m1 = es[j]; i1 = j; }
            const float p1 = __expf(m1 - m0);
            const float w0 = gp / (1.f + p1), w1 = gp * p1 / (1.f + p1);
            const int e0 = gi * 8 + i0, e1 = gi * 8 + i1;
            RR.e0 = e0; RR.e1 = e1; RR.row = row; RR.w0 = w0; RR.w1 = w1; RR.rstd = rstd;
            RR.l0 = __hip_atomic_fetch_add(LC + e0, 1u, __ATOMIC_RELAXED, __HIP_MEMORY_SCOPE_WORKGROUP);
            RR.l1 = __hip_atomic_fetch_add(LC + e1, 1u, __ATOMIC_RELAXED, __HIP_MEMORY_SCOPE_WORKGROUP);
        }
        LDS_WAIT(); asm volatile("" ::: "memory");
        };
        finish(accA, ssA, rowA, RA);
        if (has1) finish(accB, ssB, rowB, RB);
        }
        __syncthreads();
        if (F.wave == 0 && lane_ < NE && !dry) { const unsigned c = LC[lane_];
            GB[lane_] = c ? __hip_atomic_fetch_add(((unsigned*)F.ws) + CW_CNT + (l * NE + lane_) * 64, c, __ATOMIC_RELAXED, __HIP_MEMORY_SCOPE_AGENT) : 0u; }
        __syncthreads();
        auto commit = [&](const RouteRes& RR) {
            const unsigned pos0 = GB[RR.e0] + RR.l0, pos1 = GB[RR.e1] + RR.l1;
            u32x4 r0 = {(unsigned)RR.e0, pos0, (unsigned)RR.e1, pos1}, r1 = {__float_as_uint(RR.w0), __float_as_uint(RR.w1), __float_as_uint(RR.rstd), 0u};
            *(u32x4*)(rec + (size_t)RR.row * 8) = r0; *(u32x4*)(rec + (size_t)RR.row * 8 + 4) = r1;
            list[(size_t)RR.e0 * T + pos0] = (unsigned)RR.row; rl[(size_t)RR.e0 * T + pos0] = RR.rstd; list[(size_t)RR.e1 * T + pos1] = (unsigned)RR.row; rl[(size_t)RR.e1 * T + pos1] = RR.rstd; };
        if (has0 && lane_ < 16 && !dry) { commit(RA); if (has1) commit(RB); }
        __syncthreads();
    }
}
__device__ __forceinline__ void prep_small(Frame& F, int l) {
    const int tid_ = fresh_tid(F.wave); const int gt = blockIdx.x * NTHREADS + tid_, nt = F.G * NTHREADS;
    const float* wsrc = F.in[9] + (size_t)l * 4 * 128 * 128; bf16_t* WSG = (bf16_t*)(F.ws + WS_WSG);
    for (int idx = gt; idx < 4 * 128 * 128; idx += nt) { const int t = (idx >> 7) & 127, sidx = idx & 127; WSG[idx] = (bf16_t)f2bf(sidx <= t ? wsrc[idx] : 0.f); }
    const float* wg = F.in[17] + (size_t)l * D * 4; const float* we = F.in[19] + (size_t)l * D * NE; bf16_t* WH = (bf16_t*)(F.ws + WS_WRT); bf16_t* WL = WH + 48 * 1024;
    for (int idx = gt; idx < 48 * 1024; idx += nt) { const int n = idx >> 10, k = idx & 1023;
        const float v = n < 4 ? wg[k * 4 + n] : (n < 36 ? we[k * NE + (n - 4)] : 0.f);
        const unsigned h = f2bf(v); WH[idx] = (bf16_t)h; WL[idx] = (bf16_t)f2bf(v - bf2f(h)); }
}
__device__ __forceinline__ void combine_pass(Frame& F, const bf16_t* Xin, float* RS, float* OUT, const float* gain, bf16_t* H, unsigned char* H8, bool final_out) {
    const int tid_ = fresh_tid(F.wave), lane_ = tid_ & 63; (void)lane_;
    const LAS int* base = (const LAS int*)(F.lds + TAB_OFF); const unsigned* rec = (const unsigned*)(F.ws + WS_REC); const unsigned char* YB = F.ws + WS_YB;
    constexpr int RB = 4;
    f32x4 g[4];
#pragma unroll
    for (int j = 0; j < 4; ++j) g[j] = ((const f32x4*)gain)[lane_ + 64 * j];
    for (int m0 = ((int)blockIdx.x * NWAVES + F.wave); m0 < T; m0 += RB * (F.G * NWAVES)) {
        u32x4 r0[RB], r1[RB]; u32x2 xv[RB][4]; unsigned ya[RB][4], yb[RB][4];
#pragma unroll
        for (int r = 0; r < RB; ++r) { const int m = m0 + r * (F.G * NWAVES); if (m < T) { r0[r] = *(const u32x4*)(rec + (size_t)m * 8); r1[r] = *(const u32x4*)(rec + (size_t)m * 8 + 4); } }
#pragma unroll
        for (int r = 0; r < RB; ++r) { const int m = m0 + r * (F.G * NWAVES); if (m < T) {
            const size_t s0 = (size_t)base[r0[r].x] + r0[r].y, s1 = (size_t)base[r0[r].z] + r0[r].w;
            const u32x2* xr = (const u32x2*)(Xin + (size_t)m * D) + lane_;
            const unsigned* y0 = (const unsigned*)(YB + s0 * D) + lane_; const unsigned* y1 = (const unsigned*)(YB + s1 * D) + lane_;
#pragma unroll
            for (int j = 0; j < 4; ++j) { xv[r][j] = xr[64 * j]; ya[r][j] = y0[64 * j]; yb[r][j] = y1[64 * j]; } } }
#pragma unroll
        for (int r = 0; r < RB; ++r) { const int m = m0 + r * (F.G * NWAVES); if (m < T) {
            const float w0 = __uint_as_float(r1[r].x), w1 = __uint_as_float(r1[r].y); float ss = 0.f; f32x4 v[4];
#pragma unroll
            for (int j = 0; j < 4; ++j) { const u32x2 x_ = xv[r][j];
                const f32x2 a0 = __builtin_amdgcn_cvt_pk_f32_fp8((int)ya[r][j], false), a1 = __builtin_amdgcn_cvt_pk_f32_fp8((int)ya[r][j], true), b0 = __builtin_amdgcn_cvt_pk_f32_fp8((int)yb[r][j], false), b1 = __builtin_amdgcn_cvt_pk_f32_fp8((int)yb[r][j], true);
                v[j].x = lo16(x_.x) + w0 * a0[0] + w1 * b0[0]; v[j].y = hi16(x_.x) + w0 * a0[1] + w1 * b0[1]; v[j].z = lo16(x_.y) + w0 * a1[0] + w1 * b1[0]; v[j].w = hi16(x_.y) + w0 * a1[1] + w1 * b1[1];
                ss += (v[j].x * v[j].x + v[j].y * v[j].y) + (v[j].z * v[j].z + v[j].w * v[j].w); }
            const float ms = wave_sum(ss) * (1.f / D) + EPS, rstd = rsqrtf(ms);
            if (final_out) { f32x4* o = (f32x4*)(OUT + (size_t)m * D) + lane_;
#pragma unroll
                for (int j = 0; j < 4; ++j) o[64 * j] = (f32x4){v[j].x * rstd * g[j].x, v[j].y * rstd * g[j].y, v[j].z * rstd * g[j].z, v[j].w * rstd * g[j].w};
            } else {
                u32x2* o = (u32x2*)(H + (size_t)m * D) + lane_; if (lane_ == 0) RS[m] = ms * rstd;
#pragma unroll
                for (int j = 0; j < 4; ++j) { u32x2 w;
                    w.x = cvt_pk(v[j].x * rstd * g[j].x, v[j].y * rstd * g[j].y); w.y = cvt_pk(v[j].z * rstd * g[j].z, v[j].w * rstd * g[j].w); o[64 * j] = w; }
                unsigned* o8 = (unsigned*)(H8 + (size_t)m * D) + lane_;
#pragma unroll
                for (int j = 0; j < 4; ++j) o8[64 * j] = pk4f8(v[j].x * rstd * g[j].x, v[j].y * rstd * g[j].y, v[j].z * rstd * g[j].z, v[j].w * rstd * g[j].w);
            } } }
    }
}
template <int KK, int NperE, bool FP8 = false, class Fn>
__device__ __forceinline__ void gemm_moe(Frame& F, const bf16_t* A, const bf16_t* Bt, const Fn& f) {
    const LAS int* base = (const LAS int*)(F.lds + TAB_OFF);
    pg8::Gemm g{A, Bt}; pg8::MoeOrder So{(const LAS unsigned char*)(F.lds + TAB_OFF + 320), base[NE + 1], NperE / 256, F.G, (int)blockIdx.x};
    pg8::Epi8<Fn> E{f};
    pg8::gemm_phase<pg8::Epi8<Fn>, pg8::MoeOrder, KK, KK, KK, true, false, FP8>(F.lds, F.wave, g, So, E);
}

constexpr int PH_PER_LAYER = 9, N_PHASES = 1 + DEPTH * PH_PER_LAYER;
struct Args { const float* in[24]; float* out; unsigned char* ws; int ph_lo, ph_hi; };
#ifndef PHSEL
#define PHSEL -1
#endif
#ifndef REPEAT_MASK
#define REPEAT_MASK 0
#endif
#define REP(k) for (int rep_ = 0; rep_ < 1 + ((REPEAT_MASK >> (k)) & 1); ++rep_)
#define PHOK(j) (PHSEL < 0 || PHSEL == (j))
#define IN(k) (lo <= (k) && (k) < hi)
#define SEAM(k) do { if (IN(k) && IN((k) + 1)) xcd_barrier(bar, fresh_tid(F.wave) == 0); } while (0)
template <int l>
__device__ __forceinline__ void layer_body(Frame& F, const XcdBarrier& bar, const int lo, const int hi) {
    unsigned char* ws = F.ws; unsigned char* wt = ws + WS_WT;
    bf16_t* H = (bf16_t*)(ws + WS_H);
    constexpr int pb = 1 + l * PH_PER_LAYER;
    bf16_t* XS = (bf16_t*)F.out;
    bf16_t* xnew = (l + 1 < DEPTH) ? XS : (bf16_t*)(ws + WS_X1);
    if (PHOK(1) && IN(pb + 0)) {
        { EpiP1<true> E{(bf16_t*)(ws + WS_T0), (bf16_t*)(ws + WS_SGU), (bf16_t*)(ws + WS_GV), (bf16_t*)(ws + WS_CB), (bf16_t*)(ws + WS_Z), (float*)(ws + WS_ST0), (float*)(ws + WS_STV)};
          REP(0) gemm_dense<D / 2, D / 2, N_F8A, D / 2, true>(F, (const bf16_t*)(ws + WS_H8), (const bf16_t*)(wt + WT_WT8), E); }
        { EpiP1<false> E{(bf16_t*)(ws + WS_T0), (bf16_t*)(ws + WS_SGU), (bf16_t*)(ws + WS_GV), (bf16_t*)(ws + WS_CB), (bf16_t*)(ws + WS_Z), (float*)(ws + WS_ST0), (float*)(ws + WS_STV)};
          REP(0) gemm_dense<D, D, N_P1 - N_F8A, D>(F, H, (const bf16_t*)(wt + WT_WIN) + (size_t)N_F8A * D, E); } }
    SEAM(pb + 0);
    if (PHOK(2) && IN(pb + 1)) {
        const bool pass_first = (((int)blockIdx.x >> 3) & 1) != 0;
        if (pass_first) { sgmix_pass(F, l, (bf16_t*)(ws + WS_SGU)); conv_pass(F, l, (bf16_t*)(ws + WS_CB)); krope_pass(F); asm volatile("s_waitcnt vmcnt(0)" ::: "memory"); __syncthreads(); }
        { pg8::Epi8L<FnQ8, 2> E{{(bf16_t*)(ws + WS_Q), (const float*)(ws + WS_ST0), (const float*)(ws + WS_ROPE)}};
          REP(1) gemm_dense<T0W / 2, WQ8_LD / 2, 768, WQ8_LD / 2, true>(F, (const bf16_t*)(ws + WS_T0 + 256), (const bf16_t*)(wt + WT_WQ), E); }
        { pg8::Epi8A<FnKV8> E{{(bf16_t*)(ws + WS_KN), (bf16_t*)(ws + WS_V), (const float*)(ws + WS_ST0)}};
          REP(1) gemm_dense<T0W / 2, KVR / 2, 1024, KVR / 2, true>(F, (const bf16_t*)(ws + WS_T0), (const bf16_t*)(wt + WT_WKV), E); }
        if ((REPEAT_MASK >> 12) & 1) sgmix_pass(F, l, (bf16_t*)(ws + WS_GB)); if ((REPEAT_MASK >> 13) & 1) conv_pass(F, l, (bf16_t*)(ws + WS_GB));
        if (!pass_first) { sgmix_pass(F, l, (bf16_t*)(ws + WS_SGU)); conv_pass(F, l, (bf16_t*)(ws + WS_CB)); REP(11) krope_pass(F); }
    }
    SEAM(pb + 1);
    if (PHOK(3) && IN(pb + 2)) {
        const bool attn_first = (((int)blockIdx.x >> 3) & 1) != 0;
        const int vcu = (F.G % 8 == 0) ? ((int)blockIdx.x % 8) * (F.G / 8) + (int)blockIdx.x / 8 : (int)blockIdx.x;
        if (attn_first) { REP(3) att::phase((char*)F.lds_generic, fresh_tid(F.wave), vcu, F.G, (const bf16_t*)(ws + WS_Q), (const bf16_t*)(ws + WS_KN), (const bf16_t*)(ws + WS_KR), (const bf16_t*)(ws + WS_V), (bf16_t*)(ws + WS_O));
            asm volatile("s_waitcnt vmcnt(0)" ::: "memory"); __syncthreads(); }
        { pg8::Epi8<FnGates8> E{{ws}};
          REP(2) gemm_dense<D / 2, D / 2, N_GATES, D / 2, true>(F, (const bf16_t*)(ws + WS_H8), (const bf16_t*)(wt + WT_WG8), E); }
        if (!attn_first) { REP(3) att::phase((char*)F.lds_generic, fresh_tid(F.wave), vcu, F.G, (const bf16_t*)(ws + WS_Q), (const bf16_t*)(ws + WS_KN), (const bf16_t*)(ws + WS_KR), (const bf16_t*)(ws + WS_V), (bf16_t*)(ws + WS_O)); }
    }
    SEAM(pb + 2);
    if (PHOK(4) && IN(pb + 3)) {
        REP(4) {
        pg8::Gemm g{(const bf16_t*)ws, (const bf16_t*)ws};
        constexpr size_t TS = (size_t)256 * 512 * 2;
        static_assert(WS_SGU % TS == 0 && WS_CB % TS == 0 && WS_O % TS == 0 && (WS_WT + WT_WA) % TS == 0 && (WS_WT + WT_WB) % TS == 0 && (WS_WT + WT_WC) % TS == 0, "branch buffers must sit on 256 KiB boundaries");
        pg8::ChainOrder So; So.so.init(T, D, F.G, (int)blockIdx.x);
        EpiChain E{(bf16_t*)(ws + WS_MRG), ws};
        pg8::gemm_phase<EpiChain, pg8::ChainOrder, 512, 512, 512>(F.lds, F.wave, g, So, E);
        }
    }
    SEAM(pb + 3);
    if (PHOK(5) && IN(pb + 4)) {
        EpiResH E{H, (const float*)(ws + WS_RS), F.in[2] + l * D, xnew, ws + WS_XB};
        REP(5) gemm_dense<D, D, D, D>(F, (const bf16_t*)(ws + WS_MRG), (const bf16_t*)(wt + WT_WO), E); }
    SEAM(pb + 4);
    if (PHOK(6) && IN(pb + 5)) { REP(8) convert_moe_weights(F, l); if ((REPEAT_MASK >> 10) & 1) route_pass(F, l, xnew, true); route_pass(F, l, xnew, false); }
    SEAM(pb + 5);
    if (PHOK(7) && IN(pb + 6)) { moe_tables(F, l);
        const LAS int* base = (const LAS int*)(F.lds + TAB_OFF);
        pg8::Gemm g{(const bf16_t*)(ws + WS_XB), (const bf16_t*)(ws + WS_WGU)};
        pg8::MoeGatherOrder So{(const LAS unsigned char*)(F.lds + TAB_OFF + 320), (const LAS unsigned short*)(F.lds + TAB_OFF + 896), (const LAS int*)(F.lds + TAB_OFF + 192), (const unsigned*)(ws + WS_LIST), base[NE + 1], 2, F.G, (int)blockIdx.x};
        pg8::Epi8A<FnMoe1G> E{{(bf16_t*)(ws + WS_ACT), (const float*)(ws + WS_RL)}};
        REP(6) pg8::gemm_phase<pg8::Epi8A<FnMoe1G>, pg8::MoeGatherOrder, D / 2, D / 2, D / 2, true, true, true>(F.lds, F.wave, g, So, E); }
    SEAM(pb + 6);
    if (PHOK(8) && IN(pb + 7)) { if (!IN(pb + 6)) moe_tables(F, l);       FnMoe2_8 f{ws + WS_YB}; REP(7) gemm_moe<DE / 2, D, true>(F, (const bf16_t*)(ws + WS_ACT), (const bf16_t*)(ws + WS_WD), f);
        if (l + 1 < DEPTH) { convert_mixer_weights(F, l + 1); prep_small(F, l + 1); } }
    SEAM(pb + 7);
    if (PHOK(9) && IN(pb + 8)) { if (!IN(pb + 6)) moe_tables(F, l);
        if (l + 1 < DEPTH) combine_pass(F, xnew, (float*)(ws + WS_RS), nullptr, F.in[2] + (l + 1) * D, H, ws + WS_H8, false); else combine_pass(F, xnew, nullptr, F.out, F.in[23], H, ws + WS_H8, true); }
    SEAM(pb + 8);
}
__global__ void __launch_bounds__(NTHREADS, 2) fwd(Args args) {
    extern __shared__ __attribute__((aligned(16))) unsigned char lds_raw[];
    Frame F;
    F.lds = (LAS unsigned char*)lds_raw; F.lds_generic = lds_raw; F.ws = args.ws;
    F.wave = __builtin_amdgcn_readfirstlane((int)threadIdx.x >> 6); F.G = gridDim.x;
    F.in = args.in;
    F.out = args.out;
    volatile LAS unsigned* MISC = (volatile LAS unsigned*)(F.lds + MISC_OFF);
    if (threadIdx.x < 32) MISC[threadIdx.x] = 0u;
    __syncthreads();
    XcdBarrier bar; bar.bar = ((unsigned*)F.ws) + CW_BAR; bar.x = 0; bar.st = nullptr;
    const int lo = args.ph_lo, hi = args.ph_hi;
    if (hi - lo > 1) bar = xcd_barrier_post(((unsigned*)F.ws) + CW_BAR, MISC + 8);
    if (PHOK(0) && IN(0)) REP(9) { convert_mixer_weights(F, 0); prep_small(F, 0); rope_table(F); norm_rows_bf16(F, F.in[0], F.in[2], (bf16_t*)(F.ws + WS_H), F.ws + WS_H8, (float*)(F.ws + WS_RS)); }
    SEAM(0);
    layer_body<0>(F, bar, lo, hi);
    layer_body<1>(F, bar, lo, hi);
}
#undef IN
#undef SEAM

extern "C" void kernel_launch(void* const* d_in, const int* in_sizes, int n_in, void* d_out, int out_size, void* d_ws, size_t ws_size, hipStream_t stream) {
    static int grid = 0;
    if (grid == 0) {
        if (n_in != 24 || out_size != T * D || ws_size < WS_END) { fprintf(stderr, "kernel_launch: unexpected shapes (n_in %d, out %d, ws %zu)\n", n_in, out_size, ws_size); grid = -1; return; }
        int dev = 0, cus = 0;
        if (hipGetDevice(&dev) != hipSuccess || hipDeviceGetAttribute(&cus, hipDeviceAttributeMultiprocessorCount, dev) != hipSuccess) { grid = -1; return; }
        if (hipFuncSetAttribute((const void*)fwd, hipFuncAttributeMaxDynamicSharedMemorySize, LDS_BYTES) != hipSuccess) { fprintf(stderr, "kernel_launch: hipFuncSetAttribute failed\n"); grid = -1; return; }
        int per_cu = 0;
        if (hipOccupancyMaxActiveBlocksPerMultiprocessor(&per_cu, (const void*)fwd, NTHREADS, LDS_BYTES) != hipSuccess || per_cu < 1) fprintf(stderr, "kernel_launch: occupancy query says %d\n", per_cu);
        (void)hipGetLastError();
        grid = cus;
    }
    if (grid < 0) return;
    (void)hipMemsetAsync((char*)d_ws + WS_CTL, 0, CTL_ZERO_BYTES, stream);
    Args a{};
    for (int i = 0; i < 24; ++i) a.in[i] = (const float*)d_in[i];
    a.out = (float*)d_out; a.ws = (unsigned char*)d_ws;
#if MK_ONE_LAUNCH
    a.ph_lo = 0; a.ph_hi = N_PHASES;
    hipLaunchKernelGGL(fwd, dim3(grid), dim3(NTHREADS), LDS_BYTES, stream, a);
#else
    for (int p = 0; p < N_PHASES; ++p) { a.ph_lo = p; a.ph_hi = p + 1; hipLaunchKernelGGL(fwd, dim3(grid), dim3(NTHREADS), LDS_BYTES, stream, a); }
#endif
}
```
